# Optimizing an MI355X kernel written in HIP

```python
import jax
import jax.numpy as jnp
from jax import lax
import numpy as np

D_MODEL = 1024
BATCH = 32
SEQ = 2048
DEPTH = 1

RET_HEADS = 4
RET_DK = 64
RET_DV = 128
RET_CHUNK = 128
RET_THETA = 10000.0
MOBA_HEADS = 8
MOBA_DH = 64
MOBA_BLOCK = 256
MOBA_TOPK = 3
MOBA_Q_CHUNK = 16
ROPE_THETA = 500000.0
ROPE_DIM = MOBA_DH // 4
RET_QK_W = RET_HEADS * RET_DK
RET_V_W = RET_HEADS * RET_DV
MOBA_W = MOBA_HEADS * MOBA_DH
D_MIX = RET_V_W + MOBA_W
D_IN = 2 * RET_QK_W + 2 * RET_V_W + 3 * MOBA_W
SPLITS = [int(v) for v in np.cumsum([RET_QK_W, RET_QK_W, RET_V_W, RET_V_W, MOBA_W, MOBA_W])]
N_EXPERTS = 32
TOP_K = 4
D_EXPERT = D_MODEL
SWIGLU_LIMIT = 7.0
SWIGLU_ALPHA = 1.702
MOE_BLOCK = 256
RMS_EPS = 1e-5
GN_EPS = 1e-6
NEG_INF = -1e30

kernel_name = "hybrid_retention_moba_moe_layer"


def rms_norm(x, w):
    xf = x.astype(jnp.float32)
    y = xf * lax.rsqrt(jnp.mean(xf * xf, axis=-1, keepdims=True) + RMS_EPS)
    return (y * w.astype(jnp.float32)).astype(x.dtype)


def rotary(x, pos, rot_dim, theta):
    half = rot_dim // 2
    inv_freq = theta ** (-2.0 * jnp.arange(half, dtype=jnp.float32) / rot_dim)
    ang = pos.astype(jnp.float32)[:, None] * inv_freq[None, :]
    cos = jnp.cos(ang)[None, :, None, :]
    sin = jnp.sin(ang)[None, :, None, :]
    xf = x.astype(jnp.float32)
    x1 = xf[..., :half]
    x2 = xf[..., half:rot_dim]
    out = jnp.concatenate([x1 * cos - x2 * sin, x1 * sin + x2 * cos, xf[..., rot_dim:]], axis=-1)
    return out.astype(x.dtype)


def retention(q, k, v):
    b, s, h, dk = q.shape
    dv = v.shape[-1]
    c = RET_CHUNK
    nc = s // c
    to_chunks = lambda t: t.reshape(b, nc, c, h, t.shape[-1]).transpose(0, 3, 1, 2, 4).astype(jnp.float32)
    qc = to_chunks(q)
    kc = to_chunks(k) * (dk ** -0.5)
    vc = to_chunks(v)
    log_g = jnp.log1p(-jnp.exp2(-5.0 - jnp.arange(h, dtype=jnp.float32)))
    idx = jnp.arange(c, dtype=jnp.float32)
    rel = idx[:, None] - idx[None, :]
    decay = jnp.where(rel >= 0, jnp.exp(log_g[:, None, None] * jnp.maximum(rel, 0.0)), 0.0)
    scores = jnp.einsum("bhcnd,bhcmd->bhcnm", qc, kc) * decay[:, None]
    inner = jnp.einsum("bhcnm,bhcme->bhcne", scores, vc)
    zeta = jnp.exp(log_g[:, None] * (c - 1.0 - idx))
    chunk_state = jnp.einsum("bhcmd,bhcme->bhcde", kc * zeta[:, None, :, None], vc)
    chunk_decay = jnp.exp(log_g * c)[:, None, None]

    def step(r, u):
        return chunk_decay * r + u, r

    _, r_prev = lax.scan(step, jnp.zeros((b, h, dk, dv), jnp.float32), chunk_state.transpose(2, 0, 1, 3, 4))
    r_prev = r_prev.transpose(1, 2, 0, 3, 4)
    xi = jnp.exp(log_g[:, None] * (idx + 1.0))
    cross = jnp.einsum("bhcnd,bhcde->bhcne", qc * xi[:, None, :, None], r_prev)
    return (inner + cross).transpose(0, 2, 3, 1, 4).reshape(b, s, h, dv)


def moba_attention(q, k, v):
    b, h, s, d = q.shape
    nb = -(-s // MOBA_BLOCK)
    sp = nb * MOBA_BLOCK
    pad = [(0, 0), (0, 0), (0, sp - s), (0, 0)]
    q = jnp.pad(q, pad)
    k = jnp.pad(k, pad)
    v = jnp.pad(v, pad)
    kb = k.reshape(b, h, nb, MOBA_BLOCK, d)
    vb = v.reshape(b, h, nb, MOBA_BLOCK, d)
    k_mean = jnp.mean(kb.astype(jnp.float32), axis=3)
    gate = jnp.einsum("bhsd,bhnd->bhsn", q.astype(jnp.float32), k_mean)
    q_blk = jnp.arange(sp) // MOBA_BLOCK
    fully_past = jnp.arange(nb)[None, :] < q_blk[:, None]
    gate = jnp.where(fully_past, gate, NEG_INF)
    k_sel = max(1, min(MOBA_TOPK, nb - 1))
    _, sel = lax.top_k(gate, k_sel)
    nq = sp // MOBA_Q_CHUNK
    qs = q.reshape(b, h, nq, MOBA_Q_CHUNK, d).transpose(2, 0, 1, 3, 4)
    sels = sel.reshape(b, h, nq, MOBA_Q_CHUNK, k_sel).transpose(2, 0, 1, 3, 4)
    gather = jax.vmap(jax.vmap(lambda blocks, ids: blocks[ids]))
    scale = d ** -0.5
    key_in_blk = jnp.arange(MOBA_BLOCK)
    slot_ids = jnp.arange(k_sel)

    def query_chunk(args):
        ci, q_c, sel_c = args
        q0 = ci * MOBA_Q_CHUNK
        blk = q0 // MOBA_BLOCK
        k_own = lax.dynamic_index_in_dim(kb, blk, axis=2, keepdims=False)
        v_own = lax.dynamic_index_in_dim(vb, blk, axis=2, keepdims=False)
        k_g = gather(kb, sel_c)
        v_g = gather(vb, sel_c)
        s_own = jnp.einsum("bhqd,bhld->bhql", q_c, k_own, preferred_element_type=jnp.float32) * scale
        q_in_blk = q0 % MOBA_BLOCK + jnp.arange(MOBA_Q_CHUNK)
        s_own = jnp.where(key_in_blk[None, :] <= q_in_blk[:, None], s_own, NEG_INF)
        s_sel = jnp.einsum("bhqd,bhqkld->bhqkl", q_c, k_g, preferred_element_type=jnp.float32) * scale
        s_sel = jnp.where((slot_ids < blk)[:, None], s_sel, NEG_INF)
        n_sel = k_sel * MOBA_BLOCK
        logits = jnp.concatenate([s_sel.reshape(b, h, MOBA_Q_CHUNK, n_sel), s_own], axis=-1)
        p = jax.nn.softmax(logits, axis=-1)
        p_sel = p[..., :n_sel].reshape(b, h, MOBA_Q_CHUNK, k_sel, MOBA_BLOCK).astype(v.dtype)
        p_own = p[..., n_sel:].astype(v.dtype)
        return (jnp.einsum("bhqkl,bhqkld->bhqd", p_sel, v_g, preferred_element_type=jnp.float32)
                + jnp.einsum("bhql,bhld->bhqd", p_own, v_own, preferred_element_type=jnp.float32))

    out = lax.map(query_chunk, (jnp.arange(nq), qs, sels))
    return out.transpose(1, 2, 0, 3, 4).reshape(b, h, sp, d)[:, :, :s]


def clamped_swiglu(u):
    gate, lin = jnp.split(u, 2, axis=-1)
    gate = jnp.minimum(gate, SWIGLU_LIMIT)
    lin = jnp.clip(lin, -SWIGLU_LIMIT, SWIGLU_LIMIT)
    return gate * jax.nn.sigmoid(SWIGLU_ALPHA * gate) * (lin + 1.0)


def moe_ffn(h, w_router, b_router, w1, b1, w2, b2):
    n, d = h.shape
    logits = jnp.dot(h, w_router, preferred_element_type=jnp.float32) + b_router.astype(jnp.float32)
    top_logit, top_e = lax.top_k(logits, TOP_K)
    gate = jax.nn.softmax(top_logit, axis=-1)
    n_pairs = n * TOP_K
    e_flat = top_e.reshape(n_pairs)
    order = jnp.argsort(e_flat).astype(jnp.int32)
    e_sorted = e_flat[order]
    counts = jnp.bincount(e_flat, length=N_EXPERTS).astype(jnp.int32)
    padded = (counts + MOE_BLOCK - 1) // MOE_BLOCK * MOE_BLOCK
    start = jnp.cumsum(counts) - counts
    pad_end = jnp.cumsum(padded)
    pad_start = pad_end - padded
    dest = pad_start[e_sorted] + jnp.arange(n_pairs, dtype=jnp.int32) - start[e_sorted]
    n_blocks = -(-n_pairs // MOE_BLOCK) + N_EXPERTS
    slot_pair = jnp.full((n_blocks * MOE_BLOCK,), n_pairs, dtype=jnp.int32).at[dest].set(order)
    slot_tok = slot_pair // TOP_K
    slot_gate = jnp.concatenate([gate.reshape(n_pairs), jnp.zeros((1,), gate.dtype)])[slot_pair]
    block_expert = jnp.minimum(
        jnp.searchsorted(pad_end, jnp.arange(n_blocks, dtype=jnp.int32) * MOE_BLOCK, side="right"),
        N_EXPERTS - 1)
    h_pad = jnp.concatenate([h, jnp.zeros((1, d), h.dtype)], axis=0)

    def expert_block(acc, xs):
        tok, g, e = xs
        u = jnp.dot(h_pad[tok], w1[e], preferred_element_type=jnp.float32) + b1[e]
        y = jnp.dot(clamped_swiglu(u).astype(h.dtype), w2[e], preferred_element_type=jnp.float32) + b2[e]
        return acc.at[tok].add(y * g[:, None]), None

    acc, _ = lax.scan(expert_block, jnp.zeros((n + 1, d), jnp.float32),
                      (slot_tok.reshape(n_blocks, MOE_BLOCK), slot_gate.reshape(n_blocks, MOE_BLOCK), block_expert))
    return acc[:n].astype(h.dtype)


def setup_inputs(seed: int = 0) -> dict:
    key = jax.random.key(seed)
    ks = jax.random.split(key, 13)
    f32 = jnp.float32
    nrm = lambda k, shape, scale: jax.random.normal(k, shape, f32) * scale
    return {
        "x": nrm(ks[0], (BATCH, SEQ, D_MODEL), 1.0),
        "norm1_w": 1.0 + nrm(ks[1], (DEPTH, D_MODEL), 0.02),
        "w_in": nrm(ks[2], (DEPTH, D_MODEL, D_IN), D_MODEL ** -0.5),
        "ret_norm_w": 1.0 + nrm(ks[3], (DEPTH, RET_V_W), 0.02),
        "w_out": nrm(ks[4], (DEPTH, D_MIX, D_MODEL), D_MIX ** -0.5),
        "norm2_w": 1.0 + nrm(ks[5], (DEPTH, D_MODEL), 0.02),
        "w_router": nrm(ks[6], (DEPTH, D_MODEL, N_EXPERTS), D_MODEL ** -0.5),
        "b_router": nrm(ks[7], (DEPTH, N_EXPERTS), 0.01),
        "w1": nrm(ks[8], (DEPTH, N_EXPERTS, D_MODEL, 2 * D_EXPERT), D_MODEL ** -0.5),
        "b1": nrm(ks[9], (DEPTH, N_EXPERTS, 2 * D_EXPERT), 0.01),
        "w2": nrm(ks[10], (DEPTH, N_EXPERTS, D_EXPERT, D_MODEL), D_EXPERT ** -0.5),
        "b2": nrm(ks[11], (DEPTH, N_EXPERTS, D_MODEL), 0.01),
        "final_norm_w": 1.0 + nrm(ks[12], (D_MODEL,), 0.02),
    }


def reference(x, norm1_w, w_in, ret_norm_w, w_out, norm2_w, w_router, b_router, w1, b1, w2, b2, final_norm_w):
    b, s, d = x.shape
    pos = jnp.arange(s)
    for i in range(DEPTH):
        h = rms_norm(x, norm1_w[i])
        proj = jnp.dot(h, w_in[i])
        rq, rk, rv, rg, mq, mk, mv = jnp.split(proj, SPLITS, axis=-1)
        rq = rotary(rq.reshape(b, s, RET_HEADS, RET_DK), pos, RET_DK, RET_THETA)
        rk = rotary(rk.reshape(b, s, RET_HEADS, RET_DK), pos, RET_DK, RET_THETA)
        ret = retention(rq, rk, rv.reshape(b, s, RET_HEADS, RET_DV))
        mu = jnp.mean(ret, axis=-1, keepdims=True)
        var = jnp.mean(jnp.square(ret - mu), axis=-1, keepdims=True)
        ret = ((ret - mu) * lax.rsqrt(var + GN_EPS)).reshape(b, s, RET_V_W) * ret_norm_w[i].astype(jnp.float32)
        ret = (jax.nn.silu(rg.astype(jnp.float32)) * ret).astype(x.dtype)
        mq = rotary(mq.reshape(b, s, MOBA_HEADS, MOBA_DH), pos, ROPE_DIM, ROPE_THETA).transpose(0, 2, 1, 3)
        mk = rotary(mk.reshape(b, s, MOBA_HEADS, MOBA_DH), pos, ROPE_DIM, ROPE_THETA).transpose(0, 2, 1, 3)
        mv = mv.reshape(b, s, MOBA_HEADS, MOBA_DH).transpose(0, 2, 1, 3)
        moba = moba_attention(mq, mk, mv).transpose(0, 2, 1, 3).reshape(b, s, MOBA_W).astype(x.dtype)
        x = x + jnp.dot(jnp.concatenate([ret, moba], axis=-1), w_out[i])
        h2 = rms_norm(x, norm2_w[i]).reshape(b * s, d)
        x = x + moe_ffn(h2, w_router[i], b_router[i], w1[i], b1[i], w2[i], b2[i]).reshape(b, s, d)
    return rms_norm(x, final_norm_w)
```

```cpp
#include <hip/hip_runtime.h>
#include <hip/hip_bf16.h>
#include <cstdio>
#include <cstdint>
#include <cmath>

#ifndef MK_N_LAUNCHES
#define MK_N_LAUNCHES 8
#endif

#define LAS __attribute__((address_space(3)))
#define GAS __attribute__((address_space(1)))
typedef unsigned short bf16_t;
typedef short bf16x8 __attribute__((ext_vector_type(8)));
typedef short s16x4 __attribute__((ext_vector_type(4)));
typedef float f32x4 __attribute__((ext_vector_type(4)));
typedef float f32x2 __attribute__((ext_vector_type(2)));
typedef float f32x16 __attribute__((ext_vector_type(16)));
typedef unsigned u32x4 __attribute__((ext_vector_type(4)));
typedef unsigned u32x2 __attribute__((ext_vector_type(2)));
typedef GAS unsigned gu32;

constexpr int NB = 32, SEQ = 2048, DM = 1024, NTOK = NB * SEQ;
constexpr int DIN = 3072;
constexpr int NEXP = 32, TOPK = 4, NPAIR = NTOK * TOPK;
constexpr float RMS_EPS = 1e-5f, GN_EPS = 1e-6f;
constexpr float QC2 = 0.125f * 1.4426950408889634f;
constexpr int PC_RQ = 0, PC_RK = 256, PC_RV = 512, PC_RG = 1024, PC_MQ = 1536, PC_MK = 2048, PC_MV = 2560;

constexpr size_t MiB = 1u << 20;
constexpr size_t WS_CTL = 0, CTL_ZERO_BYTES = 1 * MiB;
constexpr size_t WS_ROPE = 1 * MiB;
constexpr size_t WS_KSUM = 2 * MiB;
constexpr size_t WS_RSTD = 3 * MiB;
constexpr size_t WS_WRF = 3 * MiB + 512 * 1024;
constexpr size_t WS_GATE = 4 * MiB;
constexpr size_t WS_SLOT = 5 * MiB;
constexpr size_t WS_WIN = 16 * MiB, WS_WOUT = 22 * MiB, WS_W2 = 24 * MiB;
constexpr size_t WS_PROJ = 88 * MiB, WS_MIX = 472 * MiB, WS_ACT = 88 * MiB;
constexpr size_t WS_W1 = 600 * MiB, WS_XN = 728 * MiB, WS_Y3 = 600 * MiB;
constexpr size_t WS_END = 984 * MiB;
constexpr int CW_TMO = 0, CW_CODE = 1, CW_BAR = 4096, CW_QUEUE = 40000, CW_GCNT = 40960;

constexpr int RING_BYTES = 131072;
constexpr int LDSCTL_OFF = RING_BYTES, MISC_OFF = LDSCTL_OFF + 320, LTAB_OFF = LDSCTL_OFF + 512;
constexpr int LDS_BYTES = 147456;
constexpr int NWAVES = 8;

#define RLX_AGENT __ATOMIC_RELAXED, __HIP_MEMORY_SCOPE_AGENT
#define LDS_WAIT() asm volatile("s_waitcnt lgkmcnt(0)" ::: "memory")
#define VM_WAIT() asm volatile("s_waitcnt vmcnt(0)" ::: "memory")

__device__ __forceinline__ unsigned f2bf(float f) { unsigned u = __builtin_bit_cast(unsigned, f); return (u + 0x7fffu + ((u >> 16) & 1u)) >> 16; }
__device__ __forceinline__ unsigned pk2(float lo, float hi) { return f2bf(lo) | (f2bf(hi) << 16); }
__device__ __forceinline__ float bf2f(unsigned short b) { return __builtin_bit_cast(float, (unsigned)b << 16); }
__device__ __forceinline__ unsigned cvt_pk_bf16(float lo, float hi) { unsigned r; asm volatile("v_cvt_pk_bf16_f32 %0, %1, %2" : "=v"(r) : "v"(lo), "v"(hi)); return r; }
__device__ __forceinline__ u32x4 pack8(f32x4 a, f32x4 b) { u32x4 w; w.x = cvt_pk_bf16(a[0], a[1]); w.y = cvt_pk_bf16(a[2], a[3]); w.z = cvt_pk_bf16(b[0], b[1]); w.w = cvt_pk_bf16(b[2], b[3]); return w; }

namespace pg8 {
constexpr int BM = 256, BK = 64, HALF = 128, HTB = HALF * BK * 2, STAGE_BYTES = 8 * HTB, NXCD = 8, WGM = 8;
constexpr int KD = 1024;
__device__ __forceinline__ int lds_byte(int r, int c) { const int st = (r >> 4) * 2 + (c >> 5), rr = r & 15, cc = c & 31, ob = rr * 64 + cc * 2; return st * 1024 + (ob ^ (((ob >> 9) & 1) << 5)); }
__device__ __forceinline__ void stage_rc(int b, int& R, int& C) { const int st = b / 1024, sb = b % 1024, swz = sb ^ (((sb >> 9) & 1) << 5); R = (st >> 1) * 16 + swz / 64; C = (st & 1) * 32 + (swz % 64) / 2; }
__device__ __forceinline__ int perm32(int rho) { const int n = rho >> 4, i = rho & 15; return 8 * (i >> 2) + 4 * n + (i & 3); }

struct Unit { int pm, pn, e, row0, nrows, arow; };

__device__ __forceinline__ bool tile_order(int i, int G, int c, int nM, int nN, int& pm, int& pn) {
    const int nwg = nM * nN; const long L = (long)i * G + c; if (L >= nwg) return false;
    int wgid = (int)L; { const int q = nwg / NXCD, r = nwg % NXCD, xcd = wgid % NXCD, off = wgid / NXCD; wgid = (xcd < r ? xcd * (q + 1) : r * (q + 1) + (xcd - r) * q) + off; }
    const int nig = WGM * nN, gid = wgid / nig, fm = gid * WGM, gsz = (nM - fm) < WGM ? (nM - fm) : WGM;
    pm = fm + ((wgid % nig) % gsz); pn = (wgid % nig) / gsz; return true;
}

template <class P, bool ALIGN_EPI>
__device__ __forceinline__ void gemm_phase(LAS unsigned char* lds, const P& S) {
    const int tid = threadIdx.x, wid = __builtin_amdgcn_readfirstlane(tid >> 6), lane = tid & 63, wr = wid >> 2, wc = wid & 3, fr = lane & 15, fq = lane >> 4;
    constexpr int K = KD, nt = K / BK;
    unsigned voffB[2]; int RA[2], CA[2];
#pragma unroll
    for (int i = 0; i < 2; ++i) { int R, C; stage_rc(tid * 16 + i * 8192, R, C); const int Rb = P::PERM ? ((R & ~31) + perm32(R & 31)) : R;
        voffB[i] = (unsigned)(Rb * K + C) * 2u; RA[i] = R; CA[i] = C; }
    const size_t kstep = (size_t)(BK * 2);
    const size_t hstep = (size_t)HALF * K * 2;
    const unsigned ldsw = (unsigned)wid * 1024u;
    const int aoff = lds_byte(wr * 64 + fr, fq * 8), boff = lds_byte(wc * 32 + fr, fq * 8);
#define PG8_SA(b, h) (((b) * 2 + (h)) * HTB)
#define PG8_SB(b, h) ((4 + (b) * 2 + (h)) * HTB)
#define PG8_STAGE(bufoff, gbase, voff) do { _Pragma("unroll") for (int _i = 0; _i < 2; ++_i) \
        __builtin_amdgcn_global_load_lds((const unsigned*)((const char*)(gbase) + (voff)[_i]), (LAS unsigned*)(lds + (bufoff) + ldsw + _i * 8192), 16, 0, 0); } while (0)
#define PG8_LDA(dst, b, h) do { _Pragma("unroll") for (int m = 0; m < 4; ++m) _Pragma("unroll") for (int k = 0; k < 2; ++k) dst[m][k] = *(const LAS bf16x8*)(lds + PG8_SA(b, h) + aoff + m * 2048 + k * 1024); } while (0)
#define PG8_LDB(dst, b, h) do { _Pragma("unroll") for (int n = 0; n < 2; ++n) _Pragma("unroll") for (int k = 0; k < 2; ++k) dst[n][k] = *(const LAS bf16x8*)(lds + PG8_SB(b, h) + boff + n * 2048 + k * 1024); } while (0)
#define PG8_MMA(ai, bj, At, Bt) do { __builtin_amdgcn_s_setprio(1); _Pragma("unroll") for (int m = 0; m < 4; ++m) _Pragma("unroll") for (int n = 0; n < 2; ++n) _Pragma("unroll") for (int k = 0; k < 2; ++k) \
        acc[ai][bj][m][n] = __builtin_amdgcn_mfma_f32_16x16x32_bf16(Bt[n][k], At[m][k], acc[ai][bj][m][n], 0, 0, 0); __builtin_amdgcn_s_setprio(0); } while (0)
#define PG8_WAIT_V(n) asm volatile("s_waitcnt vmcnt(" #n ")" ::: "memory")
#define PG8_WAIT_L(n) asm volatile("s_waitcnt lgkmcnt(" #n ")" ::: "memory")
#define PG8_BAR __builtin_amdgcn_s_barrier()
#define PG8_SCHED __builtin_amdgcn_sched_barrier(0)
    Unit cur, nxt; int ui = 0;
    if (!S.next(0, cur)) return;
    f32x4 acc[2][2][4][2];
#pragma unroll
    for (int a = 0; a < 2; ++a)
#pragma unroll
        for (int b = 0; b < 2; ++b)
#pragma unroll
            for (int m = 0; m < 4; ++m)
#pragma unroll
                for (int n = 0; n < 2; ++n) acc[a][b][m][n] = (f32x4){0.f, 0.f, 0.f, 0.f};
    bf16x8 At[4][2], B0[2][2], B1[2][2];
    unsigned vC[2][2], vN[2][2];
    S.a_voff(cur, RA, CA, vC);
    const char* cA = S.a_ptr(cur); const char* cB = S.b_ptr(cur);
    PG8_STAGE(PG8_SB(0, 0), cB, voffB); PG8_STAGE(PG8_SB(0, 1), cB + hstep, voffB); PG8_STAGE(PG8_SA(0, 0), cA, vC[0]); PG8_STAGE(PG8_SA(0, 1), cA, vC[1]);
    if (wr == 1) PG8_BAR;
    PG8_WAIT_V(2); PG8_BAR;
    PG8_STAGE(PG8_SB(1, 0), cB + kstep, voffB); PG8_STAGE(PG8_SA(1, 0), cA + kstep, vC[0]); PG8_STAGE(PG8_SB(1, 1), cB + hstep + kstep, voffB);
    PG8_WAIT_V(6); PG8_BAR;
    for (;;) {
        const bool has_next = S.next(ui + 1, nxt);
        const char* nA = cA; const char* nB = cB;
#pragma unroll
        for (int h = 0; h < 2; ++h)
#pragma unroll
            for (int i = 0; i < 2; ++i) vN[h][i] = vC[h][i];
        if (has_next) { nA = S.a_ptr(nxt); nB = S.b_ptr(nxt); S.a_voff(nxt, RA, CA, vN); }
        for (int t = 0; t < nt; t += 2) {
            const bool last = (t == nt - 2);
            const char* a1 = cA + (size_t)(t + 1) * kstep;
            const char* a2 = last ? nA : cA + (size_t)(t + 2) * kstep; const char* b2 = last ? nB : cB + (size_t)(t + 2) * kstep;
            const char* a3 = a2 + kstep; const char* b3 = b2 + kstep;
            unsigned vS[2][2];
#pragma unroll
            for (int h = 0; h < 2; ++h)
#pragma unroll
                for (int i = 0; i < 2; ++i) vS[h][i] = last ? vN[h][i] : vC[h][i];
            PG8_LDB(B0, 0, 0); PG8_LDB(B1, 0, 1); PG8_SCHED; PG8_LDA(At, 0, 0); PG8_STAGE(PG8_SA(1, 1), a1, vC[1]);
            PG8_WAIT_V(8); PG8_WAIT_L(0); PG8_BAR; PG8_MMA(0, 0, At, B0); PG8_MMA(0, 1, At, B1); PG8_BAR; PG8_SCHED;
            PG8_LDA(At, 0, 1); PG8_STAGE(PG8_SB(0, 0), b2, voffB); PG8_STAGE(PG8_SB(0, 1), b2 + hstep, voffB); PG8_STAGE(PG8_SA(0, 0), a2, vS[0]);
            PG8_WAIT_V(8); PG8_WAIT_L(0); PG8_BAR; PG8_MMA(1, 0, At, B0); PG8_MMA(1, 1, At, B1); PG8_BAR; PG8_SCHED;
            PG8_LDB(B0, 1, 0); PG8_LDB(B1, 1, 1); PG8_SCHED; PG8_LDA(At, 1, 0); PG8_STAGE(PG8_SA(0, 1), a2, vS[1]);
            PG8_WAIT_V(8); PG8_WAIT_L(0); PG8_BAR; PG8_MMA(0, 0, At, B0); PG8_MMA(0, 1, At, B1); PG8_BAR; PG8_SCHED;
            PG8_LDA(At, 1, 1); PG8_STAGE(PG8_SB(1, 0), b3, voffB); PG8_STAGE(PG8_SB(1, 1), b3 + hstep, voffB); PG8_STAGE(PG8_SA(1, 0), a3, vS[0]);
            PG8_WAIT_V(8); PG8_WAIT_L(0); PG8_BAR; PG8_MMA(1, 0, At, B0); PG8_MMA(1, 1, At, B1); PG8_BAR; PG8_SCHED;
        }
        if constexpr (ALIGN_EPI) { if (wr == 0) PG8_BAR; }
        S.epi(acc, cur, wr, wc, fr, fq);
        if (!has_next) break;
#pragma unroll
        for (int a = 0; a < 2; ++a)
#pragma unroll
            for (int b = 0; b < 2; ++b)
#pragma unroll
                for (int m = 0; m < 4; ++m)
#pragma unroll
                    for (int n = 0; n < 2; ++n) acc[a][b][m][n] = (f32x4){0.f, 0.f, 0.f, 0.f};
        cur = nxt; cA = nA; cB = nB; ++ui;
#pragma unroll
        for (int h = 0; h < 2; ++h)
#pragma unroll
            for (int i = 0; i < 2; ++i) vC[h][i] = vN[h][i];
        if constexpr (ALIGN_EPI) { if (wr == 1) PG8_BAR; }
    }
    PG8_WAIT_V(0);
    if constexpr (!ALIGN_EPI) { if (wr == 0) PG8_BAR; }
    PG8_BAR;
#undef PG8_SA
#undef PG8_SB
#undef PG8_STAGE
#undef PG8_LDA
#undef PG8_LDB
#undef PG8_MMA
#undef PG8_WAIT_V
#undef PG8_WAIT_L
#undef PG8_BAR
#undef PG8_SCHED
}

struct DenseBase {
    const bf16_t* A; const bf16_t* Bt; int nM, nN, G, c;
    __device__ __forceinline__ bool next(int i, Unit& u) const { int pm, pn; if (!tile_order(i, G, c, nM, nN, pm, pn)) return false; u.pm = pm; u.pn = pn; u.e = 0; u.row0 = 0; u.nrows = 256; u.arow = pm * 256; return true; }
    __device__ __forceinline__ const char* a_ptr(const Unit& u) const { return (const char*)A + (size_t)u.pm * (size_t)(BM * KD * 2); }
    __device__ __forceinline__ const char* b_ptr(const Unit& u) const { return (const char*)Bt + (size_t)u.pn * (size_t)(BM * KD * 2); }
    __device__ __forceinline__ void a_voff(const Unit&, const int (&RA)[2], const int (&CA)[2], unsigned (&v)[2][2]) const {
#pragma unroll
        for (int h = 0; h < 2; ++h)
#pragma unroll
            for (int i = 0; i < 2; ++i) v[h][i] = (unsigned)((RA[i] + HALF * h) * KD + CA[i]) * 2u; }
};

struct ProbInProj : DenseBase {
    static constexpr bool PERM = true;
    bf16_t* PROJ; const float* rc; const float* rs; const float* mc; const float* ms; float* ksum;
    __device__ __forceinline__ void epi(const f32x4 (&acc)[2][2][4][2], const Unit& u, int wr, int wc, int fr, int fq) const {
        const int pn = u.pn; const int rowt = u.pm * BM + wr * 64 + fr;
        if (pn <= 1) {
            const float sc = pn == 0 ? 1.f : 0.125f;
#pragma unroll
            for (int ai = 0; ai < 2; ++ai)
#pragma unroll
                for (int m = 0; m < 4; ++m) { const int row = rowt + ai * HALF + m * 16, s = row & (SEQ - 1);
                    const f32x4 c0 = *(const f32x4*)(rc + s * 32 + 8 * fq), c1 = *(const f32x4*)(rc + s * 32 + 8 * fq + 4);
                    const f32x4 s0 = *(const f32x4*)(rs + s * 32 + 8 * fq), s1 = *(const f32x4*)(rs + s * 32 + 8 * fq + 4);
                    const f32x4 a0 = acc[ai][0][m][0], a1 = acc[ai][0][m][1], b0 = acc[ai][1][m][0], b1 = acc[ai][1][m][1];
                    const f32x4 o10 = (a0 * c0 - b0 * s0) * sc, o11 = (a1 * c1 - b1 * s1) * sc, o20 = (a0 * s0 + b0 * c0) * sc, o21 = (a1 * s1 + b1 * c1) * sc;
                    bf16_t* dst = PROJ + (size_t)row * DIN + pn * 256 + 64 * wc + 8 * fq;
                    *(u32x4*)dst = pack8(o10, o11); *(u32x4*)(dst + 32) = pack8(o20, o21); asm volatile("" ::: "memory"); }
        } else if (pn >= 6 && pn <= 9) {
            const bool rot = ((wc & 1) == 0) && (fq < 2); const float sc = pn < 8 ? QC2 : 1.f; const bool isk = pn >= 8;
            f32x4 ks[2][2];
#pragma unroll
            for (int bj = 0; bj < 2; ++bj)
#pragma unroll
                for (int n = 0; n < 2; ++n) ks[bj][n] = (f32x4){0.f, 0.f, 0.f, 0.f};
#pragma unroll
            for (int ai = 0; ai < 2; ++ai)
#pragma unroll
                for (int m = 0; m < 4; ++m) { const int row = rowt + ai * HALF + m * 16, s = row & (SEQ - 1);
                    f32x4 c = *(const f32x4*)(mc + s * 8 + 4 * (fq & 1)), sn = *(const f32x4*)(ms + s * 8 + 4 * (fq & 1));
                    if (!rot) { c = (f32x4){1.f, 1.f, 1.f, 1.f}; sn = (f32x4){0.f, 0.f, 0.f, 0.f}; }
#pragma unroll
                    for (int bj = 0; bj < 2; ++bj) { const f32x4 v0 = acc[ai][bj][m][0], v1 = acc[ai][bj][m][1];
                        const f32x4 n0 = (v0 * c - v1 * sn) * sc, n1 = (v0 * sn + v1 * c) * sc;
                        if (isk) { ks[bj][0] += n0; ks[bj][1] += n1; asm volatile("" : "+v"(ks[bj][0]), "+v"(ks[bj][1])); }
                        *(u32x4*)(PROJ + (size_t)row * DIN + pn * 256 + bj * HALF + 32 * wc + 8 * fq) = pack8(n0, n1); }
                    asm volatile("" ::: "memory"); }
            if (isk) {
#pragma unroll
                for (int bj = 0; bj < 2; ++bj)
#pragma unroll
                    for (int n = 0; n < 2; ++n)
#pragma unroll
                        for (int e = 0; e < 4; ++e) { float v = ks[bj][n][e]; v += __shfl_xor(v, 1); v += __shfl_xor(v, 2); v += __shfl_xor(v, 4); v += __shfl_xor(v, 8); ks[bj][n][e] = v; }
                if (fr == 0) {
#pragma unroll
                    for (int bj = 0; bj < 2; ++bj)
#pragma unroll
                        for (int n = 0; n < 2; ++n) *(f32x4*)(ksum + ((size_t)u.pm * 2 + wr) * 512 + (pn - 8) * 256 + bj * HALF + 32 * wc + 8 * fq + 4 * n) = ks[bj][n]; }
            }
        } else {
#pragma unroll
            for (int ai = 0; ai < 2; ++ai)
#pragma unroll
                for (int m = 0; m < 4; ++m) { const int row = rowt + ai * HALF + m * 16;
#pragma unroll
                    for (int bj = 0; bj < 2; ++bj) *(u32x4*)(PROJ + (size_t)row * DIN + pn * 256 + bj * HALF + 32 * wc + 8 * fq) = pack8(acc[ai][bj][m][0], acc[ai][bj][m][1]); }
        }
    }
};

struct ProbOutProj : DenseBase {
    static constexpr bool PERM = false;
    const float* x; float* X1;
    __device__ __forceinline__ void epi(const f32x4 (&acc)[2][2][4][2], const Unit& u, int wr, int wc, int fr, int fq) const {
        const int row0 = u.pm * BM + wr * 64 + fr, col0 = u.pn * BM + wc * 32 + 4 * fq;
#pragma unroll
        for (int ai = 0; ai < 2; ++ai)
#pragma unroll
            for (int m = 0; m < 4; ++m) { const size_t off = (size_t)(row0 + ai * HALF + m * 16) * DM + col0;
#pragma unroll
                for (int bj = 0; bj < 2; ++bj)
#pragma unroll
                    for (int n = 0; n < 2; ++n) *(f32x4*)(X1 + off + bj * HALF + n * 16) = *(const f32x4*)(x + off + bj * HALF + n * 16) + acc[ai][bj][m][n]; }
    }
};

struct MoeBase {
    int T, NP, G, c; const LAS int* tpre; const LAS int* cpre;
    __device__ __forceinline__ bool next(int i, Unit& u) const {
        int pm, pn; if (!tile_order(i, G, c, T, NP, pm, pn)) return false;
        int e = 0;
#pragma unroll 1
        for (; e < NEXP - 1; ++e) { if (pm < __builtin_amdgcn_readfirstlane(tpre[e + 1])) break; }
        const int t0 = __builtin_amdgcn_readfirstlane(tpre[e]), c0 = __builtin_amdgcn_readfirstlane(cpre[e]), c1 = __builtin_amdgcn_readfirstlane(cpre[e + 1]);
        u.pm = pm; u.pn = pn; u.e = e; u.row0 = (pm - t0) * 256; const int rem = (c1 - c0) - u.row0; u.nrows = rem < 256 ? rem : 256; u.arow = c0 + u.row0; return true;
    }
};
struct ProbMoe1 : MoeBase {
    static constexpr bool PERM = true;
    const bf16_t* H2; const bf16_t* W1T; const int* slot; const float* rstd; const float* b1; bf16_t* ACT;
    __device__ __forceinline__ const char* a_ptr(const Unit&) const { return (const char*)H2; }
    __device__ __forceinline__ const char* b_ptr(const Unit& u) const { return (const char*)W1T + ((size_t)u.e * 2048 + (size_t)u.pn * 256) * (size_t)(KD * 2); }
    __device__ __forceinline__ void a_voff(const Unit& u, const int (&RA)[2], const int (&CA)[2], unsigned (&v)[2][2]) const {
#pragma unroll
        for (int h = 0; h < 2; ++h)
#pragma unroll
            for (int i = 0; i < 2; ++i) { int r = RA[i] + HALF * h; r = r < u.nrows ? r : u.nrows - 1; const int pair = slot[(size_t)u.e * NTOK + u.row0 + r]; v[h][i] = (unsigned)(pair >> 2) * (unsigned)(KD * 2) + (unsigned)CA[i] * 2u; } }
    __device__ __forceinline__ void epi(const f32x4 (&acc)[2][2][4][2], const Unit& u, int wr, int wc, int fr, int fq) const {
        const int cc0 = 32 * wc + 8 * fq; const float* bb = b1 + (size_t)u.e * 2048 + 128 * u.pn + cc0;
        const f32x4 bg0 = *(const f32x4*)bb, bg1 = *(const f32x4*)(bb + 4), bl0 = *(const f32x4*)(bb + 1024), bl1 = *(const f32x4*)(bb + 1028);
#pragma unroll
        for (int ai = 0; ai < 2; ++ai)
#pragma unroll
            for (int m = 0; m < 4; ++m) { const int r = ai * HALF + wr * 64 + m * 16 + fr; const bool valid = r < u.nrows; const int rr = valid ? r : u.nrows - 1;
                const int pair = slot[(size_t)u.e * NTOK + u.row0 + rr]; const float rs = rstd[pair >> 2];
                f32x4 o[2];
#pragma unroll
                for (int n = 0; n < 2; ++n) { f32x4 g = acc[ai][0][m][n] * rs + (n ? bg1 : bg0), l = acc[ai][1][m][n] * rs + (n ? bl1 : bl0);
#pragma unroll
                    for (int e = 0; e < 4; ++e) { const float gg = fminf(g[e], 7.f), ll = fminf(fmaxf(l[e], -7.f), 7.f);
                        const float sg = __builtin_amdgcn_rcpf(1.f + __builtin_amdgcn_exp2f(gg * (-1.702f * 1.4426950408889634f))); o[n][e] = gg * sg * (ll + 1.f); } }
                if (valid) *(u32x4*)(ACT + (size_t)(u.arow + r) * DM + 128 * u.pn + cc0) = pack8(o[0], o[1]); }
    }
};
struct ProbMoe2 : MoeBase {
    static constexpr bool PERM = true;
    const bf16_t* ACT; const bf16_t* W2T; const int* slot; const float* gate; const float* b2; float* X1; bf16_t* Y3;
    __device__ __forceinline__ const char* a_ptr(const Unit& u) const { return (const char*)ACT + (size_t)u.arow * (size_t)(KD * 2); }
    __device__ __forceinline__ const char* b_ptr(const Unit& u) const { return (const char*)W2T + ((size_t)u.e * 1024 + (size_t)u.pn * 256) * (size_t)(KD * 2); }
    __device__ __forceinline__ void a_voff(const Unit& u, const int (&RA)[2], const int (&CA)[2], unsigned (&v)[2][2]) const {
#pragma unroll
        for (int h = 0; h < 2; ++h)
#pragma unroll
            for (int i = 0; i < 2; ++i) { int r = RA[i] + HALF * h; r = r < u.nrows ? r : u.nrows - 1; v[h][i] = (unsigned)(r * KD + CA[i]) * 2u; } }
    __device__ __forceinline__ void epi(const f32x4 (&acc)[2][2][4][2], const Unit& u, int wr, int wc, int fr, int fq) const {
        const int col0 = u.pn * BM + 32 * wc + 8 * fq; const float* bb = b2 + (size_t)u.e * 1024 + col0;
        f32x4 bv[2][2];
#pragma unroll
        for (int bj = 0; bj < 2; ++bj)
#pragma unroll
            for (int n = 0; n < 2; ++n) bv[bj][n] = *(const f32x4*)(bb + bj * HALF + 4 * n);
#pragma unroll
        for (int ai = 0; ai < 2; ++ai)
#pragma unroll
            for (int m = 0; m < 4; ++m) { const int r = ai * HALF + wr * 64 + m * 16 + fr; const bool valid = r < u.nrows; const int rr = valid ? r : u.nrows - 1;
                const int pair = slot[(size_t)u.e * NTOK + u.row0 + rr]; const float gt = gate[pair]; const int tok = pair >> 2, k = pair & 3;
                if (valid) {
                    if (k == 0) { float* p = X1 + (size_t)tok * DM + col0;
#pragma unroll
                        for (int bj = 0; bj < 2; ++bj)
#pragma unroll
                            for (int n = 0; n < 2; ++n) { f32x4* q = (f32x4*)(p + bj * HALF + 4 * n); *q = *q + (acc[ai][bj][m][n] + bv[bj][n]) * gt; } }
                    else { bf16_t* p = Y3 + ((size_t)tok * 3 + (k - 1)) * DM + col0;
#pragma unroll
                        for (int bj = 0; bj < 2; ++bj) *(u32x4*)(p + bj * HALF) = pack8((acc[ai][bj][m][0] + bv[bj][0]) * gt, (acc[ai][bj][m][1] + bv[bj][1]) * gt); }
                } }
    }
};
}

namespace moba {
using bf16 = __hip_bfloat16;
constexpr int D = 64, PP = DIN, OP = DM;
constexpr int NW = 8, QBLK = 32, QB = QBLK * NW, KVBLK = 64;
__device__ __forceinline__ int crow(int r, int hi) { return (r & 3) + 8 * (r >> 2) + 4 * hi; }
#define SBAR() __builtin_amdgcn_sched_barrier(0)
__device__ __forceinline__ void cmask(f32x16& p0, f32x16& p1, int jb, int qrel, int hi) {
  const float NEG = -INFINITY; int kb = 64 * jb + 4 * hi;
  #pragma unroll
  for (int r = 0; r < 16; ++r) { int kv = kb + (r & 3) + 8 * (r >> 2); if (kv > qrel) p0[r] = NEG; if (kv + 32 > qrel) p1[r] = NEG; }
}
constexpr int NSLOT = 3, SLOTB = 8192;
constexpr int LDS_K = 0, LDS_V = NSLOT * SLOTB, LDS_WS = 2 * NSLOT * SLOTB, LDS_OST = LDS_WS + NW * 64 * 4, LDS_BYTES_A = LDS_OST + NW * 4096;
__device__ __forceinline__ void glds16s(const void* sbase, unsigned voff, unsigned lds_dst) { unsigned keep;
  asm volatile("s_mov_b32 %0, m0\n\ts_mov_b32 m0, %3\n\ts_nop 4\n\tglobal_load_lds_dwordx4 %1, %2\n\ts_mov_b32 m0, %0" : "=&s"(keep) : "v"(voff), "s"(sbase), "s"(lds_dst) : "memory"); }
__device__ __forceinline__ float max3f(float a, float b, float c) { float r; asm("v_max3_f32 %0, %1, %2, %3" : "=v"(r) : "v"(a), "v"(b), "v"(c)); return r; }
__device__ __forceinline__ float max2f(float a, float b) { float r; asm("v_max_f32_e32 %0, %1, %2" : "=v"(r) : "v"(a), "v"(b)); return r; }
__device__ __forceinline__ float fadd_s(float a, float b) { float r; asm("v_add_f32_e32 %0, %1, %2" : "=v"(r) : "v"(a), "v"(b)); return r; }
__device__ __forceinline__ float fsub_s(float a, float b) { float r; asm("v_sub_f32_e32 %0, %1, %2" : "=v"(r) : "v"(a), "v"(b)); return r; }
typedef __bf16 bf16x2_t __attribute__((ext_vector_type(2)));
__device__ __forceinline__ unsigned cvtpk_s(float lo, float hi) { f32x2 v = {lo, hi}; bf16x2_t b = __builtin_convertvector(v, bf16x2_t); return __builtin_bit_cast(unsigned, b); }
#define WAIT_BAR(N) asm volatile("s_waitcnt vmcnt(" #N ") lgkmcnt(0)\n\ts_barrier" ::: "memory")
__device__ __forceinline__ void qkt(f32x16& p0, f32x16& p1, const char* Kslot, const bf16x8* qr, const f32x16& negm, int r32, int hi) {
  const char* kb = Kslot + hi * 1024 + r32 * 16;
  #pragma unroll
  for (int d0 = 0; d0 < 4; ++d0) {
    const bf16x8 b0 = *reinterpret_cast<const bf16x8*>(kb + d0 * 2048);
    const bf16x8 b1 = *reinterpret_cast<const bf16x8*>(kb + d0 * 2048 + 512);
    if (d0 == 0) { p0 = __builtin_amdgcn_mfma_f32_32x32x16_bf16(b0, qr[0], negm, 0, 0, 0); p1 = __builtin_amdgcn_mfma_f32_32x32x16_bf16(b1, qr[0], negm, 0, 0, 0); }
    else { p0 = __builtin_amdgcn_mfma_f32_32x32x16_bf16(b0, qr[d0], p0, 0, 0, 0); p1 = __builtin_amdgcn_mfma_f32_32x32x16_bf16(b1, qr[d0], p1, 0, 0, 0); } }
}
typedef LAS const char* lds_cptr;
typedef short v4i16_t __attribute__((ext_vector_type(4)));
__device__ __forceinline__ void kload8(bf16x8* kf, lds_cptr kp) {
  kf[0] = *(const LAS bf16x8*)(kp);        kf[1] = *(const LAS bf16x8*)(kp + 512);
  kf[2] = *(const LAS bf16x8*)(kp + 2048); kf[3] = *(const LAS bf16x8*)(kp + 2560);
  kf[4] = *(const LAS bf16x8*)(kp + 4096); kf[5] = *(const LAS bf16x8*)(kp + 4608);
  kf[6] = *(const LAS bf16x8*)(kp + 6144); kf[7] = *(const LAS bf16x8*)(kp + 6656);
}
__device__ __forceinline__ void kload2(bf16x8* kf, lds_cptr kp, int j) { kf[2 * j] = *(const LAS bf16x8*)(kp + j * 2048); kf[2 * j + 1] = *(const LAS bf16x8*)(kp + j * 2048 + 512); }
__device__ __forceinline__ s16x4 vtr(lds_cptr p) { return __builtin_bit_cast(s16x4, __builtin_amdgcn_ds_read_tr16_b64_v4i16((LAS v4i16_t*)p)); }
__device__ __forceinline__ float rowmax(const f32x16& p0, const f32x16& p1) {
  float a = max3f(p0[0], p0[1], p1[0]), b = max3f(p0[2], p0[3], p1[1]); a = max3f(a, p1[2], p1[3]);
  #pragma unroll
  for (int r = 4; r < 16; r += 4) { a = max3f(a, p0[r], p0[r + 1]); b = max3f(b, p0[r + 2], p0[r + 3]); a = max3f(a, p1[r], p1[r + 1]); b = max3f(b, p1[r + 2], p1[r + 3]); }
  const float m = max2f(a, b);
  auto rr = __builtin_amdgcn_permlane32_swap(__float_as_uint(m), __float_as_uint(m), false, false);
  return max2f(__uint_as_float(rr[0]), __uint_as_float(rr[1]));
}
__device__ __forceinline__ void pv(f32x16* o, int vb, bf16x8 pa0, bf16x8 pa1, bf16x8 pa2, bf16x8 pa3) {
  #pragma unroll
  for (int d0 = 0; d0 < 2; ++d0) { s16x4 lo[4], hi[4];
    #pragma unroll
    for (int ks = 0; ks < 4; ++ks) {
      asm volatile("ds_read_b64_tr_b16 %0,%1 offset:%c2" : "=&v"(lo[ks]) : "v"(vb), "i"(d0 * 4096 + ks * 1024) : "memory");
      asm volatile("ds_read_b64_tr_b16 %0,%1 offset:%c2" : "=&v"(hi[ks]) : "v"(vb), "i"(d0 * 4096 + ks * 1024 + 512) : "memory"); }
    asm volatile("s_waitcnt lgkmcnt(0)" ::: "memory"); SBAR();
    #define PK(k) (bf16x8){lo[k][0], lo[k][1], lo[k][2], lo[k][3], hi[k][0], hi[k][1], hi[k][2], hi[k][3]}
    o[d0] = __builtin_amdgcn_mfma_f32_32x32x16_bf16(pa0, PK(0), o[d0], 0, 0, 0);
    o[d0] = __builtin_amdgcn_mfma_f32_32x32x16_bf16(pa1, PK(1), o[d0], 0, 0, 0);
    o[d0] = __builtin_amdgcn_mfma_f32_32x32x16_bf16(pa2, PK(2), o[d0], 0, 0, 0);
    o[d0] = __builtin_amdgcn_mfma_f32_32x32x16_bf16(pa3, PK(3), o[d0], 0, 0, 0);
    #undef PK
  }
}

template <int THRL> __device__ __forceinline__ void moba_unit(int b, int h, int qb, const bf16* PROJ, const float* ksum, bf16* MIX, char* shm) {
  int tid_ = threadIdx.x; asm volatile("" : "+v"(tid_));
  const int tid = tid_, lane = tid & 63, r32 = lane & 31, hi = lane >> 5; const int wid = __builtin_amdgcn_readfirstlane(tid >> 6);
  const long rowbase = (long)b * SEQ; const int q0 = qb * QB;
  const bf16* Qw = PROJ + (rowbase + q0 + wid * QBLK) * PP + PC_MQ + h * D;
  const bf16* Kh = PROJ + rowbase * PP + PC_MK + h * D, *Vh = PROJ + rowbase * PP + PC_MV + h * D;
  const unsigned lds0 = (unsigned)(uintptr_t)shm;
  float* wsf = (float*)(shm + LDS_WS) + wid * 64;
  const unsigned kvo = (unsigned)(lane * PP + wid * 8) * 2u;
  const unsigned vvo = (unsigned)((16 * (wid & 3) + (lane >> 2)) * PP + (wid >> 2) * 32 + (lane & 3) * 8) * 2u;
  const unsigned kdst = lds0 + LDS_K + wid * 1024, vdst = lds0 + LDS_V + wid * 1024;
  const int tb4 = 4 * qb;
  #define TM(t) (((t) < 4) ? (tb4 + (t)) : ((t) - 4))
  #define DMA_K(t, slot) glds16s(Kh + (long)TM(t) * KVBLK * PP, kvo, (unsigned)__builtin_amdgcn_readfirstlane(kdst + (slot)))
  #define DMA_V(t, slot) glds16s(Vh + (long)TM(t) * KVBLK * PP, vvo, (unsigned)__builtin_amdgcn_readfirstlane(vdst + (slot)))
  const int vb0 = (int)(lds0 + LDS_V) + ((lane >> 4) & 1) * 32 + (lane & 3) * 8 + (4 * hi + ((lane & 15) >> 2)) * 64;
  const char* Kbase = shm + LDS_K; bf16x8 kf[8];
  const lds_cptr shm3 = (lds_cptr)shm; const lds_cptr kp0 = shm3 + LDS_K + hi * 1024 + r32 * 16; const lds_cptr vp0 = shm3 + LDS_V + ((lane >> 4) & 1) * 32 + (lane & 3) * 8 + (4 * hi + ((lane & 15) >> 2)) * 64;
  const int NT = tb4 + 4;
  DMA_K(0, 0); DMA_V(0, 0); DMA_K(1, SLOTB);
  bf16x8 qr[4];
  #pragma unroll
  for (int d0 = 0; d0 < 4; ++d0) qr[d0] = *reinterpret_cast<const bf16x8*>(&Qw[(long)r32 * PP + d0 * 16 + hi * 8]);
  unsigned sel = (1u << qb) - 1u;
  if (qb > 3) {
    float v1 = -INFINITY, v2 = -INFINITY, v3 = -INFINITY; int i1 = 0, i2 = 0, i3 = 0;
    #pragma unroll 1
    for (int j = 0; j < qb; ++j) {
      const float* k0 = ksum + ((size_t)(b * 8 + j) * 2) * 512 + h * D + hi * 8; float p = 0.f;
      #pragma unroll
      for (int d0 = 0; d0 < 4; ++d0) { const f32x4 a0 = *(const f32x4*)(k0 + 16 * d0) + *(const f32x4*)(k0 + 512 + 16 * d0), a1 = *(const f32x4*)(k0 + 16 * d0 + 4) + *(const f32x4*)(k0 + 512 + 16 * d0 + 4);
        #pragma unroll
        for (int i = 0; i < 4; ++i) { p += bf2f((unsigned short)qr[d0][i]) * a0[i]; p += bf2f((unsigned short)qr[d0][4 + i]) * a1[i]; } }
      p += __shfl_xor(p, 32);
      if (p > v1) { v3 = v2; i3 = i2; v2 = v1; i2 = i1; v1 = p; i1 = j; } else if (p > v2) { v3 = v2; i3 = i2; v2 = p; i2 = j; } else if (p > v3) { v3 = p; i3 = j; }
    }
    sel = (1u << i1) | (1u << i2) | (1u << i3);
  }
  float mhat = 0.f, l_reg = 0.f; f32x16 o[2]; o[0] = f32x16{}; o[1] = f32x16{}; const f32x16 zero16 = f32x16{};
  const int qrel = wid * QBLK + r32;
  #define CMASK(P0, P1, t) do { if ((t) < 4) cmask(P0, P1, (t), qrel, hi); } while (0)
  #define NVAL(t) (((t) >= 4 && !((sel >> (((t) - 4) >> 2)) & 1u)) ? -INFINITY : -mhat)
  bool resc = false;
  #define START(P0, P1) do { const float rm = rowmax(P0, P1); resc = false; \
    { const float dl = rm; mhat = fadd_s(mhat, dl); \
      _Pragma("unroll") for (int r = 0; r < 16; ++r) { P0[r] = fsub_s(P0[r], dl); P1[r] = fsub_s(P1[r], dl); } } \
    _Pragma("unroll") for (int r = 0; r < 16; ++r) P0[r] = __builtin_amdgcn_exp2f(P0[r]); } while (0)
  #define RESC() do { if (resc) { asm volatile("s_waitcnt lgkmcnt(0)" ::: "memory"); \
      _Pragma("unroll") for (int d_ = 0; d_ < 2; ++d_) _Pragma("unroll") for (int r = 0; r < 16; ++r) o[d_][r] *= wsf[crow(r, hi)]; } } while (0)
  f32x16 pA0, pA1, pB0, pB1;
  int sl_prev = 0, sl_cur = 0, sl_next = SLOTB;
  #define ROT() do { sl_prev = sl_cur; sl_cur = sl_next; sl_next = (sl_next == (NSLOT - 1) * SLOTB) ? 0 : sl_next + SLOTB; } while (0)
  DMA_K(2, 2 * SLOTB);
  WAIT_BAR(3);
  qkt(pA0, pA1, Kbase, qr, zero16, r32, hi); asm volatile("s_nop 15\n\ts_nop 7" : "+v"(pA0), "+v"(pA1)); CMASK(pA0, pA1, 0);
  START(pA0, pA1);
  _Pragma("unroll") for (int r = 0; r < 16; ++r) pA1[r] = __builtin_amdgcn_exp2f(pA1[r]);
  WAIT_BAR(0);
  DMA_K(3, 0); DMA_V(1, SLOTB);
  ROT();
  kload8(kf, kp0 + sl_cur);
  WAIT_BAR(2);
  s16x4 vlo[8], vhi[8]; u32x4 pw0, pw1, pw2, pw3;
  #define PKW(P, B) cvtpk_s(P[B], P[B + 1])
  #define PAF(k) __builtin_bit_cast(bf16x8, pw##k)
  #define VFR(i) (bf16x8){vlo[i][0], vlo[i][1], vlo[i][2], vlo[i][3], vhi[i][0], vhi[i][1], vhi[i][2], vhi[i][3]}
  #define PIN(x) asm volatile("" : "+v"(x))
  #define MX3(a, b, c) __builtin_fmaxf(__builtin_fmaxf((a), (b)), (c))
  #define GAPA(MF, A0, A1, A2, A3, W0, W1, PW) do { MF; sacc += A0; sacc += A1; sacc += A2; sacc += A3; PIN(sacc); W0; W1; PIN(PW); SBAR(); } while (0)
  #define EX(v) __builtin_amdgcn_exp2f(v)
  #define GAPB(MF, X, B) do { MF; X[B] = EX(X[B]); X[B + 1] = EX(X[B + 1]); X[B + 2] = EX(X[B + 2]); X[B + 3] = EX(X[B + 3]); PIN(X); SBAR(); } while (0)
  #define VRD(i) do { vlo[i] = vtr(vp_ + (((i) >> 2) * 4096 + ((i) & 3) * 1024)); vhi[i] = vtr(vp_ + (((i) >> 2) * 4096 + ((i) & 3) * 1024 + 512)); } while (0)
  #define KRD(G, j) do { if (G) { kload2(kf, kp0 + sl_next, j); SBAR(); } } while (0)
  #define STEP(C0, C1, P0, P1, t, GK, GV, GL) do { const float nv_ = NVAL(t); SBAR(); \
    const lds_cptr vp_ = vp0 + sl_prev; \
    VRD(0); SBAR(); float sacc = (P0[0] + P0[1]); \
    GAPA(C0 = __builtin_amdgcn_mfma_f32_32x32x16_bf16(kf[0], qr[0], zero16, 0, 0, 0), P0[2], P0[3], P0[4], P0[5],     pw0[0] = PKW(P0, 0), pw0[1] = PKW(P0, 2), pw0); \
    VRD(4); SBAR(); GAPA(C1 = __builtin_amdgcn_mfma_f32_32x32x16_bf16(kf[1], qr[0], zero16, 0, 0, 0), P0[6], P0[7], P0[8], P0[9],     pw0[2] = PKW(P0, 4), pw0[3] = PKW(P0, 6), pw0); \
    VRD(1); SBAR(); GAPA(C0 = __builtin_amdgcn_mfma_f32_32x32x16_bf16(kf[2], qr[1], C0, 0, 0, 0),   P0[10], P0[11], P0[12], P0[13], pw1[0] = PKW(P0, 8), pw1[1] = PKW(P0, 10), pw1); \
    VRD(5); SBAR(); GAPA(C1 = __builtin_amdgcn_mfma_f32_32x32x16_bf16(kf[3], qr[1], C1, 0, 0, 0),   P0[14], P0[15], P1[0], P1[1],   pw1[2] = PKW(P0, 12), pw1[3] = PKW(P0, 14), pw1); \
    VRD(2); SBAR(); GAPA(C0 = __builtin_amdgcn_mfma_f32_32x32x16_bf16(kf[4], qr[2], C0, 0, 0, 0),   P1[2], P1[3], P1[4], P1[5],     pw2[0] = PKW(P1, 0), pw2[1] = PKW(P1, 2), pw2); \
    VRD(6); SBAR(); GAPA(C1 = __builtin_amdgcn_mfma_f32_32x32x16_bf16(kf[5], qr[2], C1, 0, 0, 0),   P1[6], P1[7], P1[8], P1[9],     pw2[2] = PKW(P1, 4), pw2[3] = PKW(P1, 6), pw2); \
    VRD(3); SBAR(); GAPA(C0 = __builtin_amdgcn_mfma_f32_32x32x16_bf16(kf[6], qr[3], C0, 0, 0, 0),   P1[10], P1[11], P1[12], P1[13], pw3[0] = PKW(P1, 8), pw3[1] = PKW(P1, 10), pw3); \
    VRD(7); SBAR(); GAPA(C1 = __builtin_amdgcn_mfma_f32_32x32x16_bf16(kf[7], qr[3], C1, 0, 0, 0),   P1[14], P1[15], 0.f, 0.f,       pw3[2] = PKW(P1, 12), pw3[3] = PKW(P1, 14), pw3); \
    l_reg += sacc; \
    if (GK) { DMA_K((t) + 3, sl_cur); } if (GV) { DMA_V((t) + 1, sl_next); } \
    _Pragma("unroll") for (int r = 0; r < 16; ++r) { C0[r] += nv_; C1[r] += nv_; } \
    CMASK(C0, C1, t); \
    { float a = MX3(C0[0], C0[1], C1[0]), b = MX3(C0[2], C0[3], C1[1]); a = MX3(a, C1[2], C1[3]); \
      _Pragma("unroll") for (int r = 4; r < 16; r += 4) { a = MX3(a, C0[r], C0[r + 1]); b = MX3(b, C0[r + 2], C0[r + 3]); a = MX3(a, C1[r], C1[r + 1]); b = MX3(b, C1[r + 2], C1[r + 3]); } \
      float rm = __builtin_fmaxf(a, b); { auto rr = __builtin_amdgcn_permlane32_swap(__float_as_uint(rm), __float_as_uint(rm), false, false); rm = __builtin_fmaxf(__uint_as_float(rr[0]), __uint_as_float(rr[1])); } \
      resc = false; \
      if (__builtin_expect(__any(rm > (float)THRL), 0)) { const float dl = __builtin_fmaxf(rm, 0.f); mhat += dl; \
        _Pragma("unroll") for (int r = 0; r < 16; ++r) { C0[r] -= dl; C1[r] -= dl; } \
        const float f = __builtin_amdgcn_exp2f(-dl); l_reg *= f; if (hi == 0) wsf[r32] = f; resc = true; } } \
    SBAR(); \
    GAPB(o[0] = __builtin_amdgcn_mfma_f32_32x32x16_bf16(PAF(0), VFR(0), o[0], 0, 0, 0), C0, 0); \
    GAPB(o[1] = __builtin_amdgcn_mfma_f32_32x32x16_bf16(PAF(0), VFR(4), o[1], 0, 0, 0), C0, 4); \
    KRD(GL, 0); GAPB(o[0] = __builtin_amdgcn_mfma_f32_32x32x16_bf16(PAF(1), VFR(1), o[0], 0, 0, 0), C0, 8); \
    KRD(GL, 1); GAPB(o[1] = __builtin_amdgcn_mfma_f32_32x32x16_bf16(PAF(1), VFR(5), o[1], 0, 0, 0), C0, 12); \
    KRD(GL, 2); GAPB(o[0] = __builtin_amdgcn_mfma_f32_32x32x16_bf16(PAF(2), VFR(2), o[0], 0, 0, 0), C1, 0); \
    KRD(GL, 3); GAPB(o[1] = __builtin_amdgcn_mfma_f32_32x32x16_bf16(PAF(2), VFR(6), o[1], 0, 0, 0), C1, 4); \
    GAPB(o[0] = __builtin_amdgcn_mfma_f32_32x32x16_bf16(PAF(3), VFR(3), o[0], 0, 0, 0), C1, 8); \
    GAPB(o[1] = __builtin_amdgcn_mfma_f32_32x32x16_bf16(PAF(3), VFR(7), o[1], 0, 0, 0), C1, 12); \
    } while (0)
  int t = 1;
  for (; t + 1 < NT; t += 2) {
    STEP(pB0, pB1, pA0, pA1, t, true, true, true);     WAIT_BAR(2); RESC(); ROT();
    STEP(pA0, pA1, pB0, pB1, t + 1, true, true, true); WAIT_BAR(2); RESC(); ROT();
  }
  STEP(pB0, pB1, pA0, pA1, NT - 1, true, true, true); WAIT_BAR(2); RESC();
  { float sacc = pB0[0] + pB0[1]; _Pragma("unroll") for (int r = 2; r < 16; ++r) sacc += pB0[r]; _Pragma("unroll") for (int r = 0; r < 16; ++r) sacc += pB1[r]; l_reg += sacc;
    pw0 = (u32x4){PKW(pB0, 0), PKW(pB0, 2), PKW(pB0, 4), PKW(pB0, 6)}; pw1 = (u32x4){PKW(pB0, 8), PKW(pB0, 10), PKW(pB0, 12), PKW(pB0, 14)}; pw2 = (u32x4){PKW(pB1, 0), PKW(pB1, 2), PKW(pB1, 4), PKW(pB1, 6)}; pw3 = (u32x4){PKW(pB1, 8), PKW(pB1, 10), PKW(pB1, 12), PKW(pB1, 14)};
    SBAR(); pv(o, vb0 + sl_cur, PAF(0), PAF(1), PAF(2), PAF(3)); }
  #undef PKW
  #undef PAF
  #undef VFR
  #undef PIN
  #undef MX3
  #undef GAPA
  #undef GAPB
  #undef EX
  #undef VRD
  #undef KRD
  #undef STEP
  { auto rr = __builtin_amdgcn_permlane32_swap(__float_as_uint(l_reg), __float_as_uint(l_reg), false, false); l_reg = __uint_as_float(rr[0]) + __uint_as_float(rr[1]); }
  if (hi == 0) wsf[32 + r32] = l_reg; asm volatile("s_waitcnt lgkmcnt(0)" ::: "memory");
  float rli[16];
  #pragma unroll
  for (int r = 0; r < 16; ++r) rli[r] = __builtin_amdgcn_rcpf(wsf[32 + crow(r, hi)]);
  bf16* Ow = MIX + (rowbase + q0 + wid * QBLK) * OP + 512 + h * D;
  { bf16* stg = (bf16*)(shm + LDS_OST) + wid * 2048;
    #pragma unroll
    for (int r = 0; r < 16; ++r) { const int orow = crow(r, hi);
      #pragma unroll
      for (int d0 = 0; d0 < 2; ++d0) stg[orow * 64 + d0 * 32 + r32] = __float2bfloat16(o[d0][r] * rli[r]); }
    asm volatile("s_waitcnt lgkmcnt(0)" ::: "memory");
    #pragma unroll
    for (int i = 0; i < 4; ++i) { const int row = i * 8 + (lane >> 3), ch = lane & 7; const u32x4 v = *(const u32x4*)(stg + row * 64 + ch * 8); *(u32x4*)(Ow + (long)row * OP + ch * 8) = v; } }
  asm volatile("s_waitcnt vmcnt(0) lgkmcnt(0)\n\ts_barrier" ::: "memory");
  #undef DMA_K
  #undef DMA_V
  #undef TM
  #undef CMASK
  #undef NVAL
  #undef START
  #undef RESC
  #undef ROT
}
#undef WAIT_BAR
}

namespace ret {
constexpr int KS_STR = 144, V_STR = 272;
constexpr int L_KS = 0, L_KH = 18432, L_VS = 36864, L_RT = 71680, L_END = 90112;
typedef short v4i16_t __attribute__((ext_vector_type(4)));
__device__ __forceinline__ s16x4 vtr(LAS const char* p) { return __builtin_bit_cast(s16x4, __builtin_amdgcn_ds_read_tr16_b64_v4i16((LAS v4i16_t*)p)); }
__device__ __forceinline__ bf16x8 cat8(s16x4 a, s16x4 b) { return (bf16x8){a[0], a[1], a[2], a[3], b[0], b[1], b[2], b[3]}; }

__device__ __forceinline__ void ret_unit(int b, int h, const bf16_t* PROJ, const float* rnw, bf16_t* MIX, LAS unsigned char* lds) {
    int tid_ = threadIdx.x; asm volatile("" : "+v"(tid_));
    const int tid = tid_, lane = tid & 63, c16 = lane & 15, g = lane >> 4; const int w = __builtin_amdgcn_readfirstlane(tid >> 6);
    const float log2g = log2f(1.0f - exp2f(-5.0f - (float)h));
    const float gC = exp2f(log2g * 128.0f);
    LAS unsigned char* Ks = lds + L_KS; LAS unsigned char* Kh = lds + L_KH; LAS unsigned char* Vs = lds + L_VS; LAS unsigned char* Rt = lds + L_RT;
    for (int i = tid; i < (L_END - L_RT) / 16; i += 512) *(LAS u32x4*)(Rt + i * 16) = (u32x4){0u, 0u, 0u, 0u};
    f32x4 Racc[4];
#pragma unroll
    for (int dt = 0; dt < 4; ++dt) Racc[dt] = (f32x4){0.f, 0.f, 0.f, 0.f};
    const size_t tokb = (size_t)b * SEQ;
    u32x4 kreg[2], vreg[4]; bf16x8 qn[2];
    const int krow0 = tid >> 3, kcc = tid & 7, vrow0 = tid >> 4, vcc = tid & 15;
#define RET_LOAD(c) do { const bf16_t* base = PROJ + (tokb + (size_t)(c) * 128) * DIN; \
        _Pragma("unroll") for (int i = 0; i < 2; ++i) kreg[i] = *(const u32x4*)(base + (size_t)(krow0 + 64 * i) * DIN + PC_RK + 64 * h + 8 * kcc); \
        _Pragma("unroll") for (int i = 0; i < 4; ++i) vreg[i] = *(const u32x4*)(base + (size_t)(vrow0 + 32 * i) * DIN + PC_RV + 128 * h + 8 * vcc); \
        _Pragma("unroll") for (int k2 = 0; k2 < 2; ++k2) qn[k2] = *(const bf16x8*)(base + (size_t)(16 * w + c16) * DIN + PC_RQ + 64 * h + 32 * k2 + 8 * g); } while (0)
    RET_LOAD(0);
    for (int c = 0; c < 16; ++c) {
#pragma unroll
        for (int i = 0; i < 2; ++i) { const int row = krow0 + 64 * i; *(LAS u32x4*)(Ks + row * KS_STR + kcc * 16) = kreg[i];
            const float z = exp2f(log2g * (float)(127 - row)); u32x4 s;
#pragma unroll
            for (int j = 0; j < 4; ++j) { const unsigned u = kreg[i][j]; s[j] = pk2(bf2f((unsigned short)(u & 0xffffu)) * z, bf2f((unsigned short)(u >> 16)) * z); }
            *(LAS u32x4*)(Kh + row * KS_STR + kcc * 16) = s; }
#pragma unroll
        for (int i = 0; i < 4; ++i) { const int row = vrow0 + 32 * i; *(LAS u32x4*)(Vs + row * V_STR + vcc * 16) = vreg[i]; }
        bf16x8 qf[2]; qf[0] = qn[0]; qf[1] = qn[1];
        __syncthreads();
        if (c + 1 < 16) RET_LOAD(c + 1);
        f32x4 oi[8], oc[8];
#pragma unroll
        for (int et = 0; et < 8; ++et) { oi[et] = (f32x4){0.f, 0.f, 0.f, 0.f}; oc[et] = (f32x4){0.f, 0.f, 0.f, 0.f}; }
        const int trq = c16 >> 2, trp = c16 & 3;
        const int nks = (w >> 1) + 1;
        LAS const char* ksb = (LAS const char*)Ks + c16 * KS_STR + g * 16;
        LAS const char* vtb = (LAS const char*)Vs + (4 * g + trq) * V_STR + trp * 8;
        LAS const char* khb = (LAS const char*)Kh + (4 * g + trq) * KS_STR + trp * 8;
        LAS const char* rtb = (LAS const char*)Rt + c16 * KS_STR + g * 16;
#pragma unroll 1
        for (int ks = 0; ks < nks; ++ks) {
            u32x4 pw;
#pragma unroll
            for (int half = 0; half < 2; ++half) { const int mt = 2 * ks + half; f32x4 st = (f32x4){0.f, 0.f, 0.f, 0.f};
                if (mt <= w) {
#pragma unroll
                    for (int k2 = 0; k2 < 2; ++k2) { const bf16x8 ka = *(const LAS bf16x8*)(ksb + mt * (16 * KS_STR) + k2 * 64);
                        st = __builtin_amdgcn_mfma_f32_16x16x32_bf16(ka, qf[k2], st, 0, 0, 0); } }
                float pv_[4];
#pragma unroll
                for (int r = 0; r < 4; ++r) { const int diff = (16 * w + c16) - (16 * mt + 4 * g + r); pv_[r] = diff >= 0 ? st[r] * exp2f(log2g * (float)diff) : 0.f; }
                pw[2 * half] = pk2(pv_[0], pv_[1]); pw[2 * half + 1] = pk2(pv_[2], pv_[3]); }
            const bf16x8 pf = __builtin_bit_cast(bf16x8, pw);
            LAS const char* vp = vtb + ks * (32 * V_STR);
#pragma unroll
            for (int et = 0; et < 8; ++et) { const bf16x8 vf = cat8(vtr(vp + et * 32), vtr(vp + et * 32 + 16 * V_STR));
                oi[et] = __builtin_amdgcn_mfma_f32_16x16x32_bf16(pf, vf, oi[et], 0, 0, 0); }
        }
#pragma unroll
        for (int k2 = 0; k2 < 2; ++k2)
#pragma unroll
            for (int et = 0; et < 8; ++et) { const bf16x8 rf = *(const LAS bf16x8*)(rtb + et * (16 * KS_STR) + k2 * 64);
                oc[et] = __builtin_amdgcn_mfma_f32_16x16x32_bf16(qf[k2], rf, oc[et], 0, 0, 0); }
        {
            float s1[4], s2[4], xi[4];
#pragma unroll
            for (int r = 0; r < 4; ++r) { xi[r] = exp2f(log2g * (float)(16 * w + 4 * g + r + 1)); s1[r] = 0.f; s2[r] = 0.f; }
#pragma unroll
            for (int et = 0; et < 8; ++et)
#pragma unroll
                for (int r = 0; r < 4; ++r) { const float x = oi[et][r] + xi[r] * oc[et][r]; oi[et][r] = x; s1[r] += x; s2[r] += x * x; }
#pragma unroll
            for (int r = 0; r < 4; ++r) {
#pragma unroll
                for (int o = 1; o < 16; o <<= 1) { s1[r] += __shfl_xor(s1[r], o); s2[r] += __shfl_xor(s2[r], o); }
                const float mu = s1[r] * (1.f / 128.f); const float var = fmaxf(s2[r] * (1.f / 128.f) - mu * mu, 0.f); s1[r] = mu; s2[r] = 1.0f / sqrtf(var + GN_EPS); }
            const size_t tok0 = tokb + (size_t)c * 128 + 16 * w + 4 * g;
#pragma unroll
            for (int et = 0; et < 8; ++et) { const int col = 128 * h + 16 * et + c16; const float wgt = rnw[col];
#pragma unroll
                for (int r = 0; r < 4; ++r) { const float gv = bf2f(PROJ[(tok0 + r) * DIN + PC_RG + col]);
                    const float sg = gv * __builtin_amdgcn_rcpf(1.f + __builtin_amdgcn_exp2f(-gv * 1.4426950408889634f));
                    MIX[(tok0 + r) * DM + col] = (bf16_t)f2bf((oi[et][r] - s1[r]) * s2[r] * wgt * sg); }
                if (et & 1) asm volatile("" ::: "memory"); }
        }
#pragma unroll
        for (int dt = 0; dt < 4; ++dt) Racc[dt] = Racc[dt] * gC;
#pragma unroll 1
        for (int ks = 0; ks < 4; ++ks) { LAS const char* vp = vtb + ks * (32 * V_STR) + w * 32;
            const bf16x8 vf = cat8(vtr(vp), vtr(vp + 16 * V_STR));
            LAS const char* kp = khb + ks * (32 * KS_STR);
#pragma unroll
            for (int dt = 0; dt < 4; ++dt) { const bf16x8 kfm = cat8(vtr(kp + dt * 32), vtr(kp + dt * 32 + 16 * KS_STR));
                Racc[dt] = __builtin_amdgcn_mfma_f32_16x16x32_bf16(kfm, vf, Racc[dt], 0, 0, 0); } }
        __syncthreads();
#pragma unroll
        for (int dt = 0; dt < 4; ++dt) { u32x2 o2; o2.x = pk2(Racc[dt][0], Racc[dt][1]); o2.y = pk2(Racc[dt][2], Racc[dt][3]);
            *(LAS u32x2*)(Rt + (16 * w + c16) * KS_STR + (16 * dt + 4 * g) * 2) = o2; }
    }
    __syncthreads();
#undef RET_LOAD
}
}

#define XB_TMO      128
#define XB_XCNT(j)  (256  + 64 * (j))
#define XB_XSUB(j)  (1280 + 64 * (j))
#define XB_XGEN(j)  (2304 + 64 * (j))
#define XB_TOP      3328
#define XB_TOPGEN   3392
#define XCD_BAR_WORDS 3456
#define XB_SPIN_CAP (1u << 18)
__device__ __forceinline__ unsigned xb_ld(unsigned* p)              { return __hip_atomic_load(p, __ATOMIC_RELAXED, __HIP_MEMORY_SCOPE_AGENT); }
__device__ __forceinline__ unsigned xb_add(unsigned* p, unsigned v) { return __hip_atomic_fetch_add(p, v, __ATOMIC_RELAXED, __HIP_MEMORY_SCOPE_AGENT); }
__device__ __forceinline__ unsigned xb_xcc_id() { return (unsigned)__builtin_amdgcn_s_getreg((3 << 11) | 20) & 0xFu; }
#define XB_SPIN(cond, bar) do { unsigned _sp = 0; while (cond) { __builtin_amdgcn_s_sleep(1); \
    if ((++_sp & 255u) == 0u) { if (xb_ld(&(bar)[XB_TMO])) break; if (_sp > XB_SPIN_CAP) { atomicAdd(&(bar)[XB_TMO], 1u); break; } } } } while (0)
struct XcdBarrier { unsigned* bar; unsigned x; volatile LAS unsigned* st; };
__device__ __forceinline__ XcdBarrier xcd_barrier_post(unsigned* bar, volatile LAS unsigned* st) {
    XcdBarrier b; b.bar = bar; b.x = xb_xcc_id(); b.st = st;
    if (threadIdx.x == 0) (void)xb_add(&bar[XB_XCNT(b.x)], 1u);
    return b;
}
__device__ __forceinline__ void xcd_barrier_complete(unsigned* bar, unsigned x, unsigned& nloc, unsigned& nx) {
    const unsigned G = gridDim.x * gridDim.y * gridDim.z;
    unsigned sum, cnt, mine, sp = 0u;
    for (;;) {
        sum = 0u; cnt = 0u; mine = 0u;
#pragma unroll
        for (unsigned j = 0; j < 16; ++j) { const unsigned c = xb_ld(&bar[XB_XCNT(j)]); sum += c; cnt += (c > 0u) ? 1u : 0u; mine = (j == x) ? c : mine; }
        if (sum == G) break;
        __builtin_amdgcn_s_sleep(1);
        if ((++sp & 255u) == 0u) { if (xb_ld(&bar[XB_TMO])) break; if (sp > XB_SPIN_CAP) { atomicAdd(&bar[XB_TMO], 1u); break; } }
    }
    nloc = mine > 0u ? mine : 1u; nx = cnt > 0u ? cnt : 1u;
}
__device__ __forceinline__ void xcd_barrier(const XcdBarrier& b) {
    asm volatile("s_waitcnt vmcnt(0)" ::: "memory");
    __syncthreads();
    if (threadIdx.x == 0) {
        unsigned* bar = b.bar;
        __builtin_amdgcn_s_waitcnt(0);
        unsigned nloc = b.st[0], nx = b.st[1];
        if (nloc == 0u) { xcd_barrier_complete(bar, b.x, nloc, nx); b.st[0] = nloc; b.st[1] = nx; }
        const unsigned old = xb_add(&bar[XB_XSUB(b.x)], 1u);
        const unsigned gen = old / nloc;
        if (old + 1u == (gen + 1u) * nloc) {
            __builtin_amdgcn_fence(__ATOMIC_RELEASE, "agent");
            asm volatile("s_waitcnt vmcnt(0)" ::: "memory");
            const unsigned og = xb_add(&bar[XB_TOP], 1u);
            const unsigned tg = og / nx;
            if (og + 1u == (tg + 1u) * nx) xb_add(&bar[XB_TOPGEN], 1u);
            else XB_SPIN(xb_ld(&bar[XB_TOPGEN]) == tg, bar);
            __builtin_amdgcn_fence(__ATOMIC_ACQUIRE, "agent");
            xb_add(&bar[XB_XGEN(b.x)], 1u);
            asm volatile("s_waitcnt vmcnt(0)" ::: "memory");
        } else {
            XB_SPIN(xb_ld(&bar[XB_XGEN(b.x)]) == gen, bar);
            __builtin_amdgcn_fence(__ATOMIC_ACQUIRE, "agent");
            asm volatile("s_waitcnt vmcnt(0)" ::: "memory");
        }
    }
    __syncthreads();
}

__device__ __forceinline__ float wave_sum(float v) {
#pragma unroll
    for (int o = 1; o < 64; o <<= 1) v += __shfl_xor(v, o);
    return v;
}
__device__ __forceinline__ int dst_row(int mode, int n) {
    if (mode == 1) {
        if (n < 512) { const int base = n & ~255, j = n & 255, hh = j >> 6, d = j & 63; return base + ((d < 32) ? (32 * hh + d) : (128 + 32 * hh + (d - 32))); }
        if (n >= PC_MQ && n < PC_MV) { const int d = n & 63; if (d < 16) { const int nn = d >> 3, fq = (d >> 2) & 1, e = d & 3; return (n & ~63) + 8 * fq + 4 * nn + e; } }
        return n;
    }
    if (mode == 2) { return (n < 1024) ? (256 * (n >> 7) + (n & 127)) : (256 * ((n - 1024) >> 7) + 128 + ((n - 1024) & 127)); }
    return n;
}
__device__ __forceinline__ void p0_transpose_item(const float* W, int K, int N, bf16_t* WT, int mode, LAS float* scr, int item, int lane) {
    const int nblk = N / 32, kb = item / nblk, nb = item % nblk, k0 = 64 * kb, n0 = 32 * nb;
#pragma unroll 8
    for (int i = 0; i < 32; ++i) { const int kk = 2 * i + (lane >> 5); scr[kk * 33 + (lane & 31)] = W[(size_t)(k0 + kk) * N + n0 + (lane & 31)]; }
    LDS_WAIT(); asm volatile("" ::: "memory");
    const int c = lane & 7;
#pragma unroll
    for (int j = 0; j < 4; ++j) { const int n = (lane >> 3) + 8 * j; const LAS float* s = scr + (8 * c) * 33 + n;
        u32x4 o; o.x = pk2(s[0 * 33], s[1 * 33]); o.y = pk2(s[2 * 33], s[3 * 33]); o.z = pk2(s[4 * 33], s[5 * 33]); o.w = pk2(s[6 * 33], s[7 * 33]);
        *(GAS u32x4*)(WT + (size_t)dst_row(mode, n0 + n) * K + k0 + 8 * c) = o; }
    LDS_WAIT(); asm volatile("" ::: "memory");
}
__device__ __forceinline__ void sincos_acc(float af, float& sn, float& cs) {
    const double a = (double)af; const double k = rint(a * 0.15915494309189535); double r = a - k * 6.283185307179586;
    double sgn = 1.0; if (r > 1.5707963267948966) { r = 3.141592653589793 - r; sgn = -1.0; } else if (r < -1.5707963267948966) { r = -3.141592653589793 - r; sgn = -1.0; }
    const double r2 = r * r;
    double s = -1.0 / 355687428096000.0; s = s * r2 + 1.0 / 1307674368000.0; s = s * r2 - 1.0 / 6227020800.0; s = s * r2 + 1.0 / 39916800.0; s = s * r2 - 1.0 / 362880.0; s = s * r2 + 1.0 / 5040.0; s = s * r2 - 1.0 / 120.0; s = s * r2 + 1.0 / 6.0; s = r - r * r2 * s;
    double c = 1.0 / 20922789888000.0; c = c * r2 - 1.0 / 87178291200.0; c = c * r2 + 1.0 / 479001600.0; c = c * r2 - 1.0 / 3628800.0; c = c * r2 + 1.0 / 40320.0; c = c * r2 - 1.0 / 720.0; c = c * r2 + 1.0 / 24.0; c = c * r2 - 0.5; c = 1.0 + c * r2;
    sn = (float)s; cs = (float)(sgn * c);
}

struct Args { const float* in[13]; float* out; unsigned char* ws; int ph_lo, ph_hi, li, pad; };
constexpr int N_PHASES = 8;

__global__ void __launch_bounds__(NWAVES * 64, 2) fwd_mega(Args args) {
    extern __shared__ __attribute__((aligned(16))) unsigned char lds_raw[];
    LAS unsigned char* lds = (LAS unsigned char*)lds_raw;
    volatile LAS unsigned* MISC = (volatile LAS unsigned*)(lds + MISC_OFF);
    LAS int* LTAB = (LAS int*)(lds + LTAB_OFF);
    const int tid = threadIdx.x, lane = tid & 63, wave = __builtin_amdgcn_readfirstlane(tid >> 6);
    const int G = gridDim.x, bx = blockIdx.x; const int vcu = (G % 8 == 0) ? (bx % 8) * (G / 8) + bx / 8 : bx;
    unsigned char* ws = args.ws;
    gu32* ctl = (gu32*)(ws + WS_CTL);
    const float* x = args.in[0]; const float* norm1_w = args.in[1]; const float* w_in = args.in[2]; const float* ret_norm_w = args.in[3]; const float* w_out = args.in[4];
    const float* norm2_w = args.in[5]; const float* w_router = args.in[6]; const float* b_router = args.in[7]; const float* w1 = args.in[8]; const float* b1 = args.in[9];
    const float* w2 = args.in[10]; const float* b2 = args.in[11]; const float* final_w = args.in[12];
    float* out = args.out;
    float* rope = (float*)(ws + WS_ROPE); float* rc = rope; float* rs = rope + SEQ * 32; float* mc = rope + 2 * SEQ * 32; float* ms = mc + SEQ * 8;
    float* ksum = (float*)(ws + WS_KSUM); float* rstd2 = (float*)(ws + WS_RSTD); bf16_t* wrf = (bf16_t*)(ws + WS_WRF); float* gate = (float*)(ws + WS_GATE); int* slot = (int*)(ws + WS_SLOT);
    bf16_t* WinT = (bf16_t*)(ws + WS_WIN); bf16_t* WoutT = (bf16_t*)(ws + WS_WOUT); bf16_t* W2T = (bf16_t*)(ws + WS_W2); bf16_t* W1T = (bf16_t*)(ws + WS_W1);
    bf16_t* PROJ = (bf16_t*)(ws + WS_PROJ); bf16_t* MIX = (bf16_t*)(ws + WS_MIX); bf16_t* ACT = (bf16_t*)(ws + WS_ACT); bf16_t* XN = (bf16_t*)(ws + WS_XN); bf16_t* Y3 = (bf16_t*)(ws + WS_Y3);

    for (int u = tid; u < (LDS_BYTES - LDSCTL_OFF) / 4; u += NWAVES * 64) ((LAS unsigned*)(lds + LDSCTL_OFF))[u] = 0u;
    __syncthreads();
    const bool use_bar = (MK_N_LAUNCHES != N_PHASES);
    XcdBarrier bar; bar.bar = (unsigned*)(ctl + CW_BAR) + args.li * XCD_BAR_WORDS; bar.x = 0; bar.st = nullptr;
    if (use_bar) bar = xcd_barrier_post((unsigned*)(ctl + CW_BAR) + args.li * XCD_BAR_WORDS, MISC + 8);
    const int lo = args.ph_lo, hi = args.ph_hi;
#ifndef PHASE_MASK
#define PHASE_MASK 0xff
#endif
#define IN(k) ((((PHASE_MASK) >> (k)) & 1) && lo <= (k) && (k) < hi)
#define SEAM(k) do { if (IN(k) && IN((k) + 1)) xcd_barrier(bar); } while (0)

    if (IN(0)) {
        LAS float* scr = (LAS float*)(lds + wave * 16384);
        const int gw = vcu * NWAVES + wave, NGW = G * NWAVES;
        constexpr int I_IN = (DM / 64) * (DIN / 32), I_OUT = (DM / 64) * (DM / 32), I_1E = (DM / 64) * (2048 / 32), I_2E = (DM / 64) * (DM / 32);
        constexpr int I_1 = NEXP * I_1E, I_2 = NEXP * I_2E, NITEMS = I_IN + I_OUT + I_1 + I_2;
        for (int it = gw; it < NITEMS; it += NGW) {
            int r = it;
            if (r < I_1) { const int e = r / I_1E; p0_transpose_item(w1 + (size_t)e * DM * 2048, DM, 2048, W1T + (size_t)e * 2048 * DM, 2, scr, r % I_1E, lane); continue; } r -= I_1;
            if (r < I_2) { const int e = r / I_2E; p0_transpose_item(w2 + (size_t)e * DM * DM, DM, DM, W2T + (size_t)e * DM * DM, 0, scr, r % I_2E, lane); continue; } r -= I_2;
            if (r < I_IN) { p0_transpose_item(w_in, DM, DIN, WinT, 1, scr, r, lane); continue; } r -= I_IN;
            p0_transpose_item(w_out, DM, DM, WoutT, 0, scr, r, lane);
        }
        {
            f32x4 wv[4];
#pragma unroll
            for (int j = 0; j < 4; ++j) wv[j] = *((const f32x4*)norm1_w + lane + 64 * j);
            for (int m = gw; m < NTOK; m += NGW) {
                const f32x4* xr = (const f32x4*)(x + (size_t)m * DM) + lane; f32x4 v[4]; float s = 0.f;
#pragma unroll
                for (int j = 0; j < 4; ++j) { v[j] = xr[64 * j]; s += (v[j].x * v[j].x + v[j].y * v[j].y) + (v[j].z * v[j].z + v[j].w * v[j].w); }
                const float rstd = 1.0f / sqrtf(wave_sum(s) * (1.f / DM) + RMS_EPS);
                unsigned long long* o8 = (unsigned long long*)(XN + (size_t)m * DM) + lane;
#pragma unroll
                for (int j = 0; j < 4; ++j) { const f32x4 y = v[j] * rstd * wv[j]; o8[64 * j] = (unsigned long long)pk2(y.x, y.y) | ((unsigned long long)pk2(y.z, y.w) << 32); }
            }
        }
        {
            const int gt = vcu * (NWAVES * 64) + tid, NGT = G * NWAVES * 64;
            for (int idx = gt; idx < SEQ * 32 + SEQ * 8; idx += NGT) {
                if (idx < SEQ * 32) { const int s = idx >> 5, i = idx & 31; const float inv = (float)exp2(-(double)i / 32.0 * 13.287712379549449);
                    float sn, cs; sincos_acc((float)s * inv, sn, cs); rc[idx] = cs; rs[idx] = sn; }
                else { const int j = idx - SEQ * 32, s = j >> 3, i = j & 7; const float inv = (float)exp2(-(double)i / 8.0 * 18.931568569324174);
                    float sn, cs; sincos_acc((float)s * inv, sn, cs); mc[j] = cs; ms[j] = sn; }
            }
            for (int idx = gt; idx < 32 * 2 * 64 * 8; idx += NGT) {
                const int j = idx & 7, ln = (idx >> 3) & 63, eh = (idx >> 9) & 1, ks = idx >> 10;
                const int k = 32 * ks + 8 * (ln >> 4) + j, e = 16 * eh + (ln & 15);
                const float wv = w_router[(size_t)k * NEXP + e]; const unsigned hb = f2bf(wv); const float lof = wv - bf2f((unsigned short)hb);
                wrf[(((size_t)(ks * 2 + eh) * 2 + 0) * 64 + ln) * 8 + j] = (bf16_t)hb;
                wrf[(((size_t)(ks * 2 + eh) * 2 + 1) * 64 + ln) * 8 + j] = (bf16_t)f2bf(lof);
            }
        }
    }
    SEAM(0);

    if (IN(1)) {
        pg8::ProbInProj P; P.A = XN; P.Bt = WinT; P.nM = NTOK / 256; P.nN = DIN / 256; P.G = G; P.c = bx;
        P.PROJ = PROJ; P.rc = rc; P.rs = rs; P.mc = mc; P.ms = ms; P.ksum = ksum;
        pg8::gemm_phase<pg8::ProbInProj, true>(lds, P);
    }
    SEAM(1);

    if (IN(2)) {
        for (;;) {
            if (tid == 0) MISC[16] = __hip_atomic_fetch_add(ctl + CW_QUEUE, 1u, RLX_AGENT);
            __syncthreads();
            const int id = __builtin_amdgcn_readfirstlane((int)MISC[16]);
            __syncthreads();
            if (id >= 128 + 2048) break;
#ifndef NO_RET
            if (id < 128) ret::ret_unit(id >> 2, id & 3, PROJ, ret_norm_w, MIX, lds);
            else
#endif
#ifndef NO_MOBA
            { const int j = id - 128; const int qb = 7 - (j >> 8), bh = j & 255;
                moba::moba_unit<8>(bh >> 3, bh & 7, qb, (const moba::bf16*)PROJ, ksum, (moba::bf16*)MIX, (char*)lds_raw); }
#else
            {}
#endif
        }
    }
    SEAM(2);

    if (IN(3)) {
        pg8::ProbOutProj P; P.A = MIX; P.Bt = WoutT; P.nM = NTOK / 256; P.nN = DM / 256; P.G = G; P.c = bx; P.x = x; P.X1 = out;
        pg8::gemm_phase<pg8::ProbOutProj, true>(lds, P);
    }
    SEAM(3);

    if (IN(4)) {
        LAS float* lg = (LAS float*)(lds) + wave * (32 * 33);
        LAS unsigned* pinfo = (LAS unsigned*)(lds + 40960);
        LAS float* pgate = (LAS float*)(lds + 40960 + 4096);
        LAS unsigned* lcnt = (LAS unsigned*)(lds + 40960 + 8192);
        LAS unsigned* lbase = lcnt + 32;
        const int c16 = lane & 15, g = lane >> 4;
        for (int blk = bx; blk < NTOK / 256; blk += G) {
            if (tid < 32) lcnt[tid] = 0u;
            __syncthreads();
            const int R0 = blk * 256 + wave * 32;
            f32x4 acc[2][2]; float ssq[2] = {0.f, 0.f};
#pragma unroll
            for (int tt = 0; tt < 2; ++tt)
#pragma unroll
                for (int eh = 0; eh < 2; ++eh) acc[tt][eh] = (f32x4){0.f, 0.f, 0.f, 0.f};
#pragma unroll 2
            for (int ks = 0; ks < 32; ++ks) {
                const f32x4 w0 = *(const f32x4*)(norm2_w + 32 * ks + 8 * g), w1v = *(const f32x4*)(norm2_w + 32 * ks + 8 * g + 4);
                bf16x8 bh[2], bl[2];
#pragma unroll
                for (int eh = 0; eh < 2; ++eh) { bh[eh] = *(const bf16x8*)(wrf + (((size_t)(ks * 2 + eh) * 2 + 0) * 64 + lane) * 8); bl[eh] = *(const bf16x8*)(wrf + (((size_t)(ks * 2 + eh) * 2 + 1) * 64 + lane) * 8); }
#pragma unroll
                for (int tt = 0; tt < 2; ++tt) { const size_t ro = (size_t)(R0 + 16 * tt + c16) * DM + 32 * ks + 8 * g;
                    const f32x4 a0 = *(const f32x4*)(out + ro), a1 = *(const f32x4*)(out + ro + 4);
                    ssq[tt] += (a0.x * a0.x + a0.y * a0.y) + (a0.z * a0.z + a0.w * a0.w) + (a1.x * a1.x + a1.y * a1.y) + (a1.z * a1.z + a1.w * a1.w);
                    const f32x4 v0 = a0 * w0, v1 = a1 * w1v; u32x4 hw, lw;
                    hw.x = pk2(v0.x, v0.y); hw.y = pk2(v0.z, v0.w); hw.z = pk2(v1.x, v1.y); hw.w = pk2(v1.z, v1.w);
                    lw.x = pk2(v0.x - __builtin_bit_cast(float, hw.x << 16), v0.y - __builtin_bit_cast(float, hw.x & 0xffff0000u)); lw.y = pk2(v0.z - __builtin_bit_cast(float, hw.y << 16), v0.w - __builtin_bit_cast(float, hw.y & 0xffff0000u));
                    lw.z = pk2(v1.x - __builtin_bit_cast(float, hw.z << 16), v1.y - __builtin_bit_cast(float, hw.z & 0xffff0000u)); lw.w = pk2(v1.z - __builtin_bit_cast(float, hw.w << 16), v1.w - __builtin_bit_cast(float, hw.w & 0xffff0000u));
                    *(u32x4*)(XN + ro) = hw;
                    const bf16x8 ah = __builtin_bit_cast(bf16x8, hw), al = __builtin_bit_cast(bf16x8, lw);
#pragma unroll
                    for (int eh = 0; eh < 2; ++eh) { acc[tt][eh] = __builtin_amdgcn_mfma_f32_16x16x32_bf16(ah, bh[eh], acc[tt][eh], 0, 0, 0);
                        acc[tt][eh] = __builtin_amdgcn_mfma_f32_16x16x32_bf16(al, bh[eh], acc[tt][eh], 0, 0, 0); acc[tt][eh] = __builtin_amdgcn_mfma_f32_16x16x32_bf16(ah, bl[eh], acc[tt][eh], 0, 0, 0); } }
            }
#pragma unroll
            for (int tt = 0; tt < 2; ++tt) { float s = ssq[tt]; s += __shfl_xor(s, 16); s += __shfl_xor(s, 32); const float rstd = 1.0f / sqrtf(s * (1.f / DM) + RMS_EPS);
                if (g == 0) rstd2[R0 + 16 * tt + c16] = rstd;
#pragma unroll
                for (int r = 0; r < 4; ++r) { const float rr = __shfl(rstd, 4 * g + r);
#pragma unroll
                    for (int eh = 0; eh < 2; ++eh) lg[(16 * tt + 4 * g + r) * 33 + 16 * eh + c16] = acc[tt][eh][r] * rr + b_router[16 * eh + c16]; } }
            LDS_WAIT(); asm volatile("" ::: "memory");
            if (lane < 32) {
                float v[32];
#pragma unroll
                for (int e = 0; e < 32; ++e) v[e] = lg[lane * 33 + e];
                float tv[4]; int te[4];
#pragma unroll
                for (int k = 0; k < 4; ++k) { float best = v[0]; int bi = 0;
#pragma unroll
                    for (int e = 1; e < 32; ++e) if (v[e] > best) { best = v[e]; bi = e; }
                    tv[k] = best; te[k] = bi;
#pragma unroll
                    for (int e = 0; e < 32; ++e) v[e] = (e == bi) ? -INFINITY : v[e]; }
                float ex[4], sum = 0.f;
#pragma unroll
                for (int k = 0; k < 4; ++k) { ex[k] = __expf(tv[k] - tv[0]); sum += ex[k]; }
                const float inv = 1.0f / sum;
#pragma unroll
                for (int k = 0; k < 4; ++k) { const unsigned lr = __hip_atomic_fetch_add(lcnt + te[k], 1u, __ATOMIC_RELAXED, __HIP_MEMORY_SCOPE_WORKGROUP);
                    const int p = (wave * 32 + lane) * 4 + k; pinfo[p] = (unsigned)te[k] | (lr << 8); pgate[p] = ex[k] * inv; }
            }
            __syncthreads();
            if (tid < 32) lbase[tid] = __hip_atomic_fetch_add(ctl + CW_GCNT + 64 * tid, lcnt[tid], RLX_AGENT);
            __syncthreads();
            for (int p = tid; p < 1024; p += NWAVES * 64) { const unsigned pi = pinfo[p]; const int e = pi & 255u; const unsigned pos = lbase[e] + (pi >> 8);
                const int pair = (blk * 256) * 4 + p; slot[(size_t)e * NTOK + pos] = pair; gate[pair] = pgate[p]; }
            __syncthreads();
        }
    }
    SEAM(4);

    if (IN(5) || IN(6)) {
        if (tid == 0) { int tp = 0, cp = 0;
            for (int e = 0; e < NEXP; ++e) { const int c = (int)__hip_atomic_load(ctl + CW_GCNT + 64 * e, RLX_AGENT); LTAB[e] = tp; LTAB[33 + e] = cp; tp += (c + 255) >> 8; cp += c; }
            LTAB[32] = tp; LTAB[33 + 32] = cp; }
        __syncthreads();
    }
    if (IN(5)) {
        pg8::ProbMoe1 P; P.T = LTAB[32]; P.NP = 8; P.G = G; P.c = bx; P.tpre = LTAB; P.cpre = LTAB + 33;
        P.H2 = XN; P.W1T = W1T; P.slot = slot; P.rstd = rstd2; P.b1 = b1; P.ACT = ACT;
        pg8::gemm_phase<pg8::ProbMoe1, true>(lds, P);
    }
    SEAM(5);
    if (IN(6)) {
        pg8::ProbMoe2 P; P.T = LTAB[32]; P.NP = 4; P.G = G; P.c = bx; P.tpre = LTAB; P.cpre = LTAB + 33;
        P.ACT = ACT; P.W2T = W2T; P.slot = slot; P.gate = gate; P.b2 = b2; P.X1 = out; P.Y3 = Y3;
        pg8::gemm_phase<pg8::ProbMoe2, true>(lds, P);
    }
    SEAM(6);

    if (IN(7)) {
        const int gw = vcu * NWAVES + wave, NGW = G * NWAVES;
        unsigned bad = __hip_atomic_load(ctl + CW_TMO, RLX_AGENT);
        for (int li = 0; li < (MK_N_LAUNCHES == N_PHASES ? 0 : MK_N_LAUNCHES); ++li) bad |= __hip_atomic_load(ctl + CW_BAR + li * XCD_BAR_WORDS + XB_TMO, RLX_AGENT);
        f32x4 wv[4];
#pragma unroll
        for (int j = 0; j < 4; ++j) wv[j] = *((const f32x4*)final_w + lane + 64 * j);
        for (int m = gw; m < NTOK; m += NGW) {
            f32x4* xr = (f32x4*)(out + (size_t)m * DM) + lane; f32x4 v[4]; float s = 0.f;
            const u32x2* y0 = (const u32x2*)(Y3 + (size_t)m * 3 * DM) + lane;
#pragma unroll
            for (int j = 0; j < 4; ++j) { v[j] = xr[64 * j];
#pragma unroll
                for (int k = 0; k < 3; ++k) { const u32x2 yy = y0[k * (DM / 4) + 64 * j];
                    v[j].x += __builtin_bit_cast(float, yy.x << 16); v[j].y += __builtin_bit_cast(float, yy.x & 0xffff0000u); v[j].z += __builtin_bit_cast(float, yy.y << 16); v[j].w += __builtin_bit_cast(float, yy.y & 0xffff0000u); }
                s += (v[j].x * v[j].x + v[j].y * v[j].y) + (v[j].z * v[j].z + v[j].w * v[j].w); }
            const float rstd = 1.0f / sqrtf(wave_sum(s) * (1.f / DM) + RMS_EPS);
#pragma unroll
            for (int j = 0; j < 4; ++j) { f32x4 y = v[j] * rstd * wv[j]; if (bad) { const float q = __builtin_nanf(""); y = (f32x4){q, q, q, q}; } xr[64 * j] = y; }
        }
    }
#undef IN
#undef SEAM
}

extern "C" void kernel_launch(void* const* d_in, const int* in_sizes, int n_in, void* d_out, int out_size, void* d_ws, size_t ws_size, hipStream_t stream) {
    static int grid = 0;
    if (grid == 0) {
        if (n_in != 13 || in_sizes[0] != NTOK * DM || out_size != NTOK * DM || ws_size < WS_END) { fprintf(stderr, "kernel_launch: unexpected shapes (n_in %d, in0 %d, out %d, ws %zu)\n", n_in, n_in > 0 ? in_sizes[0] : -1, out_size, ws_size); grid = -1; return; }
        int dev = 0, cus = 0;
        if (hipGetDevice(&dev) != hipSuccess || hipDeviceGetAttribute(&cus, hipDeviceAttributeMultiprocessorCount, dev) != hipSuccess) { grid = -1; return; }
        if (hipFuncSetAttribute((const void*)fwd_mega, hipFuncAttributeMaxDynamicSharedMemorySize, LDS_BYTES) != hipSuccess) { fprintf(stderr, "kernel_launch: hipFuncSetAttribute failed\n"); grid = -1; return; }
        int per_cu = 0;
        if (hipOccupancyMaxActiveBlocksPerMultiprocessor(&per_cu, (const void*)fwd_mega, NWAVES * 64, LDS_BYTES) != hipSuccess || per_cu < 1) fprintf(stderr, "kernel_launch: occupancy query says %d\n", per_cu);
        (void)hipGetLastError();
        grid = cus;
    }
    if (grid < 0) return;
    (void)hipMemsetAsync((char*)d_ws + WS_CTL, 0, CTL_ZERO_BYTES, stream);
    Args a{};
    for (int i = 0; i < 13; ++i) a.in[i] = (const float*)d_in[i];
    a.out = (float*)d_out; a.ws = (unsigned char*)d_ws;
    if (MK_N_LAUNCHES == 1) { a.ph_lo = 0; a.ph_hi = N_PHASES; a.li = 0; hipLaunchKernelGGL(fwd_mega, dim3(grid), dim3(NWAVES * 64), LDS_BYTES, stream, a); }
    else for (int li = 0; li < N_PHASES; ++li) { a.ph_lo = li; a.ph_hi = li + 1; a.li = 0; hipLaunchKernelGGL(fwd_mega, dim3(grid), dim3(NWAVES * 64), LDS_BYTES, stream, a); }
}
```

```cpp
#include <hip/hip_runtime.h>
#include <hip/hip_bf16.h>
#include <cstdio>
#include <cstdint>
#include <cmath>

#ifndef MK_N_LAUNCHES
#define MK_N_LAUNCHES 1
#endif

#define LAS __attribute__((address_space(3)))
#define GAS __attribute__((address_space(1)))
typedef unsigned short bf16_t;
typedef short bf16x8 __attribute__((ext_vector_type(8)));
typedef short s16x4 __attribute__((ext_vector_type(4)));
typedef float f32x4 __attribute__((ext_vector_type(4)));
typedef float f32x2 __attribute__((ext_vector_type(2)));
typedef float f32x16 __attribute__((ext_vector_type(16)));
typedef unsigned u32x4 __attribute__((ext_vector_type(4)));
typedef unsigned u32x2 __attribute__((ext_vector_type(2)));
typedef GAS unsigned gu32;

constexpr int NB = 32, SEQ = 2048, DM = 1024, NTOK = NB * SEQ;
constexpr int DIN = 3072;
constexpr int NEXP = 32, TOPK = 4, NPAIR = NTOK * TOPK;
constexpr float RMS_EPS = 1e-5f, GN_EPS = 1e-6f;
constexpr float QC2 = 0.125f * 1.4426950408889634f;
constexpr int PC_RQ = 0, PC_RK = 256, PC_RV = 512, PC_RG = 1024, PC_MQ = 1536, PC_MK = 2048, PC_MV = 2560;

constexpr size_t MiB = 1u << 20;
constexpr size_t WS_CTL = 0, CTL_ZERO_BYTES = 1 * MiB;
constexpr size_t WS_ROPE = 1 * MiB;
constexpr size_t WS_KSUM = 2 * MiB;
constexpr size_t WS_RSTD = 3 * MiB;
constexpr size_t WS_WRF = 3 * MiB + 512 * 1024;
constexpr size_t WS_GATE = 4 * MiB;
constexpr size_t WS_SLOT = 5 * MiB;
constexpr size_t WS_WIN = 16 * MiB, WS_WOUT = 22 * MiB, WS_W2 = 24 * MiB;
constexpr size_t WS_PROJ = 88 * MiB, WS_MIX = 472 * MiB, WS_ACT = 88 * MiB;
constexpr size_t WS_W1 = 600 * MiB, WS_XN = 728 * MiB, WS_Y3 = 600 * MiB;
constexpr size_t WS_END = 984 * MiB;
constexpr int CW_TMO = 0, CW_CODE = 1, CW_BAR = 4096, CW_QUEUE = 40000, CW_GCNT = 40960;

constexpr int RING_BYTES = 131072;
constexpr int LDSCTL_OFF = RING_BYTES, MISC_OFF = LDSCTL_OFF + 320, LTAB_OFF = LDSCTL_OFF + 512;
constexpr int LDS_BYTES = 147456;
constexpr int NWAVES = 8;

#define RLX_AGENT __ATOMIC_RELAXED, __HIP_MEMORY_SCOPE_AGENT
#define LDS_WAIT() asm volatile("s_waitcnt lgkmcnt(0)" ::: "memory")
#define VM_WAIT() asm volatile("s_waitcnt vmcnt(0)" ::: "memory")

__device__ __forceinline__ unsigned f2bf(float f) { unsigned u = __builtin_bit_cast(unsigned, f); return (u + 0x7fffu + ((u >> 16) & 1u)) >> 16; }
__device__ __forceinline__ unsigned pk2(float lo, float hi) { return f2bf(lo) | (f2bf(hi) << 16); }
__device__ __forceinline__ float bf2f(unsigned short b) { return __builtin_bit_cast(float, (unsigned)b << 16); }
__device__ __forceinline__ unsigned cvt_pk_bf16(float lo, float hi) { unsigned r; asm volatile("v_cvt_pk_bf16_f32 %0, %1, %2" : "=v"(r) : "v"(lo), "v"(hi)); return r; }
__device__ __forceinline__ u32x4 pack8(f32x4 a, f32x4 b) { u32x4 w; w.x = cvt_pk_bf16(a[0], a[1]); w.y = cvt_pk_bf16(a[2], a[3]); w.z = cvt_pk_bf16(b[0], b[1]); w.w = cvt_pk_bf16(b[2], b[3]); return w; }

namespace pg8 {
constexpr int BM = 256, BK = 64, HALF = 128, HTB = HALF * BK * 2, STAGE_BYTES = 8 * HTB, NXCD = 8, WGM = 8;
constexpr int KD = 1024;
__device__ __forceinline__ int lds_byte(int r, int c) { const int st = (r >> 4) * 2 + (c >> 5), rr = r & 15, cc = c & 31, ob = rr * 64 + cc * 2; return st * 1024 + (ob ^ (((ob >> 9) & 1) << 5)); }
__device__ __forceinline__ void stage_rc(int b, int& R, int& C) { const int st = b / 1024, sb = b % 1024, swz = sb ^ (((sb >> 9) & 1) << 5); R = (st >> 1) * 16 + swz / 64; C = (st & 1) * 32 + (swz % 64) / 2; }
__device__ __forceinline__ int perm32(int rho) { const int n = rho >> 4, i = rho & 15; return 8 * (i >> 2) + 4 * n + (i & 3); }

struct Unit { int pm, pn, e, row0, nrows, arow; };

__device__ __forceinline__ bool tile_order(int i, int G, int c, int nM, int nN, int& pm, int& pn) {
    const int nwg = nM * nN; const long L = (long)i * G + c; if (L >= nwg) return false;
    int wgid = (int)L; { const int q = nwg / NXCD, r = nwg % NXCD, xcd = wgid % NXCD, off = wgid / NXCD; wgid = (xcd < r ? xcd * (q + 1) : r * (q + 1) + (xcd - r) * q) + off; }
    const int nig = WGM * nN, gid = wgid / nig, fm = gid * WGM, gsz = (nM - fm) < WGM ? (nM - fm) : WGM;
    pm = fm + ((wgid % nig) % gsz); pn = (wgid % nig) / gsz; return true;
}

template <class P, bool ALIGN_EPI>
__device__ __forceinline__ void gemm_phase(LAS unsigned char* lds, const P& S) {
    const int tid = threadIdx.x, wid = __builtin_amdgcn_readfirstlane(tid >> 6), lane = tid & 63, wr = wid >> 2, wc = wid & 3, fr = lane & 15, fq = lane >> 4;
    constexpr int K = KD, nt = K / BK;
    unsigned voffB[2]; int RA[2], CA[2];
#pragma unroll
    for (int i = 0; i < 2; ++i) { int R, C; stage_rc(tid * 16 + i * 8192, R, C); const int Rb = P::PERM ? ((R & ~31) + perm32(R & 31)) : R;
        voffB[i] = (unsigned)(Rb * K + C) * 2u; RA[i] = R; CA[i] = C; }
    const size_t kstep = (size_t)(BK * 2);
    const size_t hstep = (size_t)HALF * K * 2;
    const unsigned ldsw = (unsigned)wid * 1024u;
    const int aoff = lds_byte(wr * 64 + fr, fq * 8), boff = lds_byte(wc * 32 + fr, fq * 8);
#define PG8_SA(b, h) (((b) * 2 + (h)) * HTB)
#define PG8_SB(b, h) ((4 + (b) * 2 + (h)) * HTB)
#define PG8_STAGE(bufoff, gbase, voff) do { _Pragma("unroll") for (int _i = 0; _i < 2; ++_i) \
        __builtin_amdgcn_global_load_lds((const unsigned*)((const char*)(gbase) + (voff)[_i]), (LAS unsigned*)(lds + (bufoff) + ldsw + _i * 8192), 16, 0, 0); } while (0)
#define PG8_LDA(dst, b, h) do { _Pragma("unroll") for (int m = 0; m < 4; ++m) _Pragma("unroll") for (int k = 0; k < 2; ++k) dst[m][k] = *(const LAS bf16x8*)(lds + PG8_SA(b, h) + aoff + m * 2048 + k * 1024); } while (0)
#define PG8_LDB(dst, b, h) do { _Pragma("unroll") for (int n = 0; n < 2; ++n) _Pragma("unroll") for (int k = 0; k < 2; ++k) dst[n][k] = *(const LAS bf16x8*)(lds + PG8_SB(b, h) + boff + n * 2048 + k * 1024); } while (0)
#define PG8_MMA(ai, bj, At, Bt) do { __builtin_amdgcn_s_setprio(1); _Pragma("unroll") for (int m = 0; m < 4; ++m) _Pragma("unroll") for (int n = 0; n < 2; ++n) _Pragma("unroll") for (int k = 0; k < 2; ++k) \
        acc[ai][bj][m][n] = __builtin_amdgcn_mfma_f32_16x16x32_bf16(Bt[n][k], At[m][k], acc[ai][bj][m][n], 0, 0, 0); __builtin_amdgcn_s_setprio(0); } while (0)
#define PG8_WAIT_V(n) asm volatile("s_waitcnt vmcnt(" #n ")" ::: "memory")
#define PG8_WAIT_L(n) asm volatile("s_waitcnt lgkmcnt(" #n ")" ::: "memory")
#define PG8_BAR __builtin_amdgcn_s_barrier()
#define PG8_SCHED __builtin_amdgcn_sched_barrier(0)
    Unit cur, nxt; int ui = 0;
    if (!S.next(0, cur)) return;
    f32x4 acc[2][2][4][2];
#pragma unroll
    for (int a = 0; a < 2; ++a)
#pragma unroll
        for (int b = 0; b < 2; ++b)
#pragma unroll
            for (int m = 0; m < 4; ++m)
#pragma unroll
                for (int n = 0; n < 2; ++n) acc[a][b][m][n] = (f32x4){0.f, 0.f, 0.f, 0.f};
    bf16x8 At[4][2], B0[2][2], B1[2][2];
    unsigned vC[2][2], vN[2][2];
    S.a_voff(cur, RA, CA, vC);
    const char* cA = S.a_ptr(cur); const char* cB = S.b_ptr(cur);
    PG8_STAGE(PG8_SB(0, 0), cB, voffB); PG8_STAGE(PG8_SB(0, 1), cB + hstep, voffB); PG8_STAGE(PG8_SA(0, 0), cA, vC[0]); PG8_STAGE(PG8_SA(0, 1), cA, vC[1]);
    if (wr == 1) PG8_BAR;
    PG8_WAIT_V(2); PG8_BAR;
    PG8_STAGE(PG8_SB(1, 0), cB + kstep, voffB); PG8_STAGE(PG8_SA(1, 0), cA + kstep, vC[0]); PG8_STAGE(PG8_SB(1, 1), cB + hstep + kstep, voffB);
    PG8_WAIT_V(6); PG8_BAR;
    for (;;) {
        const bool has_next = S.next(ui + 1, nxt);
        const char* nA = cA; const char* nB = cB;
#pragma unroll
        for (int h = 0; h < 2; ++h)
#pragma unroll
            for (int i = 0; i < 2; ++i) vN[h][i] = vC[h][i];
        if (has_next) { nA = S.a_ptr(nxt); nB = S.b_ptr(nxt); S.a_voff(nxt, RA, CA, vN); }
        for (int t = 0; t < nt; t += 2) {
            const bool last = (t == nt - 2);
            const char* a1 = cA + (size_t)(t + 1) * kstep;
            const char* a2 = last ? nA : cA + (size_t)(t + 2) * kstep; const char* b2 = last ? nB : cB + (size_t)(t + 2) * kstep;
            const char* a3 = a2 + kstep; const char* b3 = b2 + kstep;
            unsigned vS[2][2];
#pragma unroll
            for (int h = 0; h < 2; ++h)
#pragma unroll
                for (int i = 0; i < 2; ++i) vS[h][i] = last ? vN[h][i] : vC[h][i];
            PG8_LDB(B0, 0, 0); PG8_LDB(B1, 0, 1); PG8_SCHED; PG8_LDA(At, 0, 0); PG8_STAGE(PG8_SA(1, 1), a1, vC[1]);
            PG8_WAIT_V(8); PG8_WAIT_L(0); PG8_BAR; PG8_MMA(0, 0, At, B0); PG8_MMA(0, 1, At, B1); PG8_BAR; PG8_SCHED;
            PG8_LDA(At, 0, 1); PG8_STAGE(PG8_SB(0, 0), b2, voffB); PG8_STAGE(PG8_SB(0, 1), b2 + hstep, voffB); PG8_STAGE(PG8_SA(0, 0), a2, vS[0]);
            PG8_WAIT_V(8); PG8_WAIT_L(0); PG8_BAR; PG8_MMA(1, 0, At, B0); PG8_MMA(1, 1, At, B1); PG8_BAR; PG8_SCHED;
            PG8_LDB(B0, 1, 0); PG8_LDB(B1, 1, 1); PG8_SCHED; PG8_LDA(At, 1, 0); PG8_STAGE(PG8_SA(0, 1), a2, vS[1]);
            PG8_WAIT_V(8); PG8_WAIT_L(0); PG8_BAR; PG8_MMA(0, 0, At, B0); PG8_MMA(0, 1, At, B1); PG8_BAR; PG8_SCHED;
            PG8_LDA(At, 1, 1); PG8_STAGE(PG8_SB(1, 0), b3, voffB); PG8_STAGE(PG8_SB(1, 1), b3 + hstep, voffB); PG8_STAGE(PG8_SA(1, 0), a3, vS[0]);
            PG8_WAIT_V(8); PG8_WAIT_L(0); PG8_BAR; PG8_MMA(1, 0, At, B0); PG8_MMA(1, 1, At, B1); PG8_BAR; PG8_SCHED;
        }
        if constexpr (ALIGN_EPI) { if (wr == 0) PG8_BAR; }
        S.epi(acc, cur, wr, wc, fr, fq);
        if (!has_next) break;
#pragma unroll
        for (int a = 0; a < 2; ++a)
#pragma unroll
            for (int b = 0; b < 2; ++b)
#pragma unroll
                for (int m = 0; m < 4; ++m)
#pragma unroll
                    for (int n = 0; n < 2; ++n) acc[a][b][m][n] = (f32x4){0.f, 0.f, 0.f, 0.f};
        cur = nxt; cA = nA; cB = nB; ++ui;
#pragma unroll
        for (int h = 0; h < 2; ++h)
#pragma unroll
            for (int i = 0; i < 2; ++i) vC[h][i] = vN[h][i];
        if constexpr (ALIGN_EPI) { if (wr == 1) PG8_BAR; }
    }
    PG8_WAIT_V(0);
    if constexpr (!ALIGN_EPI) { if (wr == 0) PG8_BAR; }
    PG8_BAR;
#undef PG8_SA
#undef PG8_SB
#undef PG8_STAGE
#undef PG8_LDA
#undef PG8_LDB
#undef PG8_MMA
#undef PG8_WAIT_V
#undef PG8_WAIT_L
#undef PG8_BAR
#undef PG8_SCHED
}

struct DenseBase {
    const bf16_t* A; const bf16_t* Bt; int nM, nN, G, c;
    __device__ __forceinline__ bool next(int i, Unit& u) const { int pm, pn; if (!tile_order(i, G, c, nM, nN, pm, pn)) return false; u.pm = pm; u.pn = pn; u.e = 0; u.row0 = 0; u.nrows = 256; u.arow = pm * 256; return true; }
    __device__ __forceinline__ const char* a_ptr(const Unit& u) const { return (const char*)A + (size_t)u.pm * (size_t)(BM * KD * 2); }
    __device__ __forceinline__ const char* b_ptr(const Unit& u) const { return (const char*)Bt + (size_t)u.pn * (size_t)(BM * KD * 2); }
    __device__ __forceinline__ void a_voff(const Unit&, const int (&RA)[2], const int (&CA)[2], unsigned (&v)[2][2]) const {
#pragma unroll
        for (int h = 0; h < 2; ++h)
#pragma unroll
            for (int i = 0; i < 2; ++i) v[h][i] = (unsigned)((RA[i] + HALF * h) * KD + CA[i]) * 2u; }
};

struct ProbInProj : DenseBase {
    static constexpr bool PERM = true;
    bf16_t* PROJ; const float* rc; const float* rs; const float* mc; const float* ms; float* ksum;
    __device__ __forceinline__ void epi(const f32x4 (&acc)[2][2][4][2], const Unit& u, int wr, int wc, int fr, int fq) const {
        const int pn = u.pn; const int rowt = u.pm * BM + wr * 64 + fr;
        if (pn <= 1) {
            const float sc = pn == 0 ? 1.f : 0.125f;
#pragma unroll
            for (int ai = 0; ai < 2; ++ai)
#pragma unroll
                for (int m = 0; m < 4; ++m) { const int row = rowt + ai * HALF + m * 16, s = row & (SEQ - 1);
                    const f32x4 c0 = *(const f32x4*)(rc + s * 32 + 8 * fq), c1 = *(const f32x4*)(rc + s * 32 + 8 * fq + 4);
                    const f32x4 s0 = *(const f32x4*)(rs + s * 32 + 8 * fq), s1 = *(const f32x4*)(rs + s * 32 + 8 * fq + 4);
                    const f32x4 a0 = acc[ai][0][m][0], a1 = acc[ai][0][m][1], b0 = acc[ai][1][m][0], b1 = acc[ai][1][m][1];
                    const f32x4 o10 = (a0 * c0 - b0 * s0) * sc, o11 = (a1 * c1 - b1 * s1) * sc, o20 = (a0 * s0 + b0 * c0) * sc, o21 = (a1 * s1 + b1 * c1) * sc;
                    bf16_t* dst = PROJ + (size_t)row * DIN + pn * 256 + 64 * wc + 8 * fq;
                    *(u32x4*)dst = pack8(o10, o11); *(u32x4*)(dst + 32) = pack8(o20, o21); asm volatile("" ::: "memory"); }
        } else if (pn >= 6 && pn <= 9) {
            const bool rot = ((wc & 1) == 0) && (fq < 2); const float sc = pn < 8 ? QC2 : 1.f; const bool isk = pn >= 8;
            f32x4 ks[2][2];
#pragma unroll
            for (int bj = 0; bj < 2; ++bj)
#pragma unroll
                for (int n = 0; n < 2; ++n) ks[bj][n] = (f32x4){0.f, 0.f, 0.f, 0.f};
#pragma unroll
            for (int ai = 0; ai < 2; ++ai)
#pragma unroll
                for (int m = 0; m < 4; ++m) { const int row = rowt + ai * HALF + m * 16, s = row & (SEQ - 1);
                    f32x4 c = *(const f32x4*)(mc + s * 8 + 4 * (fq & 1)), sn = *(const f32x4*)(ms + s * 8 + 4 * (fq & 1));
                    if (!rot) { c = (f32x4){1.f, 1.f, 1.f, 1.f}; sn = (f32x4){0.f, 0.f, 0.f, 0.f}; }
#pragma unroll
                    for (int bj = 0; bj < 2; ++bj) { const f32x4 v0 = acc[ai][bj][m][0], v1 = acc[ai][bj][m][1];
                        const f32x4 n0 = (v0 * c - v1 * sn) * sc, n1 = (v0 * sn + v1 * c) * sc;
                        if (isk) { ks[bj][0] += n0; ks[bj][1] += n1; asm volatile("" : "+v"(ks[bj][0]), "+v"(ks[bj][1])); }
                        *(u32x4*)(PROJ + (size_t)row * DIN + pn * 256 + bj * HALF + 32 * wc + 8 * fq) = pack8(n0, n1); }
                    asm volatile("" ::: "memory"); }
            if (isk) {
#pragma unroll
                for (int bj = 0; bj < 2; ++bj)
#pragma unroll
                    for (int n = 0; n < 2; ++n)
#pragma unroll
                        for (int e = 0; e < 4; ++e) { float v = ks[bj][n][e]; v += __shfl_xor(v, 1); v += __shfl_xor(v, 2); v += __shfl_xor(v, 4); v += __shfl_xor(v, 8); ks[bj][n][e] = v; }
                if (fr == 0) {
#pragma unroll
                    for (int bj = 0; bj < 2; ++bj)
#pragma unroll
                        for (int n = 0; n < 2; ++n) *(f32x4*)(ksum + ((size_t)u.pm * 2 + wr) * 512 + (pn - 8) * 256 + bj * HALF + 32 * wc + 8 * fq + 4 * n) = ks[bj][n]; }
            }
        } else {
#pragma unroll
            for (int ai = 0; ai < 2; ++ai)
#pragma unroll
                for (int m = 0; m < 4; ++m) { const int row = rowt + ai * HALF + m * 16;
#pragma unroll
                    for (int bj = 0; bj < 2; ++bj) *(u32x4*)(PROJ + (size_t)row * DIN + pn * 256 + bj * HALF + 32 * wc + 8 * fq) = pack8(acc[ai][bj][m][0], acc[ai][bj][m][1]); }
        }
    }
};

struct ProbOutProj : DenseBase {
    static constexpr bool PERM = false;
    const float* x; float* X1;
    __device__ __forceinline__ void epi(const f32x4 (&acc)[2][2][4][2], const Unit& u, int wr, int wc, int fr, int fq) const {
        const int row0 = u.pm * BM + wr * 64 + fr, col0 = u.pn * BM + wc * 32 + 4 * fq;
#pragma unroll
        for (int ai = 0; ai < 2; ++ai)
#pragma unroll
            for (int m = 0; m < 4; ++m) { const size_t off = (size_t)(row0 + ai * HALF + m * 16) * DM + col0;
#pragma unroll
                for (int bj = 0; bj < 2; ++bj)
#pragma unroll
                    for (int n = 0; n < 2; ++n) *(f32x4*)(X1 + off + bj * HALF + n * 16) = *(const f32x4*)(x + off + bj * HALF + n * 16) + acc[ai][bj][m][n]; }
    }
};

struct MoeBase {
    int T, NP, G, c; const LAS int* tpre; const LAS int* cpre;
    __device__ __forceinline__ bool next(int i, Unit& u) const {
        int pm, pn; if (!tile_order(i, G, c, T, NP, pm, pn)) return false;
        int e = 0;
#pragma unroll 1
        for (; e < NEXP - 1; ++e) { if (pm < __builtin_amdgcn_readfirstlane(tpre[e + 1])) break; }
        const int t0 = __builtin_amdgcn_readfirstlane(tpre[e]), c0 = __builtin_amdgcn_readfirstlane(cpre[e]), c1 = __builtin_amdgcn_readfirstlane(cpre[e + 1]);
        u.pm = pm; u.pn = pn; u.e = e; u.row0 = (pm - t0) * 256; const int rem = (c1 - c0) - u.row0; u.nrows = rem < 256 ? rem : 256; u.arow = c0 + u.row0; return true;
    }
};
struct ProbMoe1 : MoeBase {
    static constexpr bool PERM = true;
    const bf16_t* H2; const bf16_t* W1T; const int* slot; const float* rstd; const float* b1; bf16_t* ACT;
    __device__ __forceinline__ const char* a_ptr(const Unit&) const { return (const char*)H2; }
    __device__ __forceinline__ const char* b_ptr(const Unit& u) const { return (const char*)W1T + ((size_t)u.e * 2048 + (size_t)u.pn * 256) * (size_t)(KD * 2); }
    __device__ __forceinline__ void a_voff(const Unit& u, const int (&RA)[2], const int (&CA)[2], unsigned (&v)[2][2]) const {
#pragma unroll
        for (int h = 0; h < 2; ++h)
#pragma unroll
            for (int i = 0; i < 2; ++i) { int r = RA[i] + HALF * h; r = r < u.nrows ? r : u.nrows - 1; const int pair = slot[(size_t)u.e * NTOK + u.row0 + r]; v[h][i] = (unsigned)(pair >> 2) * (unsigned)(KD * 2) + (unsigned)CA[i] * 2u; } }
    __device__ __forceinline__ void epi(const f32x4 (&acc)[2][2][4][2], const Unit& u, int wr, int wc, int fr, int fq) const {
        const int cc0 = 32 * wc + 8 * fq; const float* bb = b1 + (size_t)u.e * 2048 + 128 * u.pn + cc0;
        const f32x4 bg0 = *(const f32x4*)bb, bg1 = *(const f32x4*)(bb + 4), bl0 = *(const f32x4*)(bb + 1024), bl1 = *(const f32x4*)(bb + 1028);
#pragma unroll
        for (int ai = 0; ai < 2; ++ai)
#pragma unroll
            for (int m = 0; m < 4; ++m) { const int r = ai * HALF + wr * 64 + m * 16 + fr; const bool valid = r < u.nrows; const int rr = valid ? r : u.nrows - 1;
                const int pair = slot[(size_t)u.e * NTOK + u.row0 + rr]; const float rs = rstd[pair >> 2];
                f32x4 o[2];
#pragma unroll
                for (int n = 0; n < 2; ++n) { f32x4 g = acc[ai][0][m][n] * rs + (n ? bg1 : bg0), l = acc[ai][1][m][n] * rs + (n ? bl1 : bl0);
#pragma unroll
                    for (int e = 0; e < 4; ++e) { const float gg = fminf(g[e], 7.f), ll = fminf(fmaxf(l[e], -7.f), 7.f);
                        const float sg = __builtin_amdgcn_rcpf(1.f + __builtin_amdgcn_exp2f(gg * (-1.702f * 1.4426950408889634f))); o[n][e] = gg * sg * (ll + 1.f); } }
                if (valid) *(u32x4*)(ACT + (size_t)(u.arow + r) * DM + 128 * u.pn + cc0) = pack8(o[0], o[1]); }
    }
};
struct ProbMoe2 : MoeBase {
    static constexpr bool PERM = true;
    const bf16_t* ACT; const bf16_t* W2T; const int* slot; const float* gate; const float* b2; float* X1; bf16_t* Y3;
    __device__ __forceinline__ const char* a_ptr(const Unit& u) const { return (const char*)ACT + (size_t)u.arow * (size_t)(KD * 2); }
    __device__ __forceinline__ const char* b_ptr(const Unit& u) const { return (const char*)W2T + ((size_t)u.e * 1024 + (size_t)u.pn * 256) * (size_t)(KD * 2); }
    __device__ __forceinline__ void a_voff(const Unit& u, const int (&RA)[2], const int (&CA)[2], unsigned (&v)[2][2]) const {
#pragma unroll
        for (int h = 0; h < 2; ++h)
#pragma unroll
            for (int i = 0; i < 2; ++i) { int r = RA[i] + HALF * h; r = r < u.nrows ? r : u.nrows - 1; v[h][i] = (unsigned)(r * KD + CA[i]) * 2u; } }
    __device__ __forceinline__ void epi(const f32x4 (&acc)[2][2][4][2], const Unit& u, int wr, int wc, int fr, int fq) const {
        const int col0 = u.pn * BM + 32 * wc + 8 * fq; const float* bb = b2 + (size_t)u.e * 1024 + col0;
        f32x4 bv[2][2];
#pragma unroll
        for (int bj = 0; bj < 2; ++bj)
#pragma unroll
            for (int n = 0; n < 2; ++n) bv[bj][n] = *(const f32x4*)(bb + bj * HALF + 4 * n);
#pragma unroll
        for (int ai = 0; ai < 2; ++ai)
#pragma unroll
            for (int m = 0; m < 4; ++m) { const int r = ai * HALF + wr * 64 + m * 16 + fr; const bool valid = r < u.nrows; const int rr = valid ? r : u.nrows - 1;
                const int pair = slot[(size_t)u.e * NTOK + u.row0 + rr]; const float gt = gate[pair]; const int tok = pair >> 2, k = pair & 3;
                if (valid) {
                    if (k == 0) { float* p = X1 + (size_t)tok * DM + col0;
#pragma unroll
                        for (int bj = 0; bj < 2; ++bj)
#pragma unroll
                            for (int n = 0; n < 2; ++n) { f32x4* q = (f32x4*)(p + bj * HALF + 4 * n); *q = *q + (acc[ai][bj][m][n] + bv[bj][n]) * gt; } }
                    else { bf16_t* p = Y3 + ((size_t)tok * 3 + (k - 1)) * DM + col0;
#pragma unroll
                        for (int bj = 0; bj < 2; ++bj) *(u32x4*)(p + bj * HALF) = pack8((acc[ai][bj][m][0] + bv[bj][0]) * gt, (acc[ai][bj][m][1] + bv[bj][1]) * gt); }
                } }
    }
};
}

namespace moba {
using bf16 = __hip_bfloat16;
constexpr int D = 64, PP = DIN, OP = DM;
constexpr int NW = 8, QBLK = 32, QB = QBLK * NW, KVBLK = 64;
__device__ __forceinline__ int crow(int r, int hi) { return (r & 3) + 8 * (r >> 2) + 4 * hi; }
#define SBAR() __builtin_amdgcn_sched_barrier(0)
__device__ __forceinline__ void cmask(f32x16& p0, f32x16& p1, int jb, int qrel, int hi) {
  const float NEG = -INFINITY; int kb = 64 * jb + 4 * hi;
  #pragma unroll
  for (int r = 0; r < 16; ++r) { int kv = kb + (r & 3) + 8 * (r >> 2); if (kv > qrel) p0[r] = NEG; if (kv + 32 > qrel) p1[r] = NEG; }
}
constexpr int NSLOT = 3, SLOTB = 8192;
constexpr int LDS_K = 0, LDS_V = NSLOT * SLOTB, LDS_WS = 2 * NSLOT * SLOTB, LDS_OST = LDS_WS + NW * 64 * 4, LDS_BYTES_A = LDS_OST + NW * 4096;
__device__ __forceinline__ void glds16s(const void* sbase, unsigned voff, unsigned lds_dst) { unsigned keep;
  asm volatile("s_mov_b32 %0, m0\n\ts_mov_b32 m0, %3\n\ts_nop 4\n\tglobal_load_lds_dwordx4 %1, %2\n\ts_mov_b32 m0, %0" : "=&s"(keep) : "v"(voff), "s"(sbase), "s"(lds_dst) : "memory"); }
__device__ __forceinline__ float max3f(float a, float b, float c) { float r; asm("v_max3_f32 %0, %1, %2, %3" : "=v"(r) : "v"(a), "v"(b), "v"(c)); return r; }
__device__ __forceinline__ float max2f(float a, float b) { float r; asm("v_max_f32_e32 %0, %1, %2" : "=v"(r) : "v"(a), "v"(b)); return r; }
__device__ __forceinline__ float fadd_s(float a, float b) { float r; asm("v_add_f32_e32 %0, %1, %2" : "=v"(r) : "v"(a), "v"(b)); return r; }
__device__ __forceinline__ float fsub_s(float a, float b) { float r; asm("v_sub_f32_e32 %0, %1, %2" : "=v"(r) : "v"(a), "v"(b)); return r; }
typedef __bf16 bf16x2_t __attribute__((ext_vector_type(2)));
__device__ __forceinline__ unsigned cvtpk_s(float lo, float hi) { f32x2 v = {lo, hi}; bf16x2_t b = __builtin_convertvector(v, bf16x2_t); return __builtin_bit_cast(unsigned, b); }
#define WAIT_BAR(N) asm volatile("s_waitcnt vmcnt(" #N ") lgkmcnt(0)\n\ts_barrier" ::: "memory")
__device__ __forceinline__ void qkt(f32x16& p0, f32x16& p1, const char* Kslot, const bf16x8* qr, const f32x16& negm, int r32, int hi) {
  const char* kb = Kslot + hi * 1024 + r32 * 16;
  #pragma unroll
  for (int d0 = 0; d0 < 4; ++d0) {
    const bf16x8 b0 = *reinterpret_cast<const bf16x8*>(kb + d0 * 2048);
    const bf16x8 b1 = *reinterpret_cast<const bf16x8*>(kb + d0 * 2048 + 512);
    if (d0 == 0) { p0 = __builtin_amdgcn_mfma_f32_32x32x16_bf16(b0, qr[0], negm, 0, 0, 0); p1 = __builtin_amdgcn_mfma_f32_32x32x16_bf16(b1, qr[0], negm, 0, 0, 0); }
    else { p0 = __builtin_amdgcn_mfma_f32_32x32x16_bf16(b0, qr[d0], p0, 0, 0, 0); p1 = __builtin_amdgcn_mfma_f32_32x32x16_bf16(b1, qr[d0], p1, 0, 0, 0); } }
}
typedef LAS const char* lds_cptr;
typedef short v4i16_t __attribute__((ext_vector_type(4)));
__device__ __forceinline__ void kload8(bf16x8* kf, lds_cptr kp) {
  kf[0] = *(const LAS bf16x8*)(kp);        kf[1] = *(const LAS bf16x8*)(kp + 512);
  kf[2] = *(const LAS bf16x8*)(kp + 2048); kf[3] = *(const LAS bf16x8*)(kp + 2560);
  kf[4] = *(const LAS bf16x8*)(kp + 4096); kf[5] = *(const LAS bf16x8*)(kp + 4608);
  kf[6] = *(const LAS bf16x8*)(kp + 6144); kf[7] = *(const LAS bf16x8*)(kp + 6656);
}
__device__ __forceinline__ void kload2(bf16x8* kf, lds_cptr kp, int j) { kf[2 * j] = *(const LAS bf16x8*)(kp + j * 2048); kf[2 * j + 1] = *(const LAS bf16x8*)(kp + j * 2048 + 512); }
__device__ __forceinline__ s16x4 vtr(lds_cptr p) { return __builtin_bit_cast(s16x4, __builtin_amdgcn_ds_read_tr16_b64_v4i16((LAS v4i16_t*)p)); }
__device__ __forceinline__ float rowmax(const f32x16& p0, const f32x16& p1) {
  float a = max3f(p0[0], p0[1], p1[0]), b = max3f(p0[2], p0[3], p1[1]); a = max3f(a, p1[2], p1[3]);
  #pragma unroll
  for (int r = 4; r < 16; r += 4) { a = max3f(a, p0[r], p0[r + 1]); b = max3f(b, p0[r + 2], p0[r + 3]); a = max3f(a, p1[r], p1[r + 1]); b = max3f(b, p1[r + 2], p1[r + 3]); }
  const float m = max2f(a, b);
  auto rr = __builtin_amdgcn_permlane32_swap(__float_as_uint(m), __float_as_uint(m), false, false);
  return max2f(__uint_as_float(rr[0]), __uint_as_float(rr[1]));
}
__device__ __forceinline__ void pv(f32x16* o, int vb, bf16x8 pa0, bf16x8 pa1, bf16x8 pa2, bf16x8 pa3) {
  #pragma unroll
  for (int d0 = 0; d0 < 2; ++d0) { s16x4 lo[4], hi[4];
    #pragma unroll
    for (int ks = 0; ks < 4; ++ks) {
      asm volatile("ds_read_b64_tr_b16 %0,%1 offset:%c2" : "=&v"(lo[ks]) : "v"(vb), "i"(d0 * 4096 + ks * 1024) : "memory");
      asm volatile("ds_read_b64_tr_b16 %0,%1 offset:%c2" : "=&v"(hi[ks]) : "v"(vb), "i"(d0 * 4096 + ks * 1024 + 512) : "memory"); }
    asm volatile("s_waitcnt lgkmcnt(0)" ::: "memory"); SBAR();
    #define PK(k) (bf16x8){lo[k][0], lo[k][1], lo[k][2], lo[k][3], hi[k][0], hi[k][1], hi[k][2], hi[k][3]}
    o[d0] = __builtin_amdgcn_mfma_f32_32x32x16_bf16(pa0, PK(0), o[d0], 0, 0, 0);
    o[d0] = __builtin_amdgcn_mfma_f32_32x32x16_bf16(pa1, PK(1), o[d0], 0, 0, 0);
    o[d0] = __builtin_amdgcn_mfma_f32_32x32x16_bf16(pa2, PK(2), o[d0], 0, 0, 0);
    o[d0] = __builtin_amdgcn_mfma_f32_32x32x16_bf16(pa3, PK(3), o[d0], 0, 0, 0);
    #undef PK
  }
}

template <int THRL> __device__ __forceinline__ void moba_unit(int b, int h, int qb, const bf16* PROJ, const float* ksum, bf16* MIX, char* shm) {
  int tid_ = threadIdx.x; asm volatile("" : "+v"(tid_));
  const int tid = tid_, lane = tid & 63, r32 = lane & 31, hi = lane >> 5; const int wid = __builtin_amdgcn_readfirstlane(tid >> 6);
  const long rowbase = (long)b * SEQ; const int q0 = qb * QB;
  const bf16* Qw = PROJ + (rowbase + q0 + wid * QBLK) * PP + PC_MQ + h * D;
  const bf16* Kh = PROJ + rowbase * PP + PC_MK + h * D, *Vh = PROJ + rowbase * PP + PC_MV + h * D;
  const unsigned lds0 = (unsigned)(uintptr_t)shm;
  float* wsf = (float*)(shm + LDS_WS) + wid * 64;
  const unsigned kvo = (unsigned)(lane * PP + wid * 8) * 2u;
  const unsigned vvo = (unsigned)((16 * (wid & 3) + (lane >> 2)) * PP + (wid >> 2) * 32 + (lane & 3) * 8) * 2u;
  const unsigned kdst = lds0 + LDS_K + wid * 1024, vdst = lds0 + LDS_V + wid * 1024;
  const int tb4 = 4 * qb;
  #define TM(t) (((t) < 4) ? (tb4 + (t)) : ((t) - 4))
  #define DMA_K(t, slot) glds16s(Kh + (long)TM(t) * KVBLK * PP, kvo, (unsigned)__builtin_amdgcn_readfirstlane(kdst + (slot)))
  #define DMA_V(t, slot) glds16s(Vh + (long)TM(t) * KVBLK * PP, vvo, (unsigned)__builtin_amdgcn_readfirstlane(vdst + (slot)))
  const int vb0 = (int)(lds0 + LDS_V) + ((lane >> 4) & 1) * 32 + (lane & 3) * 8 + (4 * hi + ((lane & 15) >> 2)) * 64;
  const char* Kbase = shm + LDS_K; bf16x8 kf[8];
  const lds_cptr shm3 = (lds_cptr)shm; const lds_cptr kp0 = shm3 + LDS_K + hi * 1024 + r32 * 16; const lds_cptr vp0 = shm3 + LDS_V + ((lane >> 4) & 1) * 32 + (lane & 3) * 8 + (4 * hi + ((lane & 15) >> 2)) * 64;
  const int NT = tb4 + 4;
  DMA_K(0, 0); DMA_V(0, 0); DMA_K(1, SLOTB);
  bf16x8 qr[4];
  #pragma unroll
  for (int d0 = 0; d0 < 4; ++d0) qr[d0] = *reinterpret_cast<const bf16x8*>(&Qw[(long)r32 * PP + d0 * 16 + hi * 8]);
  unsigned sel = (1u << qb) - 1u;
  if (qb > 3) {
    float v1 = -INFINITY, v2 = -INFINITY, v3 = -INFINITY; int i1 = 0, i2 = 0, i3 = 0;
    #pragma unroll 1
    for (int j = 0; j < qb; ++j) {
      const float* k0 = ksum + ((size_t)(b * 8 + j) * 2) * 512 + h * D + hi * 8; float p = 0.f;
      #pragma unroll
      for (int d0 = 0; d0 < 4; ++d0) { const f32x4 a0 = *(const f32x4*)(k0 + 16 * d0) + *(const f32x4*)(k0 + 512 + 16 * d0), a1 = *(const f32x4*)(k0 + 16 * d0 + 4) + *(const f32x4*)(k0 + 512 + 16 * d0 + 4);
        #pragma unroll
        for (int i = 0; i < 4; ++i) { p += bf2f((unsigned short)qr[d0][i]) * a0[i]; p += bf2f((unsigned short)qr[d0][4 + i]) * a1[i]; } }
      p += __shfl_xor(p, 32);
      if (p > v1) { v3 = v2; i3 = i2; v2 = v1; i2 = i1; v1 = p; i1 = j; } else if (p > v2) { v3 = v2; i3 = i2; v2 = p; i2 = j; } else if (p > v3) { v3 = p; i3 = j; }
    }
    sel = (1u << i1) | (1u << i2) | (1u << i3);
  }
  float mhat = 0.f, l_reg = 0.f; f32x16 o[2]; o[0] = f32x16{}; o[1] = f32x16{}; const f32x16 zero16 = f32x16{};
  const int qrel = wid * QBLK + r32;
  #define CMASK(P0, P1, t) do { if ((t) < 4) cmask(P0, P1, (t), qrel, hi); } while (0)
  #define NVAL(t) (((t) >= 4 && !((sel >> (((t) - 4) >> 2)) & 1u)) ? -INFINITY : -mhat)
  bool resc = false;
  #define START(P0, P1) do { const float rm = rowmax(P0, P1); resc = false; \
    { const float dl = rm; mhat = fadd_s(mhat, dl); \
      _Pragma("unroll") for (int r = 0; r < 16; ++r) { P0[r] = fsub_s(P0[r], dl); P1[r] = fsub_s(P1[r], dl); } } \
    _Pragma("unroll") for (int r = 0; r < 16; ++r) P0[r] = __builtin_amdgcn_exp2f(P0[r]); } while (0)
  #define RESC() do { if (resc) { asm volatile("s_waitcnt lgkmcnt(0)" ::: "memory"); \
      _Pragma("unroll") for (int d_ = 0; d_ < 2; ++d_) _Pragma("unroll") for (int r = 0; r < 16; ++r) o[d_][r] *= wsf[crow(r, hi)]; } } while (0)
  f32x16 pA0, pA1, pB0, pB1;
  int sl_prev = 0, sl_cur = 0, sl_next = SLOTB;
  #define ROT() do { sl_prev = sl_cur; sl_cur = sl_next; sl_next = (sl_next == (NSLOT - 1) * SLOTB) ? 0 : sl_next + SLOTB; } while (0)
  DMA_K(2, 2 * SLOTB);
  WAIT_BAR(3);
  qkt(pA0, pA1, Kbase, qr, zero16, r32, hi); asm volatile("s_nop 15\n\ts_nop 7" : "+v"(pA0), "+v"(pA1)); CMASK(pA0, pA1, 0);
  START(pA0, pA1);
  _Pragma("unroll") for (int r = 0; r < 16; ++r) pA1[r] = __builtin_amdgcn_exp2f(pA1[r]);
  WAIT_BAR(0);
  DMA_K(3, 0); DMA_V(1, SLOTB);
  ROT();
  kload8(kf, kp0 + sl_cur);
  WAIT_BAR(2);
  s16x4 vlo[8], vhi[8]; u32x4 pw0, pw1, pw2, pw3;
  #define PKW(P, B) cvtpk_s(P[B], P[B + 1])
  #define PAF(k) __builtin_bit_cast(bf16x8, pw##k)
  #define VFR(i) (bf16x8){vlo[i][0], vlo[i][1], vlo[i][2], vlo[i][3], vhi[i][0], vhi[i][1], vhi[i][2], vhi[i][3]}
  #define PIN(x) asm volatile("" : "+v"(x))
  #define MX3(a, b, c) __builtin_fmaxf(__builtin_fmaxf((a), (b)), (c))
  #define GAPA(MF, A0, A1, A2, A3, W0, W1, PW) do { MF; sacc += A0; sacc += A1; sacc += A2; sacc += A3; PIN(sacc); W0; W1; PIN(PW); SBAR(); } while (0)
  #define EX(v) __builtin_amdgcn_exp2f(v)
  #define GAPB(MF, X, B) do { MF; X[B] = EX(X[B]); X[B + 1] = EX(X[B + 1]); X[B + 2] = EX(X[B + 2]); X[B + 3] = EX(X[B + 3]); PIN(X); SBAR(); } while (0)
  #define VRD(i) do { vlo[i] = vtr(vp_ + (((i) >> 2) * 4096 + ((i) & 3) * 1024)); vhi[i] = vtr(vp_ + (((i) >> 2) * 4096 + ((i) & 3) * 1024 + 512)); } while (0)
  #define KRD(G, j) do { if (G) { kload2(kf, kp0 + sl_next, j); SBAR(); } } while (0)
  #define STEP(C0, C1, P0, P1, t, GK, GV, GL) do { const float nv_ = NVAL(t); SBAR(); \
    const lds_cptr vp_ = vp0 + sl_prev; \
    VRD(0); SBAR(); float sacc = (P0[0] + P0[1]); \
    GAPA(C0 = __builtin_amdgcn_mfma_f32_32x32x16_bf16(kf[0], qr[0], zero16, 0, 0, 0), P0[2], P0[3], P0[4], P0[5],     pw0[0] = PKW(P0, 0), pw0[1] = PKW(P0, 2), pw0); \
    VRD(4); SBAR(); GAPA(C1 = __builtin_amdgcn_mfma_f32_32x32x16_bf16(kf[1], qr[0], zero16, 0, 0, 0), P0[6], P0[7], P0[8], P0[9],     pw0[2] = PKW(P0, 4), pw0[3] = PKW(P0, 6), pw0); \
    VRD(1); SBAR(); GAPA(C0 = __builtin_amdgcn_mfma_f32_32x32x16_bf16(kf[2], qr[1], C0, 0, 0, 0),   P0[10], P0[11], P0[12], P0[13], pw1[0] = PKW(P0, 8), pw1[1] = PKW(P0, 10), pw1); \
    VRD(5); SBAR(); GAPA(C1 = __builtin_amdgcn_mfma_f32_32x32x16_bf16(kf[3], qr[1], C1, 0, 0, 0),   P0[14], P0[15], P1[0], P1[1],   pw1[2] = PKW(P0, 12), pw1[3] = PKW(P0, 14), pw1); \
    VRD(2); SBAR(); GAPA(C0 = __builtin_amdgcn_mfma_f32_32x32x16_bf16(kf[4], qr[2], C0, 0, 0, 0),   P1[2], P1[3], P1[4], P1[5],     pw2[0] = PKW(P1, 0), pw2[1] = PKW(P1, 2), pw2); \
    VRD(6); SBAR(); GAPA(C1 = __builtin_amdgcn_mfma_f32_32x32x16_bf16(kf[5], qr[2], C1, 0, 0, 0),   P1[6], P1[7], P1[8], P1[9],     pw2[2] = PKW(P1, 4), pw2[3] = PKW(P1, 6), pw2); \
    VRD(3); SBAR(); GAPA(C0 = __builtin_amdgcn_mfma_f32_32x32x16_bf16(kf[6], qr[3], C0, 0, 0, 0),   P1[10], P1[11], P1[12], P1[13], pw3[0] = PKW(P1, 8), pw3[1] = PKW(P1, 10), pw3); \
    VRD(7); SBAR(); GAPA(C1 = __builtin_amdgcn_mfma_f32_32x32x16_bf16(kf[7], qr[3], C1, 0, 0, 0),   P1[14], P1[15], 0.f, 0.f,       pw3[2] = PKW(P1, 12), pw3[3] = PKW(P1, 14), pw3); \
    l_reg += sacc; \
    if (GK) { DMA_K((t) + 3, sl_cur); } if (GV) { DMA_V((t) + 1, sl_next); } \
    _Pragma("unroll") for (int r = 0; r < 16; ++r) { C0[r] += nv_; C1[r] += nv_; } \
    CMASK(C0, C1, t); \
    { float a = MX3(C0[0], C0[1], C1[0]), b = MX3(C0[2], C0[3], C1[1]); a = MX3(a, C1[2], C1[3]); \
      _Pragma("unroll") for (int r = 4; r < 16; r += 4) { a = MX3(a, C0[r], C0[r + 1]); b = MX3(b, C0[r + 2], C0[r + 3]); a = MX3(a, C1[r], C1[r + 1]); b = MX3(b, C1[r + 2], C1[r + 3]); } \
      float rm = __builtin_fmaxf(a, b); { auto rr = __builtin_amdgcn_permlane32_swap(__float_as_uint(rm), __float_as_uint(rm), false, false); rm = __builtin_fmaxf(__uint_as_float(rr[0]), __uint_as_float(rr[1])); } \
      resc = false; \
      if (__builtin_expect(__any(rm > (float)THRL), 0)) { const float dl = __builtin_fmaxf(rm, 0.f); mhat += dl; \
        _Pragma("unroll") for (int r = 0; r < 16; ++r) { C0[r] -= dl; C1[r] -= dl; } \
        const float f = __builtin_amdgcn_exp2f(-dl); l_reg *= f; if (hi == 0) wsf[r32] = f; resc = true; } } \
    SBAR(); \
    GAPB(o[0] = __builtin_amdgcn_mfma_f32_32x32x16_bf16(PAF(0), VFR(0), o[0], 0, 0, 0), C0, 0); \
    GAPB(o[1] = __builtin_amdgcn_mfma_f32_32x32x16_bf16(PAF(0), VFR(4), o[1], 0, 0, 0), C0, 4); \
    KRD(GL, 0); GAPB(o[0] = __builtin_amdgcn_mfma_f32_32x32x16_bf16(PAF(1), VFR(1), o[0], 0, 0, 0), C0, 8); \
    KRD(GL, 1); GAPB(o[1] = __builtin_amdgcn_mfma_f32_32x32x16_bf16(PAF(1), VFR(5), o[1], 0, 0, 0), C0, 12); \
    KRD(GL, 2); GAPB(o[0] = __builtin_amdgcn_mfma_f32_32x32x16_bf16(PAF(2), VFR(2), o[0], 0, 0, 0), C1, 0); \
    KRD(GL, 3); GAPB(o[1] = __builtin_amdgcn_mfma_f32_32x32x16_bf16(PAF(2), VFR(6), o[1], 0, 0, 0), C1, 4); \
    GAPB(o[0] = __builtin_amdgcn_mfma_f32_32x32x16_bf16(PAF(3), VFR(3), o[0], 0, 0, 0), C1, 8); \
    GAPB(o[1] = __builtin_amdgcn_mfma_f32_32x32x16_bf16(PAF(3), VFR(7), o[1], 0, 0, 0), C1, 12); \
    } while (0)
  int t = 1;
  for (; t + 1 < NT; t += 2) {
    STEP(pB0, pB1, pA0, pA1, t, true, true, true);     WAIT_BAR(2); RESC(); ROT();
    STEP(pA0, pA1, pB0, pB1, t + 1, true, true, true); WAIT_BAR(2); RESC(); ROT();
  }
  STEP(pB0, pB1, pA0, pA1, NT - 1, true, true, true); WAIT_BAR(2); RESC();
  { float sacc = pB0[0] + pB0[1]; _Pragma("unroll") for (int r = 2; r < 16; ++r) sacc += pB0[r]; _Pragma("unroll") for (int r = 0; r < 16; ++r) sacc += pB1[r]; l_reg += sacc;
    pw0 = (u32x4){PKW(pB0, 0), PKW(pB0, 2), PKW(pB0, 4), PKW(pB0, 6)}; pw1 = (u32x4){PKW(pB0, 8), PKW(pB0, 10), PKW(pB0, 12), PKW(pB0, 14)}; pw2 = (u32x4){PKW(pB1, 0), PKW(pB1, 2), PKW(pB1, 4), PKW(pB1, 6)}; pw3 = (u32x4){PKW(pB1, 8), PKW(pB1, 10), PKW(pB1, 12), PKW(pB1, 14)};
    SBAR(); pv(o, vb0 + sl_cur, PAF(0), PAF(1), PAF(2), PAF(3)); }
  #undef PKW
  #undef PAF
  #undef VFR
  #undef PIN
  #undef MX3
  #undef GAPA
  #undef GAPB
  #undef EX
  #undef VRD
  #undef KRD
  #undef STEP
  { auto rr = __builtin_amdgcn_permlane32_swap(__float_as_uint(l_reg), __float_as_uint(l_reg), false, false); l_reg = __uint_as_float(rr[0]) + __uint_as_float(rr[1]); }
  if (hi == 0) wsf[32 + r32] = l_reg; asm volatile("s_waitcnt lgkmcnt(0)" ::: "memory");
  float rli[16];
  #pragma unroll
  for (int r = 0; r < 16; ++r) rli[r] = __builtin_amdgcn_rcpf(wsf[32 + crow(r, hi)]);
  bf16* Ow = MIX + (rowbase + q0 + wid * QBLK) * OP + 512 + h * D;
  { bf16* stg = (bf16*)(shm + LDS_OST) + wid * 2048;
    #pragma unroll
    for (int r = 0; r < 16; ++r) { const int orow = crow(r, hi);
      #pragma unroll
      for (int d0 = 0; d0 < 2; ++d0) stg[orow * 64 + d0 * 32 + r32] = __float2bfloat16(o[d0][r] * rli[r]); }
    asm volatile("s_waitcnt lgkmcnt(0)" ::: "memory");
    #pragma unroll
    for (int i = 0; i < 4; ++i) { const int row = i * 8 + (lane >> 3), ch = lane & 7; const u32x4 v = *(const u32x4*)(stg + row * 64 + ch * 8); *(u32x4*)(Ow + (long)row * OP + ch * 8) = v; } }
  asm volatile("s_waitcnt vmcnt(0) lgkmcnt(0)\n\ts_barrier" ::: "memory");
  #undef DMA_K
  #undef DMA_V
  #undef TM
  #undef CMASK
  #undef NVAL
  #undef START
  #undef RESC
  #undef ROT
}
#undef WAIT_BAR
}

namespace ret {
constexpr int KS_STR = 144, V_STR = 272;
constexpr int L_KS = 0, L_KH = 18432, L_VS = 36864, L_RT = 71680, L_END = 90112;
typedef short v4i16_t __attribute__((ext_vector_type(4)));
__device__ __forceinline__ s16x4 vtr(LAS const char* p) { return __builtin_bit_cast(s16x4, __builtin_amdgcn_ds_read_tr16_b64_v4i16((LAS v4i16_t*)p)); }
__device__ __forceinline__ bf16x8 cat8(s16x4 a, s16x4 b) { return (bf16x8){a[0], a[1], a[2], a[3], b[0], b[1], b[2], b[3]}; }

__device__ __forceinline__ void ret_unit(int b, int h, const bf16_t* PROJ, const float* rnw, bf16_t* MIX, LAS unsigned char* lds) {
    int tid_ = threadIdx.x; asm volatile("" : "+v"(tid_));
    const int tid = tid_, lane = tid & 63, c16 = lane & 15, g = lane >> 4; const int w = __builtin_amdgcn_readfirstlane(tid >> 6);
    const float log2g = log2f(1.0f - exp2f(-5.0f - (float)h));
    const float gC = exp2f(log2g * 128.0f);
    LAS unsigned char* Ks = lds + L_KS; LAS unsigned char* Kh = lds + L_KH; LAS unsigned char* Vs = lds + L_VS; LAS unsigned char* Rt = lds + L_RT;
    for (int i = tid; i < (L_END - L_RT) / 16; i += 512) *(LAS u32x4*)(Rt + i * 16) = (u32x4){0u, 0u, 0u, 0u};
    f32x4 Racc[4];
#pragma unroll
    for (int dt = 0; dt < 4; ++dt) Racc[dt] = (f32x4){0.f, 0.f, 0.f, 0.f};
    const size_t tokb = (size_t)b * SEQ;
    u32x4 kreg[2], vreg[4]; bf16x8 qn[2];
    const int krow0 = tid >> 3, kcc = tid & 7, vrow0 = tid >> 4, vcc = tid & 15;
#define RET_LOAD(c) do { const bf16_t* base = PROJ + (tokb + (size_t)(c) * 128) * DIN; \
        _Pragma("unroll") for (int i = 0; i < 2; ++i) kreg[i] = *(const u32x4*)(base + (size_t)(krow0 + 64 * i) * DIN + PC_RK + 64 * h + 8 * kcc); \
        _Pragma("unroll") for (int i = 0; i < 4; ++i) vreg[i] = *(const u32x4*)(base + (size_t)(vrow0 + 32 * i) * DIN + PC_RV + 128 * h + 8 * vcc); \
        _Pragma("unroll") for (int k2 = 0; k2 < 2; ++k2) qn[k2] = *(const bf16x8*)(base + (size_t)(16 * w + c16) * DIN + PC_RQ + 64 * h + 32 * k2 + 8 * g); } while (0)
    RET_LOAD(0);
    for (int c = 0; c < 16; ++c) {
#pragma unroll
        for (int i = 0; i < 2; ++i) { const int row = krow0 + 64 * i; *(LAS u32x4*)(Ks + row * KS_STR + kcc * 16) = kreg[i];
            const float z = exp2f(log2g * (float)(127 - row)); u32x4 s;
#pragma unroll
            for (int j = 0; j < 4; ++j) { const unsigned u = kreg[i][j]; s[j] = pk2(bf2f((unsigned short)(u & 0xffffu)) * z, bf2f((unsigned short)(u >> 16)) * z); }
            *(LAS u32x4*)(Kh + row * KS_STR + kcc * 16) = s; }
#pragma unroll
        for (int i = 0; i < 4; ++i) { const int row = vrow0 + 32 * i; *(LAS u32x4*)(Vs + row * V_STR + vcc * 16) = vreg[i]; }
        bf16x8 qf[2]; qf[0] = qn[0]; qf[1] = qn[1];
        __syncthreads();
        if (c + 1 < 16) RET_LOAD(c + 1);
        f32x4 oi[8], oc[8];
#pragma unroll
        for (int et = 0; et < 8; ++et) { oi[et] = (f32x4){0.f, 0.f, 0.f, 0.f}; oc[et] = (f32x4){0.f, 0.f, 0.f, 0.f}; }
        const int trq = c16 >> 2, trp = c16 & 3;
        const int nks = (w >> 1) + 1;
        LAS const char* ksb = (LAS const char*)Ks + c16 * KS_STR + g * 16;
        LAS const char* vtb = (LAS const char*)Vs + (4 * g + trq) * V_STR + trp * 8;
        LAS const char* khb = (LAS const char*)Kh + (4 * g + trq) * KS_STR + trp * 8;
        LAS const char* rtb = (LAS const char*)Rt + c16 * KS_STR + g * 16;
#pragma unroll 1
        for (int ks = 0; ks < nks; ++ks) {
            u32x4 pw;
#pragma unroll
            for (int half = 0; half < 2; ++half) { const int mt = 2 * ks + half; f32x4 st = (f32x4){0.f, 0.f, 0.f, 0.f};
                if (mt <= w) {
#pragma unroll
                    for (int k2 = 0; k2 < 2; ++k2) { const bf16x8 ka = *(const LAS bf16x8*)(ksb + mt * (16 * KS_STR) + k2 * 64);
                        st = __builtin_amdgcn_mfma_f32_16x16x32_bf16(ka, qf[k2], st, 0, 0, 0); } }
                float pv_[4];
#pragma unroll
                for (int r = 0; r < 4; ++r) { const int diff = (16 * w + c16) - (16 * mt + 4 * g + r); pv_[r] = diff >= 0 ? st[r] * exp2f(log2g * (float)diff) : 0.f; }
                pw[2 * half] = pk2(pv_[0], pv_[1]); pw[2 * half + 1] = pk2(pv_[2], pv_[3]); }
            const bf16x8 pf = __builtin_bit_cast(bf16x8, pw);
            LAS const char* vp = vtb + ks * (32 * V_STR);
#pragma unroll
            for (int et = 0; et < 8; ++et) { const bf16x8 vf = cat8(vtr(vp + et * 32), vtr(vp + et * 32 + 16 * V_STR));
                oi[et] = __builtin_amdgcn_mfma_f32_16x16x32_bf16(pf, vf, oi[et], 0, 0, 0); }
        }
#pragma unroll
        for (int k2 = 0; k2 < 2; ++k2)
#pragma unroll
            for (int et = 0; et < 8; ++et) { const bf16x8 rf = *(const LAS bf16x8*)(rtb + et * (16 * KS_STR) + k2 * 64);
                oc[et] = __builtin_amdgcn_mfma_f32_16x16x32_bf16(qf[k2], rf, oc[et], 0, 0, 0); }
        {
            float s1[4], s2[4], xi[4];
#pragma unroll
            for (int r = 0; r < 4; ++r) { xi[r] = exp2f(log2g * (float)(16 * w + 4 * g + r + 1)); s1[r] = 0.f; s2[r] = 0.f; }
#pragma unroll
            for (int et = 0; et < 8; ++et)
#pragma unroll
                for (int r = 0; r < 4; ++r) { const float x = oi[et][r] + xi[r] * oc[et][r]; oi[et][r] = x; s1[r] += x; s2[r] += x * x; }
#pragma unroll
            for (int r = 0; r < 4; ++r) {
#pragma unroll
                for (int o = 1; o < 16; o <<= 1) { s1[r] += __shfl_xor(s1[r], o); s2[r] += __shfl_xor(s2[r], o); }
                const float mu = s1[r] * (1.f / 128.f); const float var = fmaxf(s2[r] * (1.f / 128.f) - mu * mu, 0.f); s1[r] = mu; s2[r] = 1.0f / sqrtf(var + GN_EPS); }
            const size_t tok0 = tokb + (size_t)c * 128 + 16 * w + 4 * g;
#pragma unroll
            for (int et = 0; et < 8; ++et) { const int col = 128 * h + 16 * et + c16; const float wgt = rnw[col];
#pragma unroll
                for (int r = 0; r < 4; ++r) { const float gv = bf2f(PROJ[(tok0 + r) * DIN + PC_RG + col]);
                    const float sg = gv * __builtin_amdgcn_rcpf(1.f + __builtin_amdgcn_exp2f(-gv * 1.4426950408889634f));
                    MIX[(tok0 + r) * DM + col] = (bf16_t)f2bf((oi[et][r] - s1[r]) * s2[r] * wgt * sg); }
                if (et & 1) asm volatile("" ::: "memory"); }
        }
#pragma unroll
        for (int dt = 0; dt < 4; ++dt) Racc[dt] = Racc[dt] * gC;
#pragma unroll 1
        for (int ks = 0; ks < 4; ++ks) { LAS const char* vp = vtb + ks * (32 * V_STR) + w * 32;
            const bf16x8 vf = cat8(vtr(vp), vtr(vp + 16 * V_STR));
            LAS const char* kp = khb + ks * (32 * KS_STR);
#pragma unroll
            for (int dt = 0; dt < 4; ++dt) { const bf16x8 kfm = cat8(vtr(kp + dt * 32), vtr(kp + dt * 32 + 16 * KS_STR));
                Racc[dt] = __builtin_amdgcn_mfma_f32_16x16x32_bf16(kfm, vf, Racc[dt], 0, 0, 0); } }
        __syncthreads();
#pragma unroll
        for (int dt = 0; dt < 4; ++dt) { u32x2 o2; o2.x = pk2(Racc[dt][0], Racc[dt][1]); o2.y = pk2(Racc[dt][2], Racc[dt][3]);
            *(LAS u32x2*)(Rt + (16 * w + c16) * KS_STR + (16 * dt + 4 * g) * 2) = o2; }
    }
    __syncthreads();
#undef RET_LOAD
}
}

#define XB_TMO      128
#define XB_XCNT(j)  (256  + 64 * (j))
#define XB_XSUB(j)  (1280 + 64 * (j))
#define XB_XGEN(j)  (2304 + 64 * (j))
#define XB_TOP      3328
#define XB_TOPGEN   3392
#define XCD_BAR_WORDS 3456
#define XB_SPIN_CAP (1u << 18)
__device__ __forceinline__ unsigned xb_ld(unsigned* p)              { return __hip_atomic_load(p, __ATOMIC_RELAXED, __HIP_MEMORY_SCOPE_AGENT); }
__device__ __forceinline__ unsigned xb_add(unsigned* p, unsigned v) { return __hip_atomic_fetch_add(p, v, __ATOMIC_RELAXED, __HIP_MEMORY_SCOPE_AGENT); }
__device__ __forceinline__ unsigned xb_xcc_id() { return (unsigned)__builtin_amdgcn_s_getreg((3 << 11) | 20) & 0xFu; }
#define XB_SPIN(cond, bar) do { unsigned _sp = 0; while (cond) { __builtin_amdgcn_s_sleep(1); \
    if ((++_sp & 255u) == 0u) { if (xb_ld(&(bar)[XB_TMO])) break; if (_sp > XB_SPIN_CAP) { atomicAdd(&(bar)[XB_TMO], 1u); break; } } } } while (0)
struct XcdBarrier { unsigned* bar; unsigned x; volatile LAS unsigned* st; };
__device__ __forceinline__ XcdBarrier xcd_barrier_post(unsigned* bar, volatile LAS unsigned* st) {
    XcdBarrier b; b.bar = bar; b.x = xb_xcc_id(); b.st = st;
    if (threadIdx.x == 0) (void)xb_add(&bar[XB_XCNT(b.x)], 1u);
    return b;
}
__device__ __forceinline__ void xcd_barrier_complete(unsigned* bar, unsigned x, unsigned& nloc, unsigned& nx) {
    const unsigned G = gridDim.x * gridDim.y * gridDim.z;
    unsigned sum, cnt, mine, sp = 0u;
    for (;;) {
        sum = 0u; cnt = 0u; mine = 0u;
#pragma unroll
        for (unsigned j = 0; j < 16; ++j) { const unsigned c = xb_ld(&bar[XB_XCNT(j)]); sum += c; cnt += (c > 0u) ? 1u : 0u; mine = (j == x) ? c : mine; }
        if (sum == G) break;
        __builtin_amdgcn_s_sleep(1);
        if ((++sp & 255u) == 0u) { if (xb_ld(&bar[XB_TMO])) break; if (sp > XB_SPIN_CAP) { atomicAdd(&bar[XB_TMO], 1u); break; } }
    }
    nloc = mine > 0u ? mine : 1u; nx = cnt > 0u ? cnt : 1u;
}
__device__ __forceinline__ void xcd_barrier(const XcdBarrier& b) {
    asm volatile("s_waitcnt vmcnt(0)" ::: "memory");
    __syncthreads();
    if (threadIdx.x == 0) {
        unsigned* bar = b.bar;
        __builtin_amdgcn_s_waitcnt(0);
        unsigned nloc = b.st[0], nx = b.st[1];
        if (nloc == 0u) { xcd_barrier_complete(bar, b.x, nloc, nx); b.st[0] = nloc; b.st[1] = nx; }
        const unsigned old = xb_add(&bar[XB_XSUB(b.x)], 1u);
        const unsigned gen = old / nloc;
        if (old + 1u == (gen + 1u) * nloc) {
            __builtin_amdgcn_fence(__ATOMIC_RELEASE, "agent");
            asm volatile("s_waitcnt vmcnt(0)" ::: "memory");
            const unsigned og = xb_add(&bar[XB_TOP], 1u);
            const unsigned tg = og / nx;
            if (og + 1u == (tg + 1u) * nx) xb_add(&bar[XB_TOPGEN], 1u);
            else XB_SPIN(xb_ld(&bar[XB_TOPGEN]) == tg, bar);
            __builtin_amdgcn_fence(__ATOMIC_ACQUIRE, "agent");
            xb_add(&bar[XB_XGEN(b.x)], 1u);
            asm volatile("s_waitcnt vmcnt(0)" ::: "memory");
        } else {
            XB_SPIN(xb_ld(&bar[XB_XGEN(b.x)]) == gen, bar);
            __builtin_amdgcn_fence(__ATOMIC_ACQUIRE, "agent");
            asm volatile("s_waitcnt vmcnt(0)" ::: "memory");
        }
    }
    __syncthreads();
}

__device__ __forceinline__ float wave_sum(float v) {
#pragma unroll
    for (int o = 1; o < 64; o <<= 1) v += __shfl_xor(v, o);
    return v;
}
__device__ __forceinline__ int dst_row(int mode, int n) {
    if (mode == 1) {
        if (n < 512) { const int base = n & ~255, j = n & 255, hh = j >> 6, d = j & 63; return base + ((d < 32) ? (32 * hh + d) : (128 + 32 * hh + (d - 32))); }
        if (n >= PC_MQ && n < PC_MV) { const int d = n & 63; if (d < 16) { const int nn = d >> 3, fq = (d >> 2) & 1, e = d & 3; return (n & ~63) + 8 * fq + 4 * nn + e; } }
        return n;
    }
    if (mode == 2) { return (n < 1024) ? (256 * (n >> 7) + (n & 127)) : (256 * ((n - 1024) >> 7) + 128 + ((n - 1024) & 127)); }
    return n;
}
__device__ __forceinline__ void p0_transpose_item(const float* W, int K, int N, bf16_t* WT, int mode, LAS float* scr, int item, int lane) {
    const int nblk = N / 32, kb = item / nblk, nb = item % nblk, k0 = 64 * kb, n0 = 32 * nb;
#pragma unroll 8
    for (int i = 0; i < 32; ++i) { const int kk = 2 * i + (lane >> 5); scr[kk * 33 + (lane & 31)] = W[(size_t)(k0 + kk) * N + n0 + (lane & 31)]; }
    LDS_WAIT(); asm volatile("" ::: "memory");
    const int c = lane & 7;
#pragma unroll
    for (int j = 0; j < 4; ++j) { const int n = (lane >> 3) + 8 * j; const LAS float* s = scr + (8 * c) * 33 + n;
        u32x4 o; o.x = pk2(s[0 * 33], s[1 * 33]); o.y = pk2(s[2 * 33], s[3 * 33]); o.z = pk2(s[4 * 33], s[5 * 33]); o.w = pk2(s[6 * 33], s[7 * 33]);
        *(GAS u32x4*)(WT + (size_t)dst_row(mode, n0 + n) * K + k0 + 8 * c) = o; }
    LDS_WAIT(); asm volatile("" ::: "memory");
}
__device__ __forceinline__ void sincos_acc(float af, float& sn, float& cs) {
    const double a = (double)af; const double k = rint(a * 0.15915494309189535); double r = a - k * 6.283185307179586;
    double sgn = 1.0; if (r > 1.5707963267948966) { r = 3.141592653589793 - r; sgn = -1.0; } else if (r < -1.5707963267948966) { r = -3.141592653589793 - r; sgn = -1.0; }
    const double r2 = r * r;
    double s = -1.0 / 355687428096000.0; s = s * r2 + 1.0 / 1307674368000.0; s = s * r2 - 1.0 / 6227020800.0; s = s * r2 + 1.0 / 39916800.0; s = s * r2 - 1.0 / 362880.0; s = s * r2 + 1.0 / 5040.0; s = s * r2 - 1.0 / 120.0; s = s * r2 + 1.0 / 6.0; s = r - r * r2 * s;
    double c = 1.0 / 20922789888000.0; c = c * r2 - 1.0 / 87178291200.0; c = c * r2 + 1.0 / 479001600.0; c = c * r2 - 1.0 / 3628800.0; c = c * r2 + 1.0 / 40320.0; c = c * r2 - 1.0 / 720.0; c = c * r2 + 1.0 / 24.0; c = c * r2 - 0.5; c = 1.0 + c * r2;
    sn = (float)s; cs = (float)(sgn * c);
}

struct Args { const float* in[13]; float* out; unsigned char* ws; int ph_lo, ph_hi, li, pad; };
constexpr int N_PHASES = 8;

__global__ void __launch_bounds__(NWAVES * 64, 2) fwd_mega(Args args) {
    extern __shared__ __attribute__((aligned(16))) unsigned char lds_raw[];
    LAS unsigned char* lds = (LAS unsigned char*)lds_raw;
    volatile LAS unsigned* MISC = (volatile LAS unsigned*)(lds + MISC_OFF);
    LAS int* LTAB = (LAS int*)(lds + LTAB_OFF);
    const int tid = threadIdx.x, lane = tid & 63, wave = __builtin_amdgcn_readfirstlane(tid >> 6);
    const int G = gridDim.x, bx = blockIdx.x; const int vcu = (G % 8 == 0) ? (bx % 8) * (G / 8) + bx / 8 : bx;
    unsigned char* ws = args.ws;
    gu32* ctl = (gu32*)(ws + WS_CTL);
    const float* x = args.in[0]; const float* norm1_w = args.in[1]; const float* w_in = args.in[2]; const float* ret_norm_w = args.in[3]; const float* w_out = args.in[4];
    const float* norm2_w = args.in[5]; const float* w_router = args.in[6]; const float* b_router = args.in[7]; const float* w1 = args.in[8]; const float* b1 = args.in[9];
    const float* w2 = args.in[10]; const float* b2 = args.in[11]; const float* final_w = args.in[12];
    float* out = args.out;
    float* rope = (float*)(ws + WS_ROPE); float* rc = rope; float* rs = rope + SEQ * 32; float* mc = rope + 2 * SEQ * 32; float* ms = mc + SEQ * 8;
    float* ksum = (float*)(ws + WS_KSUM); float* rstd2 = (float*)(ws + WS_RSTD); bf16_t* wrf = (bf16_t*)(ws + WS_WRF); float* gate = (float*)(ws + WS_GATE); int* slot = (int*)(ws + WS_SLOT);
    bf16_t* WinT = (bf16_t*)(ws + WS_WIN); bf16_t* WoutT = (bf16_t*)(ws + WS_WOUT); bf16_t* W2T = (bf16_t*)(ws + WS_W2); bf16_t* W1T = (bf16_t*)(ws + WS_W1);
    bf16_t* PROJ = (bf16_t*)(ws + WS_PROJ); bf16_t* MIX = (bf16_t*)(ws + WS_MIX); bf16_t* ACT = (bf16_t*)(ws + WS_ACT); bf16_t* XN = (bf16_t*)(ws + WS_XN); bf16_t* Y3 = (bf16_t*)(ws + WS_Y3);

    for (int u = tid; u < (LDS_BYTES - LDSCTL_OFF) / 4; u += NWAVES * 64) ((LAS unsigned*)(lds + LDSCTL_OFF))[u] = 0u;
    __syncthreads();
    const bool use_bar = (MK_N_LAUNCHES != N_PHASES);
    XcdBarrier bar; bar.bar = (unsigned*)(ctl + CW_BAR) + args.li * XCD_BAR_WORDS; bar.x = 0; bar.st = nullptr;
    if (use_bar) bar = xcd_barrier_post((unsigned*)(ctl + CW_BAR) + args.li * XCD_BAR_WORDS, MISC + 8);
    const int lo = args.ph_lo, hi = args.ph_hi;
#ifndef PHASE_MASK
#define PHASE_MASK 0xff
#endif
#define IN(k) ((((PHASE_MASK) >> (k)) & 1) && lo <= (k) && (k) < hi)
#define SEAM(k) do { if (IN(k) && IN((k) + 1)) xcd_barrier(bar); } while (0)

    if (IN(0)) {
        LAS float* scr = (LAS float*)(lds + wave * 16384);
        const int gw = vcu * NWAVES + wave, NGW = G * NWAVES;
        constexpr int I_IN = (DM / 64) * (DIN / 32), I_OUT = (DM / 64) * (DM / 32), I_1E = (DM / 64) * (2048 / 32), I_2E = (DM / 64) * (DM / 32);
        constexpr int I_1 = NEXP * I_1E, I_2 = NEXP * I_2E, NITEMS = I_IN + I_OUT + I_1 + I_2;
        for (int it = gw; it < NITEMS; it += NGW) {
            int r = it;
            if (r < I_1) { const int e = r / I_1E; p0_transpose_item(w1 + (size_t)e * DM * 2048, DM, 2048, W1T + (size_t)e * 2048 * DM, 2, scr, r % I_1E, lane); continue; } r -= I_1;
            if (r < I_2) { const int e = r / I_2E; p0_transpose_item(w2 + (size_t)e * DM * DM, DM, DM, W2T + (size_t)e * DM * DM, 0, scr, r % I_2E, lane); continue; } r -= I_2;
            if (r < I_IN) { p0_transpose_item(w_in, DM, DIN, WinT, 1, scr, r, lane); continue; } r -= I_IN;
            p0_transpose_item(w_out, DM, DM, WoutT, 0, scr, r, lane);
        }
        {
            f32x4 wv[4];
#pragma unroll
            for (int j = 0; j < 4; ++j) wv[j] = *((const f32x4*)norm1_w + lane + 64 * j);
            for (int m = gw; m < NTOK; m += NGW) {
                const f32x4* xr = (const f32x4*)(x + (size_t)m * DM) + lane; f32x4 v[4]; float s = 0.f;
#pragma unroll
                for (int j = 0; j < 4; ++j) { v[j] = xr[64 * j]; s += (v[j].x * v[j].x + v[j].y * v[j].y) + (v[j].z * v[j].z + v[j].w * v[j].w); }
                const float rstd = 1.0f / sqrtf(wave_sum(s) * (1.f / DM) + RMS_EPS);
                unsigned long long* o8 = (unsigned long long*)(XN + (size_t)m * DM) + lane;
#pragma unroll
                for (int j = 0; j < 4; ++j) { const f32x4 y = v[j] * rstd * wv[j]; o8[64 * j] = (unsigned long long)pk2(y.x, y.y) | ((unsigned long long)pk2(y.z, y.w) << 32); }
            }
        }
        {
            const int gt = vcu * (NWAVES * 64) + tid, NGT = G * NWAVES * 64;
            for (int idx = gt; idx < SEQ * 32 + SEQ * 8; idx += NGT) {
                if (idx < SEQ * 32) { const int s = idx >> 5, i = idx & 31; const float inv = (float)exp2(-(double)i / 32.0 * 13.287712379549449);
                    float sn, cs; sincos_acc((float)s * inv, sn, cs); rc[idx] = cs; rs[idx] = sn; }
                else { const int j = idx - SEQ * 32, s = j >> 3, i = j & 7; const float inv = (float)exp2(-(double)i / 8.0 * 18.931568569324174);
                    float sn, cs; sincos_acc((float)s * inv, sn, cs); mc[j] = cs; ms[j] = sn; }
            }
            for (int idx = gt; idx < 32 * 2 * 64 * 8; idx += NGT) {
                const int j = idx & 7, ln = (idx >> 3) & 63, eh = (idx >> 9) & 1, ks = idx >> 10;
                const int k = 32 * ks + 8 * (ln >> 4) + j, e = 16 * eh + (ln & 15);
                const float wv = w_router[(size_t)k * NEXP + e]; const unsigned hb = f2bf(wv); const float lof = wv - bf2f((unsigned short)hb);
                wrf[(((size_t)(ks * 2 + eh) * 2 + 0) * 64 + ln) * 8 + j] = (bf16_t)hb;
                wrf[(((size_t)(ks * 2 + eh) * 2 + 1) * 64 + ln) * 8 + j] = (bf16_t)f2bf(lof);
            }
        }
    }
    SEAM(0);

    if (IN(1)) {
        pg8::ProbInProj P; P.A = XN; P.Bt = WinT; P.nM = NTOK / 256; P.nN = DIN / 256; P.G = G; P.c = bx;
        P.PROJ = PROJ; P.rc = rc; P.rs = rs; P.mc = mc; P.ms = ms; P.ksum = ksum;
        pg8::gemm_phase<pg8::ProbInProj, true>(lds, P);
    }
    SEAM(1);

    if (IN(2)) {
        for (;;) {
            if (tid == 0) MISC[16] = __hip_atomic_fetch_add(ctl + CW_QUEUE, 1u, RLX_AGENT);
            __syncthreads();
            const int id = __builtin_amdgcn_readfirstlane((int)MISC[16]);
            __syncthreads();
            if (id >= 128 + 2048) break;
#ifndef NO_RET
            if (id < 128) ret::ret_unit(id >> 2, id & 3, PROJ, ret_norm_w, MIX, lds);
            else
#endif
#ifndef NO_MOBA
            { const int j = id - 128; const int qb = 7 - (j >> 8), bh = j & 255;
                moba::moba_unit<8>(bh >> 3, bh & 7, qb, (const moba::bf16*)PROJ, ksum, (moba::bf16*)MIX, (char*)lds_raw); }
#else
            {}
#endif
        }
    }
    SEAM(2);

    if (IN(3)) {
        pg8::ProbOutProj P; P.A = MIX; P.Bt = WoutT; P.nM = NTOK / 256; P.nN = DM / 256; P.G = G; P.c = bx; P.x = x; P.X1 = out;
        pg8::gemm_phase<pg8::ProbOutProj, true>(lds, P);
    }
    SEAM(3);

    if (IN(4)) {
        LAS float* lg = (LAS float*)(lds) + wave * (32 * 33);
        LAS unsigned* pinfo = (LAS unsigned*)(lds + 40960);
        LAS float* pgate = (LAS float*)(lds + 40960 + 4096);
        LAS unsigned* lcnt = (LAS unsigned*)(lds + 40960 + 8192);
        LAS unsigned* lbase = lcnt + 32;
        const int c16 = lane & 15, g = lane >> 4;
        for (int blk = bx; blk < NTOK / 256; blk += G) {
            if (tid < 32) lcnt[tid] = 0u;
            __syncthreads();
            const int R0 = blk * 256 + wave * 32;
            f32x4 acc[2][2]; float ssq[2] = {0.f, 0.f};
#pragma unroll
            for (int tt = 0; tt < 2; ++tt)
#pragma unroll
                for (int eh = 0; eh < 2; ++eh) acc[tt][eh] = (f32x4){0.f, 0.f, 0.f, 0.f};
#pragma unroll 2
            for (int ks = 0; ks < 32; ++ks) {
                const f32x4 w0 = *(const f32x4*)(norm2_w + 32 * ks + 8 * g), w1v = *(const f32x4*)(norm2_w + 32 * ks + 8 * g + 4);
                bf16x8 bh[2], bl[2];
#pragma unroll
                for (int eh = 0; eh < 2; ++eh) { bh[eh] = *(const bf16x8*)(wrf + (((size_t)(ks * 2 + eh) * 2 + 0) * 64 + lane) * 8); bl[eh] = *(const bf16x8*)(wrf + (((size_t)(ks * 2 + eh) * 2 + 1) * 64 + lane) * 8); }
#pragma unroll
                for (int tt = 0; tt < 2; ++tt) { const size_t ro = (size_t)(R0 + 16 * tt + c16) * DM + 32 * ks + 8 * g;
                    const f32x4 a0 = *(const f32x4*)(out + ro), a1 = *(const f32x4*)(out + ro + 4);
                    ssq[tt] += (a0.x * a0.x + a0.y * a0.y) + (a0.z * a0.z + a0.w * a0.w) + (a1.x * a1.x + a1.y * a1.y) + (a1.z * a1.z + a1.w * a1.w);
                    const f32x4 v0 = a0 * w0, v1 = a1 * w1v; u32x4 hw, lw;
                    hw.x = pk2(v0.x, v0.y); hw.y = pk2(v0.z, v0.w); hw.z = pk2(v1.x, v1.y); hw.w = pk2(v1.z, v1.w);
                    lw.x = pk2(v0.x - __builtin_bit_cast(float, hw.x << 16), v0.y - __builtin_bit_cast(float, hw.x & 0xffff0000u)); lw.y = pk2(v0.z - __builtin_bit_cast(float, hw.y << 16), v0.w - __builtin_bit_cast(float, hw.y & 0xffff0000u));
                    lw.z = pk2(v1.x - __builtin_bit_cast(float, hw.z << 16), v1.y - __builtin_bit_cast(float, hw.z & 0xffff0000u)); lw.w = pk2(v1.z - __builtin_bit_cast(float, hw.w << 16), v1.w - __builtin_bit_cast(float, hw.w & 0xffff0000u));
                    *(u32x4*)(XN + ro) = hw;
                    const bf16x8 ah = __builtin_bit_cast(bf16x8, hw), al = __builtin_bit_cast(bf16x8, lw);
#pragma unroll
                    for (int eh = 0; eh < 2; ++eh) { acc[tt][eh] = __builtin_amdgcn_mfma_f32_16x16x32_bf16(ah, bh[eh], acc[tt][eh], 0, 0, 0);
                        acc[tt][eh] = __builtin_amdgcn_mfma_f32_16x16x32_bf16(al, bh[eh], acc[tt][eh], 0, 0, 0); acc[tt][eh] = __builtin_amdgcn_mfma_f32_16x16x32_bf16(ah, bl[eh], acc[tt][eh], 0, 0, 0); } }
            }
#pragma unroll
            for (int tt = 0; tt < 2; ++tt) { float s = ssq[tt]; s += __shfl_xor(s, 16); s += __shfl_xor(s, 32); const float rstd = 1.0f / sqrtf(s * (1.f / DM) + RMS_EPS);
                if (g == 0) rstd2[R0 + 16 * tt + c16] = rstd;
#pragma unroll
                for (int r = 0; r < 4; ++r) { const float rr = __shfl(rstd, 4 * g + r);
#pragma unroll
                    for (int eh = 0; eh < 2; ++eh) lg[(16 * tt + 4 * g + r) * 33 + 16 * eh + c16] = acc[tt][eh][r] * rr + b_router[16 * eh + c16]; } }
            LDS_WAIT(); asm volatile("" ::: "memory");
            if (lane < 32) {
                float v[32];
#pragma unroll
                for (int e = 0; e < 32; ++e) v[e] = lg[lane * 33 + e];
                float tv[4]; int te[4];
#pragma unroll
                for (int k = 0; k < 4; ++k) { float best = v[0]; int bi = 0;
#pragma unroll
                    for (int e = 1; e < 32; ++e) if (v[e] > best) { best = v[e]; bi = e; }
                    tv[k] = best; te[k] = bi;
#pragma unroll
                    for (int e = 0; e < 32; ++e) v[e] = (e == bi) ? -INFINITY : v[e]; }
                float ex[4], sum = 0.f;
#pragma unroll
                for (int k = 0; k < 4; ++k) { ex[k] = __expf(tv[k] - tv[0]); sum += ex[k]; }
                const float inv = 1.0f / sum;
#pragma unroll
                for (int k = 0; k < 4; ++k) { const unsigned lr = __hip_atomic_fetch_add(lcnt + te[k], 1u, __ATOMIC_RELAXED, __HIP_MEMORY_SCOPE_WORKGROUP);
                    const int p = (wave * 32 + lane) * 4 + k; pinfo[p] = (unsigned)te[k] | (lr << 8); pgate[p] = ex[k] * inv; }
            }
            __syncthreads();
            if (tid < 32) lbase[tid] = __hip_atomic_fetch_add(ctl + CW_GCNT + 64 * tid, lcnt[tid], RLX_AGENT);
            __syncthreads();
            for (int p = tid; p < 1024; p += NWAVES * 64) { const unsigned pi = pinfo[p]; const int e = pi & 255u; const unsigned pos = lbase[e] + (pi >> 8);
                const int pair = (blk * 256) * 4 + p; slot[(size_t)e * NTOK + pos] = pair; gate[pair] = pgate[p]; }
            __syncthreads();
        }
    }
    SEAM(4);

    if (IN(5) || IN(6)) {
        if (tid == 0) { int tp = 0, cp = 0;
            for (int e = 0; e < NEXP; ++e) { const int c = (int)__hip_atomic_load(ctl + CW_GCNT + 64 * e, RLX_AGENT); LTAB[e] = tp; LTAB[33 + e] = cp; tp += (c + 255) >> 8; cp += c; }
            LTAB[32] = tp; LTAB[33 + 32] = cp; }
        __syncthreads();
    }
    if (IN(5)) {
        pg8::ProbMoe1 P; P.T = LTAB[32]; P.NP = 8; P.G = G; P.c = bx; P.tpre = LTAB; P.cpre = LTAB + 33;
        P.H2 = XN; P.W1T = W1T; P.slot = slot; P.rstd = rstd2; P.b1 = b1; P.ACT = ACT;
        pg8::gemm_phase<pg8::ProbMoe1, true>(lds, P);
    }
    SEAM(5);
    if (IN(6)) {
        pg8::ProbMoe2 P; P.T = LTAB[32]; P.NP = 4; P.G = G; P.c = bx; P.tpre = LTAB; P.cpre = LTAB + 33;
        P.ACT = ACT; P.W2T = W2T; P.slot = slot; P.gate = gate; P.b2 = b2; P.X1 = out; P.Y3 = Y3;
        pg8::gemm_phase<pg8::ProbMoe2, true>(lds, P);
    }
    SEAM(6);

    if (IN(7)) {
        const int gw = vcu * NWAVES + wave, NGW = G * NWAVES;
        unsigned bad = __hip_atomic_load(ctl + CW_TMO, RLX_AGENT);
        for (int li = 0; li < (MK_N_LAUNCHES == N_PHASES ? 0 : MK_N_LAUNCHES); ++li) bad |= __hip_atomic_load(ctl + CW_BAR + li * XCD_BAR_WORDS + XB_TMO, RLX_AGENT);
        f32x4 wv[4];
#pragma unroll
        for (int j = 0; j < 4; ++j) wv[j] = *((const f32x4*)final_w + lane + 64 * j);
        for (int m = gw; m < NTOK; m += NGW) {
            f32x4* xr = (f32x4*)(out + (size_t)m * DM) + lane; f32x4 v[4]; float s = 0.f;
            const u32x2* y0 = (const u32x2*)(Y3 + (size_t)m * 3 * DM) + lane;
#pragma unroll
            for (int j = 0; j < 4; ++j) { v[j] = xr[64 * j];
#pragma unroll
                for (int k = 0; k < 3; ++k) { const u32x2 yy = y0[k * (DM / 4) + 64 * j];
                    v[j].x += __builtin_bit_cast(float, yy.x << 16); v[j].y += __builtin_bit_cast(float, yy.x & 0xffff0000u); v[j].z += __builtin_bit_cast(float, yy.y << 16); v[j].w += __builtin_bit_cast(float, yy.y & 0xffff0000u); }
                s += (v[j].x * v[j].x + v[j].y * v[j].y) + (v[j].z * v[j].z + v[j].w * v[j].w); }
            const float rstd = 1.0f / sqrtf(wave_sum(s) * (1.f / DM) + RMS_EPS);
#pragma unroll
            for (int j = 0; j < 4; ++j) { f32x4 y = v[j] * rstd * wv[j]; if (bad) { const float q = __builtin_nanf(""); y = (f32x4){q, q, q, q}; } xr[64 * j] = y; }
        }
    }
#undef IN
#undef SEAM
}

extern "C" void kernel_launch(void* const* d_in, const int* in_sizes, int n_in, void* d_out, int out_size, void* d_ws, size_t ws_size, hipStream_t stream) {
    static int grid = 0;
    if (grid == 0) {
        if (n_in != 13 || in_sizes[0] != NTOK * DM || out_size != NTOK * DM || ws_size < WS_END) { fprintf(stderr, "kernel_launch: unexpected shapes (n_in %d, in0 %d, out %d, ws %zu)\n", n_in, n_in > 0 ? in_sizes[0] : -1, out_size, ws_size); grid = -1; return; }
        int dev = 0, cus = 0;
        if (hipGetDevice(&dev) != hipSuccess || hipDeviceGetAttribute(&cus, hipDeviceAttributeMultiprocessorCount, dev) != hipSuccess) { grid = -1; return; }
        if (hipFuncSetAttribute((const void*)fwd_mega, hipFuncAttributeMaxDynamicSharedMemorySize, LDS_BYTES) != hipSuccess) { fprintf(stderr, "kernel_launch: hipFuncSetAttribute failed\n"); grid = -1; return; }
        int per_cu = 0;
        if (hipOccupancyMaxActiveBlocksPerMultiprocessor(&per_cu, (const void*)fwd_mega, NWAVES * 64, LDS_BYTES) != hipSuccess || per_cu < 1) fprintf(stderr, "kernel_launch: occupancy query says %d\n", per_cu);
        (void)hipGetLastError();
        grid = cus;
    }
    if (grid < 0) return;
    (void)hipMemsetAsync((char*)d_ws + WS_CTL, 0, CTL_ZERO_BYTES, stream);
    Args a{};
    for (int i = 0; i < 13; ++i) a.in[i] = (const float*)d_in[i];
    a.out = (float*)d_out; a.ws = (unsigned char*)d_ws;
    if (MK_N_LAUNCHES == 1) { a.ph_lo = 0; a.ph_hi = N_PHASES; a.li = 0; hipLaunchKernelGGL(fwd_mega, dim3(grid), dim3(NWAVES * 64), LDS_BYTES, stream, a); }
    else for (int li = 0; li < N_PHASES; ++li) { a.ph_lo = li; a.ph_hi = li + 1; a.li = 0; hipLaunchKernelGGL(fwd_mega, dim3(grid), dim3(NWAVES * 64), LDS_BYTES, stream, a); }
}
```

```cpp
#include <hip/hip_runtime.h>
#include <hip/hip_bf16.h>
#include <cstdio>
#include <cstdint>
#include <cmath>

#ifndef MK_N_LAUNCHES
#define MK_N_LAUNCHES 1
#endif

#define LAS __attribute__((address_space(3)))
#define GAS __attribute__((address_space(1)))
typedef unsigned short bf16_t;
typedef short bf16x8 __attribute__((ext_vector_type(8)));
typedef short s16x4 __attribute__((ext_vector_type(4)));
typedef float f32x4 __attribute__((ext_vector_type(4)));
typedef float f32x2 __attribute__((ext_vector_type(2)));
typedef float f32x16 __attribute__((ext_vector_type(16)));
typedef unsigned u32x4 __attribute__((ext_vector_type(4)));
typedef unsigned u32x2 __attribute__((ext_vector_type(2)));
typedef GAS unsigned gu32;
typedef int v8i __attribute__((ext_vector_type(8)));

constexpr int NB = 32, SEQ = 2048, DM = 1024, NTOK = NB * SEQ;
constexpr int DIN = 3072;
constexpr int NEXP = 32, TOPK = 4, NPAIR = NTOK * TOPK;
constexpr float RMS_EPS = 1e-5f, GN_EPS = 1e-6f;
constexpr float QC2 = 0.125f * 1.4426950408889634f;
constexpr int PC_RQ = 0, PC_RK = 256, PC_RV = 512, PC_RG = 1024, PC_MQ = 1536, PC_MK = 2048, PC_MV = 2560;

constexpr size_t MiB = 1u << 20;
constexpr size_t WS_CTL = 0, CTL_ZERO_BYTES = 1 * MiB;
constexpr size_t WS_ROPE = 1 * MiB;
constexpr size_t WS_KSUM = 2 * MiB;
constexpr size_t WS_RSTD = 3 * MiB;
constexpr size_t WS_WRF = 3 * MiB + 512 * 1024;
constexpr size_t WS_GATE = 4 * MiB;
constexpr size_t WS_SLOT = 5 * MiB;
constexpr size_t WS_WIN = 16 * MiB, WS_WOUT = 22 * MiB, WS_SGATE = 16 * MiB;
constexpr size_t WS_W2 = 24 * MiB, WS_W1 = 56 * MiB;
constexpr size_t WS_XN = 120 * MiB;
constexpr size_t WS_PROJ = 248 * MiB, WS_MIX = 632 * MiB;
constexpr size_t WS_ACT = 248 * MiB;
constexpr size_t WS_SRSTD = 632 * MiB;
constexpr size_t WS_Y4 = 504 * MiB;
constexpr size_t WS_END = 1016 * MiB;
constexpr int CW_TMO = 0, CW_CODE = 1, CW_BAR = 4096, CW_QUEUE = 40000, CW_GCNT = 40960;

constexpr int RING_BYTES = 131072;
constexpr int LDSCTL_OFF = RING_BYTES, MISC_OFF = LDSCTL_OFF + 320, LTAB_OFF = LDSCTL_OFF + 512;
constexpr int LDS_BYTES = 147456;
constexpr int NWAVES = 8;

#define RLX_AGENT __ATOMIC_RELAXED, __HIP_MEMORY_SCOPE_AGENT
#define LDS_WAIT() asm volatile("s_waitcnt lgkmcnt(0)" ::: "memory")
#define VM_WAIT() asm volatile("s_waitcnt vmcnt(0)" ::: "memory")

__device__ __forceinline__ unsigned f2bf(float f) { unsigned u = __builtin_bit_cast(unsigned, f); return (u + 0x7fffu + ((u >> 16) & 1u)) >> 16; }
__device__ __forceinline__ unsigned pk2(float lo, float hi) { return f2bf(lo) | (f2bf(hi) << 16); }
__device__ __forceinline__ float bf2f(unsigned short b) { return __builtin_bit_cast(float, (unsigned)b << 16); }
__device__ __forceinline__ unsigned cvt_pk_bf16(float lo, float hi) { unsigned r; asm volatile("v_cvt_pk_bf16_f32 %0, %1, %2" : "=v"(r) : "v"(lo), "v"(hi)); return r; }
__device__ __forceinline__ u32x4 pack8(f32x4 a, f32x4 b) { u32x4 w; w.x = cvt_pk_bf16(a[0], a[1]); w.y = cvt_pk_bf16(a[2], a[3]); w.z = cvt_pk_bf16(b[0], b[1]); w.w = cvt_pk_bf16(b[2], b[3]); return w; }

__device__ __forceinline__ u32x2 pack8_fp8(f32x4 a, f32x4 b) { u32x2 w; int t = 0;
    t = __builtin_amdgcn_cvt_pk_fp8_f32(a[0], a[1], t, false); t = __builtin_amdgcn_cvt_pk_fp8_f32(a[2], a[3], t, true); w.x = (unsigned)t; t = 0;
    t = __builtin_amdgcn_cvt_pk_fp8_f32(b[0], b[1], t, false); t = __builtin_amdgcn_cvt_pk_fp8_f32(b[2], b[3], t, true); w.y = (unsigned)t; return w; }

namespace pg8 {
constexpr int BM = 256, BK = 64, HALF = 128, HTB = HALF * BK * 2, STAGE_BYTES = 8 * HTB, NXCD = 8, WGM = 8;
constexpr int KD = 1024;
__device__ __forceinline__ int lds_byte(int r, int c) { const int st = (r >> 4) * 2 + (c >> 5), rr = r & 15, cc = c & 31, ob = rr * 64 + cc * 2; return st * 1024 + (ob ^ (((ob >> 9) & 1) << 5)); }
__device__ __forceinline__ void stage_rc(int b, int& R, int& C) { const int st = b / 1024, sb = b % 1024, swz = sb ^ (((sb >> 9) & 1) << 5); R = (st >> 1) * 16 + swz / 64; C = (st & 1) * 32 + (swz % 64) / 2; }
__device__ __forceinline__ int perm32(int rho) { const int n = rho >> 4, i = rho & 15; return 8 * (i >> 2) + 4 * n + (i & 3); }

struct Unit { int pm, pn, e, row0, nrows, arow; };

__device__ __forceinline__ bool tile_order(int i, int G, int c, int nM, int nN, int& pm, int& pn) {
    const int nwg = nM * nN; const long L = (long)i * G + c; if (L >= nwg) return false;
    int wgid = (int)L; { const int q = nwg / NXCD, r = nwg % NXCD, xcd = wgid % NXCD, off = wgid / NXCD; wgid = (xcd < r ? xcd * (q + 1) : r * (q + 1) + (xcd - r) * q) + off; }
    const int nig = WGM * nN, gid = wgid / nig, fm = gid * WGM, gsz = (nM - fm) < WGM ? (nM - fm) : WGM;
    pm = fm + ((wgid % nig) % gsz); pn = (wgid % nig) / gsz; return true;
}

template <class P, bool ALIGN_EPI>
__device__ __forceinline__ void gemm_phase(LAS unsigned char* lds, const P& S) {
    const int tid = threadIdx.x, wid = __builtin_amdgcn_readfirstlane(tid >> 6), lane = tid & 63, wr = wid >> 2, wc = wid & 3, fr = lane & 15, fq = lane >> 4;
    constexpr int KB = P::FP8 ? KD : KD * 2;
    constexpr int nt = KB / 128;
    unsigned voffB[2]; int RA[2], CA[2];
#pragma unroll
    for (int i = 0; i < 2; ++i) { int R, C; stage_rc(tid * 16 + i * 8192, R, C); const int Rb = P::PERM ? ((R & ~31) + perm32(R & 31)) : R;
        voffB[i] = (unsigned)(Rb * KB + C * 2); RA[i] = R; CA[i] = C; }
    const size_t kstep = 128;
    const size_t hstep = (size_t)HALF * KB;
    const unsigned ldsw = (unsigned)wid * 1024u;
    const int aoff = P::FP8 ? lds_byte(wr * 64 + fr, fq * 16) : lds_byte(wr * 64 + fr, fq * 8), boff = P::FP8 ? lds_byte(wc * 32 + fr, fq * 16) : lds_byte(wc * 32 + fr, fq * 8);
#define PG8_SA(b, h) (((b) * 2 + (h)) * HTB)
#define PG8_SB(b, h) ((4 + (b) * 2 + (h)) * HTB)
#define PG8_STAGE(bufoff, gbase, voff) do { _Pragma("unroll") for (int _i = 0; _i < 2; ++_i) \
        __builtin_amdgcn_global_load_lds((const unsigned*)((const char*)(gbase) + (voff)[_i]), (LAS unsigned*)(lds + (bufoff) + ldsw + _i * 8192), 16, 0, 0); } while (0)
    constexpr int KOFF = P::FP8 ? 16 : 1024;
    const int scw_ = P::SCW, scx_ = P::SCX;
#define PG8_LDA(dst, b, h) do { _Pragma("unroll") for (int m = 0; m < 4; ++m) _Pragma("unroll") for (int k = 0; k < 2; ++k) dst[m][k] = *(const LAS bf16x8*)(lds + PG8_SA(b, h) + aoff + m * 2048 + k * KOFF); } while (0)
#define PG8_LDB(dst, b, h) do { _Pragma("unroll") for (int n = 0; n < 2; ++n) _Pragma("unroll") for (int k = 0; k < 2; ++k) dst[n][k] = *(const LAS bf16x8*)(lds + PG8_SB(b, h) + boff + n * 2048 + k * KOFF); } while (0)
#define PG8_CAT(x) __builtin_bit_cast(v8i, __builtin_shufflevector(x[0], x[1], 0, 1, 2, 3, 4, 5, 6, 7, 8, 9, 10, 11, 12, 13, 14, 15))
#define PG8_MMA(ai, bj, At, Bt) do { __builtin_amdgcn_s_setprio(1); _Pragma("unroll") for (int m = 0; m < 4; ++m) _Pragma("unroll") for (int n = 0; n < 2; ++n) { \
        if constexpr (P::FP8) asm volatile("v_mfma_scale_f32_16x16x128_f8f6f4 %0, %1, %2, %0, %3, %4 op_sel_hi:[0,0,0]" : "+v"(acc[ai][bj][m][n]) : "v"(PG8_CAT(Bt[n])), "v"(PG8_CAT(At[m])), "v"(scw_), "v"(scx_)); \
        else { _Pragma("unroll") for (int k = 0; k < 2; ++k) acc[ai][bj][m][n] = __builtin_amdgcn_mfma_f32_16x16x32_bf16(Bt[n][k], At[m][k], acc[ai][bj][m][n], 0, 0, 0); } } \
        __builtin_amdgcn_s_setprio(0); } while (0)
#define PG8_WAIT_V(n) asm volatile("s_waitcnt vmcnt(" #n ")" ::: "memory")
#define PG8_WAIT_L(n) asm volatile("s_waitcnt lgkmcnt(" #n ")" ::: "memory")
#define PG8_BAR __builtin_amdgcn_s_barrier()
#define PG8_SCHED __builtin_amdgcn_sched_barrier(0)
    Unit cur, nxt; int ui = 0;
    if (!S.next(0, cur)) return;
    f32x4 acc[2][2][4][2];
#pragma unroll
    for (int a = 0; a < 2; ++a)
#pragma unroll
        for (int b = 0; b < 2; ++b)
#pragma unroll
            for (int m = 0; m < 4; ++m)
#pragma unroll
                for (int n = 0; n < 2; ++n) acc[a][b][m][n] = (f32x4){0.f, 0.f, 0.f, 0.f};
    bf16x8 At[4][2], B0[2][2], B1[2][2];
    unsigned vC[2][2], vN[2][2];
    S.a_voff(cur, RA, CA, vC);
    const char* cA = S.a_ptr(cur); const char* cB = S.b_ptr(cur);
    PG8_STAGE(PG8_SB(0, 0), cB, voffB); PG8_STAGE(PG8_SB(0, 1), cB + hstep, voffB); PG8_STAGE(PG8_SA(0, 0), cA, vC[0]); PG8_STAGE(PG8_SA(0, 1), cA, vC[1]);
    if (wr == 1) PG8_BAR;
    PG8_WAIT_V(2); PG8_BAR;
    PG8_STAGE(PG8_SB(1, 0), cB + kstep, voffB); PG8_STAGE(PG8_SA(1, 0), cA + kstep, vC[0]); PG8_STAGE(PG8_SB(1, 1), cB + hstep + kstep, voffB);
    PG8_WAIT_V(6); PG8_BAR;
    for (;;) {
        const bool has_next = S.next(ui + 1, nxt);
        const char* nA = cA; const char* nB = cB;
#pragma unroll
        for (int h = 0; h < 2; ++h)
#pragma unroll
            for (int i = 0; i < 2; ++i) vN[h][i] = vC[h][i];
        if (has_next) { nA = S.a_ptr(nxt); nB = S.b_ptr(nxt); if constexpr (!P::SIDE) S.a_voff(nxt, RA, CA, vN); }
        if constexpr (P::SIDE) S.side_issue(cur, nxt, has_next, ui, wid, lane, lds);
        for (int tt_ = 0; tt_ < nt * P::KREP; tt_ += 2) { const int t = tt_ & (nt - 1);
            const bool last = (tt_ == nt * P::KREP - 2);
            const char* a1 = cA + (size_t)(t + 1) * kstep;
            const char* a2 = last ? nA : cA + (size_t)((t + 2) & (nt - 1)) * kstep; const char* b2 = last ? nB : cB + (size_t)((t + 2) & (nt - 1)) * kstep;
            const char* a3 = a2 + kstep; const char* b3 = b2 + kstep;
            if constexpr (P::SIDE) { if (last && has_next) S.a_voff_side(nxt, ui + 1, RA, CA, vN, lds); }
            unsigned vS[2][2];
#pragma unroll
            for (int h = 0; h < 2; ++h)
#pragma unroll
                for (int i = 0; i < 2; ++i) vS[h][i] = last ? vN[h][i] : vC[h][i];
            PG8_LDB(B0, 0, 0); PG8_LDB(B1, 0, 1); PG8_SCHED; PG8_LDA(At, 0, 0); PG8_STAGE(PG8_SA(1, 1), a1, vC[1]);
            PG8_WAIT_V(8); PG8_WAIT_L(0); PG8_BAR; PG8_MMA(0, 0, At, B0); PG8_MMA(0, 1, At, B1); PG8_BAR; PG8_SCHED;
            PG8_LDA(At, 0, 1); PG8_STAGE(PG8_SB(0, 0), b2, voffB); PG8_STAGE(PG8_SB(0, 1), b2 + hstep, voffB); PG8_STAGE(PG8_SA(0, 0), a2, vS[0]);
            PG8_WAIT_V(8); PG8_WAIT_L(0); PG8_BAR; PG8_MMA(1, 0, At, B0); PG8_MMA(1, 1, At, B1); PG8_BAR; PG8_SCHED;
            PG8_LDB(B0, 1, 0); PG8_LDB(B1, 1, 1); PG8_SCHED; PG8_LDA(At, 1, 0); PG8_STAGE(PG8_SA(0, 1), a2, vS[1]);
            PG8_WAIT_V(8); PG8_WAIT_L(0); PG8_BAR; PG8_MMA(0, 0, At, B0); PG8_MMA(0, 1, At, B1); PG8_BAR; PG8_SCHED;
            PG8_LDA(At, 1, 1); PG8_STAGE(PG8_SB(1, 0), b3, voffB); PG8_STAGE(PG8_SB(1, 1), b3 + hstep, voffB); PG8_STAGE(PG8_SA(1, 0), a3, vS[0]);
            PG8_WAIT_V(8); PG8_WAIT_L(0); PG8_BAR; PG8_MMA(1, 0, At, B0); PG8_MMA(1, 1, At, B1); PG8_BAR; PG8_SCHED;
        }
        if constexpr (ALIGN_EPI) { if (wr == 0) PG8_BAR; }
        if constexpr (P::FP8) asm volatile("s_nop 15\n\ts_nop 7" ::: "memory");
        if constexpr (P::KREP == 2) {
#pragma unroll
            for (int a = 0; a < 2; ++a)
#pragma unroll
                for (int b = 0; b < 2; ++b)
#pragma unroll
                    for (int m = 0; m < 4; ++m)
#pragma unroll
                        for (int n = 0; n < 2; ++n) acc[a][b][m][n] = acc[a][b][m][n] * 0.5f; }
        S.epi(acc, cur, ui, wr, wc, fr, fq, lds);
#ifdef PROBE_EPI2
        if constexpr (P::IDEM) { asm volatile("" ::: "memory"); S.epi(acc, cur, ui, wr, wc, fr, fq, lds); }
#endif
        if (!has_next) break;
#pragma unroll
        for (int a = 0; a < 2; ++a)
#pragma unroll
            for (int b = 0; b < 2; ++b)
#pragma unroll
                for (int m = 0; m < 4; ++m)
#pragma unroll
                    for (int n = 0; n < 2; ++n) acc[a][b][m][n] = (f32x4){0.f, 0.f, 0.f, 0.f};
        cur = nxt; cA = nA; cB = nB; ++ui;
#pragma unroll
        for (int h = 0; h < 2; ++h)
#pragma unroll
            for (int i = 0; i < 2; ++i) vC[h][i] = vN[h][i];
        if constexpr (ALIGN_EPI) { if (wr == 1) PG8_BAR; }
    }
    PG8_WAIT_V(0);
    if constexpr (!ALIGN_EPI) { if (wr == 0) PG8_BAR; }
    PG8_BAR;
#undef PG8_SA
#undef PG8_SB
#undef PG8_STAGE
#undef PG8_LDA
#undef PG8_LDB
#undef PG8_MMA
#undef PG8_CAT
#undef PG8_WAIT_V
#undef PG8_WAIT_L
#undef PG8_BAR
#undef PG8_SCHED
}

struct DenseBase {
    const bf16_t* A; const bf16_t* Bt; int nM, nN, G, c;
    __device__ __forceinline__ bool next(int i, Unit& u) const { int pm, pn; if (!tile_order(i, G, c, nM, nN, pm, pn)) return false; u.pm = pm; u.pn = pn; u.e = 0; u.row0 = 0; u.nrows = 256; u.arow = pm * 256; return true; }
    __device__ __forceinline__ const char* a_ptr(const Unit& u) const { return (const char*)A + (size_t)u.pm * (size_t)(BM * KD * 2); }
    __device__ __forceinline__ const char* b_ptr(const Unit& u) const { return (const char*)Bt + (size_t)u.pn * (size_t)(BM * KD * 2); }
    __device__ __forceinline__ void a_voff(const Unit&, const int (&RA)[2], const int (&CA)[2], unsigned (&v)[2][2]) const {
#pragma unroll
        for (int h = 0; h < 2; ++h)
#pragma unroll
            for (int i = 0; i < 2; ++i) v[h][i] = (unsigned)((RA[i] + HALF * h) * KD + CA[i]) * 2u; }
};

struct ProbInProj : DenseBase {
    static constexpr bool PERM = true;
#ifdef PROBE_KX2_ProbInProj
    static constexpr int KREP = 2;
#else
    static constexpr int KREP = 1;
#endif
    static constexpr bool SIDE = false, IDEM = false, FP8 = false; static constexpr int SCW = 0, SCX = 0;
    bf16_t* PROJ; const float* rc; const float* rs; const float* mc; const float* ms; float* ksum;
    __device__ __forceinline__ void epi(const f32x4 (&acc)[2][2][4][2], const Unit& u, int, int wr, int wc, int fr, int fq, LAS unsigned char*) const {
        const int pn = u.pn; const int rowt = u.pm * BM + wr * 64 + fr;
        if (pn <= 1) {
            const float sc = pn == 0 ? 1.f : 0.125f;
#pragma unroll
            for (int ai = 0; ai < 2; ++ai)
#pragma unroll
                for (int m = 0; m < 4; ++m) { const int row = rowt + ai * HALF + m * 16, s = row & (SEQ - 1);
                    const f32x4 c0 = *(const f32x4*)(rc + s * 32 + 8 * fq), c1 = *(const f32x4*)(rc + s * 32 + 8 * fq + 4);
                    const f32x4 s0 = *(const f32x4*)(rs + s * 32 + 8 * fq), s1 = *(const f32x4*)(rs + s * 32 + 8 * fq + 4);
                    const f32x4 a0 = acc[ai][0][m][0], a1 = acc[ai][0][m][1], b0 = acc[ai][1][m][0], b1 = acc[ai][1][m][1];
                    const f32x4 o10 = (a0 * c0 - b0 * s0) * sc, o11 = (a1 * c1 - b1 * s1) * sc, o20 = (a0 * s0 + b0 * c0) * sc, o21 = (a1 * s1 + b1 * c1) * sc;
                    bf16_t* dst = PROJ + (size_t)row * DIN + pn * 256 + 64 * wc + 8 * fq;
                    *(u32x4*)dst = pack8(o10, o11); *(u32x4*)(dst + 32) = pack8(o20, o21); asm volatile("" ::: "memory"); }
        } else if (pn >= 6 && pn <= 9) {
            const bool rot = ((wc & 1) == 0) && (fq < 2); const float sc = pn < 8 ? QC2 : 1.f; const bool isk = pn >= 8;
            f32x4 ks[2][2];
#pragma unroll
            for (int bj = 0; bj < 2; ++bj)
#pragma unroll
                for (int n = 0; n < 2; ++n) ks[bj][n] = (f32x4){0.f, 0.f, 0.f, 0.f};
#pragma unroll
            for (int ai = 0; ai < 2; ++ai)
#pragma unroll
                for (int m = 0; m < 4; ++m) { const int row = rowt + ai * HALF + m * 16, s = row & (SEQ - 1);
                    f32x4 c = *(const f32x4*)(mc + s * 8 + 4 * (fq & 1)), sn = *(const f32x4*)(ms + s * 8 + 4 * (fq & 1));
                    if (!rot) { c = (f32x4){1.f, 1.f, 1.f, 1.f}; sn = (f32x4){0.f, 0.f, 0.f, 0.f}; }
#pragma unroll
                    for (int bj = 0; bj < 2; ++bj) { const f32x4 v0 = acc[ai][bj][m][0], v1 = acc[ai][bj][m][1];
                        const f32x4 n0 = (v0 * c - v1 * sn) * sc, n1 = (v0 * sn + v1 * c) * sc;
                        if (isk) { ks[bj][0] += n0; ks[bj][1] += n1; asm volatile("" : "+v"(ks[bj][0]), "+v"(ks[bj][1])); }
                        *(u32x4*)(PROJ + (size_t)row * DIN + pn * 256 + bj * HALF + 32 * wc + 8 * fq) = pack8(n0, n1); }
                    asm volatile("" ::: "memory"); }
            if (isk) {
#pragma unroll
                for (int bj = 0; bj < 2; ++bj)
#pragma unroll
                    for (int n = 0; n < 2; ++n)
#pragma unroll
                        for (int e = 0; e < 4; ++e) { float v = ks[bj][n][e]; v += __shfl_xor(v, 1); v += __shfl_xor(v, 2); v += __shfl_xor(v, 4); v += __shfl_xor(v, 8); ks[bj][n][e] = v; }
                if (fr == 0) {
#pragma unroll
                    for (int bj = 0; bj < 2; ++bj)
#pragma unroll
                        for (int n = 0; n < 2; ++n) *(f32x4*)(ksum + ((size_t)u.pm * 2 + wr) * 512 + (pn - 8) * 256 + bj * HALF + 32 * wc + 8 * fq + 4 * n) = ks[bj][n]; }
            }
        } else {
#pragma unroll
            for (int ai = 0; ai < 2; ++ai)
#pragma unroll
                for (int m = 0; m < 4; ++m) { const int row = rowt + ai * HALF + m * 16;
#pragma unroll
                    for (int bj = 0; bj < 2; ++bj) *(u32x4*)(PROJ + (size_t)row * DIN + pn * 256 + bj * HALF + 32 * wc + 8 * fq) = pack8(acc[ai][bj][m][0], acc[ai][bj][m][1]); }
        }
    }
};

struct ProbOutProj : DenseBase {
    static constexpr bool PERM = false;
#ifdef PROBE_KX2_ProbOutProj
    static constexpr int KREP = 2;
#else
    static constexpr int KREP = 1;
#endif
    static constexpr bool SIDE = false, IDEM = false, FP8 = false; static constexpr int SCW = 0, SCX = 0;
    const float* x; float* X1;
    __device__ __forceinline__ void epi(const f32x4 (&acc)[2][2][4][2], const Unit& u, int, int wr, int wc, int fr, int fq, LAS unsigned char*) const {
        const int row0 = u.pm * BM + wr * 64 + fr, col0 = u.pn * BM + wc * 32 + 4 * fq;
#pragma unroll
        for (int ai = 0; ai < 2; ++ai)
#pragma unroll
            for (int m = 0; m < 4; ++m) { const size_t off = (size_t)(row0 + ai * HALF + m * 16) * DM + col0;
#pragma unroll
                for (int bj = 0; bj < 2; ++bj)
#pragma unroll
                    for (int n = 0; n < 2; ++n) *(f32x4*)(X1 + off + bj * HALF + n * 16) = *(const f32x4*)(x + off + bj * HALF + n * 16) + acc[ai][bj][m][n]; }
    }
};

struct MoeBase {
    int T, NP, G, c; const LAS int* tpre; const LAS int* cpre;
    __device__ __forceinline__ bool next(int i, Unit& u) const {
        int pm, pn; if (!tile_order(i, G, c, T, NP, pm, pn)) return false;
        int e = 0;
#pragma unroll 1
        for (; e < NEXP - 1; ++e) { if (pm < __builtin_amdgcn_readfirstlane(tpre[e + 1])) break; }
        const int t0 = __builtin_amdgcn_readfirstlane(tpre[e]), c0 = __builtin_amdgcn_readfirstlane(cpre[e]), c1 = __builtin_amdgcn_readfirstlane(cpre[e + 1]);
        u.pm = pm; u.pn = pn; u.e = e; u.row0 = (pm - t0) * 256; const int rem = (c1 - c0) - u.row0; u.nrows = rem < 256 ? rem : 256; u.arow = c0 + u.row0; return true;
    }
};
constexpr int SIDE_OFF = RING_BYTES + 1024, SIDE_PAR = 4096, SD_SLOT = 0, SD_ROW = 1024, SD_BIAS = 2048;
__device__ __forceinline__ void side_dma(const void* gsrc_lane, LAS unsigned char* dst_wave) { __builtin_amdgcn_global_load_lds((const unsigned*)gsrc_lane, (LAS unsigned*)dst_wave, 16, 0, 0); }
struct ProbMoe1 : MoeBase {
    static constexpr bool PERM = true, SIDE = true, IDEM = true, FP8 = true;
    static constexpr int SCW = 0x79797979, SCX = 0x7f7f7f7f;
#ifdef PROBE_KX2_ProbMoe1
    static constexpr int KREP = 2;
#else
    static constexpr int KREP = 1;
#endif
    const unsigned char* H2; const unsigned char* W1T; const int* slot; const float* srstd; const float* b1; unsigned char* ACT;
    __device__ __forceinline__ const char* a_ptr(const Unit&) const { return (const char*)H2; }
    __device__ __forceinline__ const char* b_ptr(const Unit& u) const { return (const char*)W1T + ((size_t)u.e * 2048 + (size_t)u.pn * 256) * (size_t)KD; }
    __device__ __forceinline__ void a_voff(const Unit& u, const int (&RA)[2], const int (&CA)[2], unsigned (&v)[2][2]) const {
#pragma unroll
        for (int h = 0; h < 2; ++h)
#pragma unroll
            for (int i = 0; i < 2; ++i) { int r = RA[i] + HALF * h; r = r < u.nrows ? r : u.nrows - 1; const int pair = slot[(size_t)u.e * NTOK + u.row0 + r]; v[h][i] = (unsigned)(pair >> 2) * (unsigned)KD + (unsigned)CA[i] * 2u; } }
    __device__ __forceinline__ void a_voff_side(const Unit& u, int uin, const int (&RA)[2], const int (&CA)[2], unsigned (&v)[2][2], LAS unsigned char* lds) const {
        const LAS int* sb = (const LAS int*)(lds + SIDE_OFF + (uin & 1) * SIDE_PAR + SD_SLOT);
#pragma unroll
        for (int h = 0; h < 2; ++h)
#pragma unroll
            for (int i = 0; i < 2; ++i) { int r = RA[i] + HALF * h; r = r < u.nrows ? r : u.nrows - 1; const int pair = sb[r]; v[h][i] = (unsigned)(pair >> 2) * (unsigned)KD + (unsigned)CA[i] * 2u; } }
    __device__ __forceinline__ void side_issue(const Unit& cur, const Unit& nxt, bool has_next, int ui, int wid, int lane, LAS unsigned char* lds) const {
        if (wid == 0) { if (has_next) side_dma(slot + (size_t)nxt.e * NTOK + nxt.row0 + 4 * lane, lds + SIDE_OFF + ((ui + 1) & 1) * SIDE_PAR + SD_SLOT); }
        else if (wid == 1) side_dma(srstd + (size_t)cur.e * NTOK + cur.row0 + 4 * lane, lds + SIDE_OFF + (ui & 1) * SIDE_PAR + SD_ROW);
        else if (wid == 2) side_dma(b1 + (size_t)cur.e * 2048 + 128 * cur.pn + ((lane >> 5) * 1024) + 4 * (lane & 31), lds + SIDE_OFF + (ui & 1) * SIDE_PAR + SD_BIAS);
    }
    __device__ __forceinline__ void epi(const f32x4 (&acc)[2][2][4][2], const Unit& u, int ui, int wr, int wc, int fr, int fq, LAS unsigned char* lds) const {
        const LAS unsigned char* sd = lds + SIDE_OFF + (ui & 1) * SIDE_PAR;
        const int cc0 = 32 * wc + 8 * fq; const LAS float* bb = (const LAS float*)(sd + SD_BIAS) + cc0; const LAS float* rsb = (const LAS float*)(sd + SD_ROW);
        const f32x4 bg0 = *(const LAS f32x4*)bb, bg1 = *(const LAS f32x4*)(bb + 4), bl0 = *(const LAS f32x4*)(bb + 128), bl1 = *(const LAS f32x4*)(bb + 132);
#pragma unroll
        for (int ai = 0; ai < 2; ++ai)
#pragma unroll
            for (int m = 0; m < 4; ++m) { const int r = ai * HALF + wr * 64 + m * 16 + fr; const bool valid = r < u.nrows;
                const float rs = rsb[r];
                f32x4 o[2];
#pragma unroll
                for (int n = 0; n < 2; ++n) { f32x4 g = acc[ai][0][m][n] * rs + (n ? bg1 : bg0), l = acc[ai][1][m][n] * rs + (n ? bl1 : bl0);
#pragma unroll
                    for (int e = 0; e < 4; ++e) { const float gg = fminf(g[e], 7.f), ll = fminf(fmaxf(l[e], -7.f), 7.f);
                        const float sg = __builtin_amdgcn_rcpf(1.f + __builtin_amdgcn_exp2f(gg * (-1.702f * 1.4426950408889634f))); o[n][e] = gg * sg * (ll * 4.f + 4.f); } }
                if (valid) *(u32x2*)(ACT + (size_t)(u.arow + r) * DM + 128 * u.pn + cc0) = pack8_fp8(o[0], o[1]); }
    }
};
struct ProbMoe2 : MoeBase {
    static constexpr bool PERM = true, SIDE = true, IDEM = true, FP8 = true;
    static constexpr int SCW = 0x79797979, SCX = 0x7d7d7d7d;
#ifdef PROBE_KX2_ProbMoe2
    static constexpr int KREP = 2;
#else
    static constexpr int KREP = 1;
#endif
    const unsigned char* ACT; const unsigned char* W2T; const int* slot; const float* sgate; const float* b2; bf16_t* Y4;
    __device__ __forceinline__ const char* a_ptr(const Unit& u) const { return (const char*)ACT + (size_t)u.arow * (size_t)KD; }
    __device__ __forceinline__ const char* b_ptr(const Unit& u) const { return (const char*)W2T + ((size_t)u.e * 1024 + (size_t)u.pn * 256) * (size_t)KD; }
    __device__ __forceinline__ void a_voff(const Unit& u, const int (&RA)[2], const int (&CA)[2], unsigned (&v)[2][2]) const {
#pragma unroll
        for (int h = 0; h < 2; ++h)
#pragma unroll
            for (int i = 0; i < 2; ++i) { int r = RA[i] + HALF * h; r = r < u.nrows ? r : u.nrows - 1; v[h][i] = (unsigned)(r * KD + CA[i] * 2); } }
    __device__ __forceinline__ void a_voff_side(const Unit& u, int, const int (&RA)[2], const int (&CA)[2], unsigned (&v)[2][2], LAS unsigned char*) const { a_voff(u, RA, CA, v); }
    __device__ __forceinline__ void side_issue(const Unit& cur, const Unit&, bool, int ui, int wid, int lane, LAS unsigned char* lds) const {
        if (wid == 0) side_dma(slot + (size_t)cur.e * NTOK + cur.row0 + 4 * lane, lds + SIDE_OFF + (ui & 1) * SIDE_PAR + SD_SLOT);
        else if (wid == 1) side_dma(sgate + (size_t)cur.e * NTOK + cur.row0 + 4 * lane, lds + SIDE_OFF + (ui & 1) * SIDE_PAR + SD_ROW);
        else if (wid == 2) side_dma(b2 + (size_t)cur.e * 1024 + 256 * cur.pn + 4 * lane, lds + SIDE_OFF + (ui & 1) * SIDE_PAR + SD_BIAS);
    }
    __device__ __forceinline__ void epi(const f32x4 (&acc)[2][2][4][2], const Unit& u, int ui, int wr, int wc, int fr, int fq, LAS unsigned char* lds) const {
        const LAS unsigned char* sd = lds + SIDE_OFF + (ui & 1) * SIDE_PAR;
        const int cl0 = 32 * wc + 8 * fq, col0 = u.pn * BM + cl0; const LAS float* bb = (const LAS float*)(sd + SD_BIAS) + cl0;
        const LAS int* psb = (const LAS int*)(sd + SD_SLOT); const LAS float* gsb = (const LAS float*)(sd + SD_ROW);
        f32x4 bv[2][2];
#pragma unroll
        for (int bj = 0; bj < 2; ++bj)
#pragma unroll
            for (int n = 0; n < 2; ++n) bv[bj][n] = *(const LAS f32x4*)(bb + bj * HALF + 4 * n);
#pragma unroll
        for (int ai = 0; ai < 2; ++ai)
#pragma unroll
            for (int m = 0; m < 4; ++m) { const int r = ai * HALF + wr * 64 + m * 16 + fr; const bool valid = r < u.nrows;
                const int pair = psb[r]; const float gt = gsb[r];
                if (valid) { bf16_t* p = Y4 + (size_t)pair * DM + col0;
#pragma unroll
                    for (int bj = 0; bj < 2; ++bj) *(u32x4*)(p + bj * HALF) = pack8((acc[ai][bj][m][0] + bv[bj][0]) * gt, (acc[ai][bj][m][1] + bv[bj][1]) * gt); } }
    }
};
}

namespace moba {
using bf16 = __hip_bfloat16;
constexpr int D = 64, PP = DIN, OP = DM;
constexpr int NW = 8, QBLK = 32, QB = QBLK * NW, KVBLK = 64;
__device__ __forceinline__ int crow(int r, int hi) { return (r & 3) + 8 * (r >> 2) + 4 * hi; }
#define SBAR() __builtin_amdgcn_sched_barrier(0)
__device__ __forceinline__ void cmask(f32x16& p0, f32x16& p1, int jb, int qrel, int hi) {
  const float NEG = -INFINITY; int kb = 64 * jb + 4 * hi;
  #pragma unroll
  for (int r = 0; r < 16; ++r) { int kv = kb + (r & 3) + 8 * (r >> 2); if (kv > qrel) p0[r] = NEG; if (kv + 32 > qrel) p1[r] = NEG; }
}
constexpr int NSLOT = 3, SLOTB = 8192;
constexpr int LDS_K = 0, LDS_V = NSLOT * SLOTB, LDS_WS = 2 * NSLOT * SLOTB, LDS_OST = LDS_WS + NW * 64 * 4, LDS_BYTES_A = LDS_OST + NW * 4096;
__device__ __forceinline__ void glds16s(const void* sbase, unsigned voff, unsigned lds_dst) { unsigned keep;
  asm volatile("s_mov_b32 %0, m0\n\ts_mov_b32 m0, %3\n\ts_nop 4\n\tglobal_load_lds_dwordx4 %1, %2\n\ts_mov_b32 m0, %0" : "=&s"(keep) : "v"(voff), "s"(sbase), "s"(lds_dst) : "memory"); }
__device__ __forceinline__ float max3f(float a, float b, float c) { float r; asm("v_max3_f32 %0, %1, %2, %3" : "=v"(r) : "v"(a), "v"(b), "v"(c)); return r; }
__device__ __forceinline__ float max2f(float a, float b) { float r; asm("v_max_f32_e32 %0, %1, %2" : "=v"(r) : "v"(a), "v"(b)); return r; }
__device__ __forceinline__ float fadd_s(float a, float b) { float r; asm("v_add_f32_e32 %0, %1, %2" : "=v"(r) : "v"(a), "v"(b)); return r; }
__device__ __forceinline__ float fsub_s(float a, float b) { float r; asm("v_sub_f32_e32 %0, %1, %2" : "=v"(r) : "v"(a), "v"(b)); return r; }
typedef __bf16 bf16x2_t __attribute__((ext_vector_type(2)));
__device__ __forceinline__ unsigned cvtpk_s(float lo, float hi) { f32x2 v = {lo, hi}; bf16x2_t b = __builtin_convertvector(v, bf16x2_t); return __builtin_bit_cast(unsigned, b); }
#define WAIT_BAR(N) asm volatile("s_waitcnt vmcnt(" #N ") lgkmcnt(0)\n\ts_barrier" ::: "memory")
__device__ __forceinline__ void qkt(f32x16& p0, f32x16& p1, const char* Kslot, const bf16x8* qr, const f32x16& negm, int r32, int hi) {
  const char* kb = Kslot + hi * 1024 + r32 * 16;
  #pragma unroll
  for (int d0 = 0; d0 < 4; ++d0) {
    const bf16x8 b0 = *reinterpret_cast<const bf16x8*>(kb + d0 * 2048);
    const bf16x8 b1 = *reinterpret_cast<const bf16x8*>(kb + d0 * 2048 + 512);
    if (d0 == 0) { p0 = __builtin_amdgcn_mfma_f32_32x32x16_bf16(b0, qr[0], negm, 0, 0, 0); p1 = __builtin_amdgcn_mfma_f32_32x32x16_bf16(b1, qr[0], negm, 0, 0, 0); }
    else { p0 = __builtin_amdgcn_mfma_f32_32x32x16_bf16(b0, qr[d0], p0, 0, 0, 0); p1 = __builtin_amdgcn_mfma_f32_32x32x16_bf16(b1, qr[d0], p1, 0, 0, 0); } }
}
typedef LAS const char* lds_cptr;
typedef short v4i16_t __attribute__((ext_vector_type(4)));
__device__ __forceinline__ void kload8(bf16x8* kf, lds_cptr kp) {
  kf[0] = *(const LAS bf16x8*)(kp);        kf[1] = *(const LAS bf16x8*)(kp + 512);
  kf[2] = *(const LAS bf16x8*)(kp + 2048); kf[3] = *(const LAS bf16x8*)(kp + 2560);
  kf[4] = *(const LAS bf16x8*)(kp + 4096); kf[5] = *(const LAS bf16x8*)(kp + 4608);
  kf[6] = *(const LAS bf16x8*)(kp + 6144); kf[7] = *(const LAS bf16x8*)(kp + 6656);
}
__device__ __forceinline__ void kload2(bf16x8* kf, lds_cptr kp, int j) { kf[2 * j] = *(const LAS bf16x8*)(kp + j * 2048); kf[2 * j + 1] = *(const LAS bf16x8*)(kp + j * 2048 + 512); }
__device__ __forceinline__ s16x4 vtr(lds_cptr p) { return __builtin_bit_cast(s16x4, __builtin_amdgcn_ds_read_tr16_b64_v4i16((LAS v4i16_t*)p)); }
__device__ __forceinline__ float rowmax(const f32x16& p0, const f32x16& p1) {
  float a = max3f(p0[0], p0[1], p1[0]), b = max3f(p0[2], p0[3], p1[1]); a = max3f(a, p1[2], p1[3]);
  #pragma unroll
  for (int r = 4; r < 16; r += 4) { a = max3f(a, p0[r], p0[r + 1]); b = max3f(b, p0[r + 2], p0[r + 3]); a = max3f(a, p1[r], p1[r + 1]); b = max3f(b, p1[r + 2], p1[r + 3]); }
  const float m = max2f(a, b);
  auto rr = __builtin_amdgcn_permlane32_swap(__float_as_uint(m), __float_as_uint(m), false, false);
  return max2f(__uint_as_float(rr[0]), __uint_as_float(rr[1]));
}
__device__ __forceinline__ void pv(f32x16* o, int vb, bf16x8 pa0, bf16x8 pa1, bf16x8 pa2, bf16x8 pa3) {
  #pragma unroll
  for (int d0 = 0; d0 < 2; ++d0) { s16x4 lo[4], hi[4];
    #pragma unroll
    for (int ks = 0; ks < 4; ++ks) {
      asm volatile("ds_read_b64_tr_b16 %0,%1 offset:%c2" : "=&v"(lo[ks]) : "v"(vb), "i"(d0 * 4096 + ks * 1024) : "memory");
      asm volatile("ds_read_b64_tr_b16 %0,%1 offset:%c2" : "=&v"(hi[ks]) : "v"(vb), "i"(d0 * 4096 + ks * 1024 + 512) : "memory"); }
    asm volatile("s_waitcnt lgkmcnt(0)" ::: "memory"); SBAR();
    #define PK(k) (bf16x8){lo[k][0], lo[k][1], lo[k][2], lo[k][3], hi[k][0], hi[k][1], hi[k][2], hi[k][3]}
    o[d0] = __builtin_amdgcn_mfma_f32_32x32x16_bf16(pa0, PK(0), o[d0], 0, 0, 0);
    o[d0] = __builtin_amdgcn_mfma_f32_32x32x16_bf16(pa1, PK(1), o[d0], 0, 0, 0);
    o[d0] = __builtin_amdgcn_mfma_f32_32x32x16_bf16(pa2, PK(2), o[d0], 0, 0, 0);
    o[d0] = __builtin_amdgcn_mfma_f32_32x32x16_bf16(pa3, PK(3), o[d0], 0, 0, 0);
    #undef PK
  }
}

template <int THRL> __device__ __forceinline__ void moba_unit(int b, int h, int qb, const bf16* PROJ, const float* ksum, bf16* MIX, char* shm) {
  int tid_ = threadIdx.x; asm volatile("" : "+v"(tid_));
  const int tid = tid_, lane = tid & 63, r32 = lane & 31, hi = lane >> 5; const int wid = __builtin_amdgcn_readfirstlane(tid >> 6);
  const long rowbase = (long)b * SEQ; const int q0 = qb * QB;
  const bf16* Qw = PROJ + (rowbase + q0 + wid * QBLK) * PP + PC_MQ + h * D;
  const bf16* Kh = PROJ + rowbase * PP + PC_MK + h * D, *Vh = PROJ + rowbase * PP + PC_MV + h * D;
  const unsigned lds0 = (unsigned)(uintptr_t)shm;
  float* wsf = (float*)(shm + LDS_WS) + wid * 64;
  const unsigned kvo = (unsigned)(lane * PP + wid * 8) * 2u;
  const unsigned vvo = (unsigned)((16 * (wid & 3) + (lane >> 2)) * PP + (wid >> 2) * 32 + (lane & 3) * 8) * 2u;
  const unsigned kdst = lds0 + LDS_K + wid * 1024, vdst = lds0 + LDS_V + wid * 1024;
  const int tb4 = 4 * qb;
  #define TM(t) (((t) < 4) ? (tb4 + (t)) : ((t) - 4))
  #define DMA_K(t, slot) glds16s(Kh + (long)TM(t) * KVBLK * PP, kvo, (unsigned)__builtin_amdgcn_readfirstlane(kdst + (slot)))
  #define DMA_V(t, slot) glds16s(Vh + (long)TM(t) * KVBLK * PP, vvo, (unsigned)__builtin_amdgcn_readfirstlane(vdst + (slot)))
  const int vb0 = (int)(lds0 + LDS_V) + ((lane >> 4) & 1) * 32 + (lane & 3) * 8 + (4 * hi + ((lane & 15) >> 2)) * 64;
  const char* Kbase = shm + LDS_K; bf16x8 kf[8];
  const lds_cptr shm3 = (lds_cptr)shm; const lds_cptr kp0 = shm3 + LDS_K + hi * 1024 + r32 * 16; const lds_cptr vp0 = shm3 + LDS_V + ((lane >> 4) & 1) * 32 + (lane & 3) * 8 + (4 * hi + ((lane & 15) >> 2)) * 64;
  const int NT = tb4 + 4;
  DMA_K(0, 0); DMA_V(0, 0); DMA_K(1, SLOTB);
  bf16x8 qr[4];
  #pragma unroll
  for (int d0 = 0; d0 < 4; ++d0) qr[d0] = *reinterpret_cast<const bf16x8*>(&Qw[(long)r32 * PP + d0 * 16 + hi * 8]);
  unsigned sel = (1u << qb) - 1u;
  if (qb > 3) {
    float v1 = -INFINITY, v2 = -INFINITY, v3 = -INFINITY; int i1 = 0, i2 = 0, i3 = 0;
    #pragma unroll 1
    for (int j = 0; j < qb; ++j) {
      const float* k0 = ksum + ((size_t)(b * 8 + j) * 2) * 512 + h * D + hi * 8; float p = 0.f;
      #pragma unroll
      for (int d0 = 0; d0 < 4; ++d0) { const f32x4 a0 = *(const f32x4*)(k0 + 16 * d0) + *(const f32x4*)(k0 + 512 + 16 * d0), a1 = *(const f32x4*)(k0 + 16 * d0 + 4) + *(const f32x4*)(k0 + 512 + 16 * d0 + 4);
        #pragma unroll
        for (int i = 0; i < 4; ++i) { p += bf2f((unsigned short)qr[d0][i]) * a0[i]; p += bf2f((unsigned short)qr[d0][4 + i]) * a1[i]; } }
      p += __shfl_xor(p, 32);
      if (p > v1) { v3 = v2; i3 = i2; v2 = v1; i2 = i1; v1 = p; i1 = j; } else if (p > v2) { v3 = v2; i3 = i2; v2 = p; i2 = j; } else if (p > v3) { v3 = p; i3 = j; }
    }
    sel = (1u << i1) | (1u << i2) | (1u << i3);
  }
  float mhat = 0.f, l_reg = 0.f; f32x16 o[2]; o[0] = f32x16{}; o[1] = f32x16{}; const f32x16 zero16 = f32x16{};
  const int qrel = wid * QBLK + r32;
  #define CMASK(P0, P1, t) do { if ((t) < 4) cmask(P0, P1, (t), qrel, hi); } while (0)
  #define NVAL(t) (((t) >= 4 && !((sel >> (((t) - 4) >> 2)) & 1u)) ? -INFINITY : -mhat)
  bool resc = false;
  #define START(P0, P1) do { const float rm = rowmax(P0, P1); resc = false; \
    { const float dl = rm; mhat = fadd_s(mhat, dl); \
      _Pragma("unroll") for (int r = 0; r < 16; ++r) { P0[r] = fsub_s(P0[r], dl); P1[r] = fsub_s(P1[r], dl); } } \
    _Pragma("unroll") for (int r = 0; r < 16; ++r) P0[r] = __builtin_amdgcn_exp2f(P0[r]); } while (0)
  #define RESC() do { if (resc) { asm volatile("s_waitcnt lgkmcnt(0)" ::: "memory"); \
      _Pragma("unroll") for (int d_ = 0; d_ < 2; ++d_) _Pragma("unroll") for (int r = 0; r < 16; ++r) o[d_][r] *= wsf[crow(r, hi)]; } } while (0)
  f32x16 pA0, pA1, pB0, pB1;
  int sl_prev = 0, sl_cur = 0, sl_next = SLOTB;
  #define ROT() do { sl_prev = sl_cur; sl_cur = sl_next; sl_next = (sl_next == (NSLOT - 1) * SLOTB) ? 0 : sl_next + SLOTB; } while (0)
  DMA_K(2, 2 * SLOTB);
  WAIT_BAR(3);
  qkt(pA0, pA1, Kbase, qr, zero16, r32, hi); asm volatile("s_nop 15\n\ts_nop 7" : "+v"(pA0), "+v"(pA1)); CMASK(pA0, pA1, 0);
  START(pA0, pA1);
  _Pragma("unroll") for (int r = 0; r < 16; ++r) pA1[r] = __builtin_amdgcn_exp2f(pA1[r]);
  WAIT_BAR(0);
  DMA_K(3, 0); DMA_V(1, SLOTB);
  ROT();
  kload8(kf, kp0 + sl_cur);
  WAIT_BAR(2);
  s16x4 vlo[8], vhi[8]; u32x4 pw0, pw1, pw2, pw3;
  #define PKW(P, B) cvtpk_s(P[B], P[B + 1])
  #define PAF(k) __builtin_bit_cast(bf16x8, pw##k)
  #define VFR(i) (bf16x8){vlo[i][0], vlo[i][1], vlo[i][2], vlo[i][3], vhi[i][0], vhi[i][1], vhi[i][2], vhi[i][3]}
  #define PIN(x) asm volatile("" : "+v"(x))
  #define MX3(a, b, c) __builtin_fmaxf(__builtin_fmaxf((a), (b)), (c))
  #define GAPA(MF, A0, A1, A2, A3, W0, W1, PW) do { MF; sacc += A0; sacc += A1; sacc += A2; sacc += A3; PIN(sacc); W0; W1; PIN(PW); SBAR(); } while (0)
  #define EX(v) __builtin_amdgcn_exp2f(v)
  #define GAPB(MF, X, B) do { MF; X[B] = EX(X[B]); X[B + 1] = EX(X[B + 1]); X[B + 2] = EX(X[B + 2]); X[B + 3] = EX(X[B + 3]); PIN(X); SBAR(); } while (0)
  #define VRD(i) do { vlo[i] = vtr(vp_ + (((i) >> 2) * 4096 + ((i) & 3) * 1024)); vhi[i] = vtr(vp_ + (((i) >> 2) * 4096 + ((i) & 3) * 1024 + 512)); } while (0)
  #define KRD(G, j) do { if (G) { kload2(kf, kp0 + sl_next, j); SBAR(); } } while (0)
  #define STEP(C0, C1, P0, P1, t, GK, GV, GL) do { const float nv_ = NVAL(t); SBAR(); \
    const lds_cptr vp_ = vp0 + sl_prev; \
    VRD(0); SBAR(); float sacc = (P0[0] + P0[1]); \
    GAPA(C0 = __builtin_amdgcn_mfma_f32_32x32x16_bf16(kf[0], qr[0], zero16, 0, 0, 0), P0[2], P0[3], P0[4], P0[5],     pw0[0] = PKW(P0, 0), pw0[1] = PKW(P0, 2), pw0); \
    VRD(4); SBAR(); GAPA(C1 = __builtin_amdgcn_mfma_f32_32x32x16_bf16(kf[1], qr[0], zero16, 0, 0, 0), P0[6], P0[7], P0[8], P0[9],     pw0[2] = PKW(P0, 4), pw0[3] = PKW(P0, 6), pw0); \
    VRD(1); SBAR(); GAPA(C0 = __builtin_amdgcn_mfma_f32_32x32x16_bf16(kf[2], qr[1], C0, 0, 0, 0),   P0[10], P0[11], P0[12], P0[13], pw1[0] = PKW(P0, 8), pw1[1] = PKW(P0, 10), pw1); \
    VRD(5); SBAR(); GAPA(C1 = __builtin_amdgcn_mfma_f32_32x32x16_bf16(kf[3], qr[1], C1, 0, 0, 0),   P0[14], P0[15], P1[0], P1[1],   pw1[2] = PKW(P0, 12), pw1[3] = PKW(P0, 14), pw1); \
    VRD(2); SBAR(); GAPA(C0 = __builtin_amdgcn_mfma_f32_32x32x16_bf16(kf[4], qr[2], C0, 0, 0, 0),   P1[2], P1[3], P1[4], P1[5],     pw2[0] = PKW(P1, 0), pw2[1] = PKW(P1, 2), pw2); \
    VRD(6); SBAR(); GAPA(C1 = __builtin_amdgcn_mfma_f32_32x32x16_bf16(kf[5], qr[2], C1, 0, 0, 0),   P1[6], P1[7], P1[8], P1[9],     pw2[2] = PKW(P1, 4), pw2[3] = PKW(P1, 6), pw2); \
    VRD(3); SBAR(); GAPA(C0 = __builtin_amdgcn_mfma_f32_32x32x16_bf16(kf[6], qr[3], C0, 0, 0, 0),   P1[10], P1[11], P1[12], P1[13], pw3[0] = PKW(P1, 8), pw3[1] = PKW(P1, 10), pw3); \
    VRD(7); SBAR(); GAPA(C1 = __builtin_amdgcn_mfma_f32_32x32x16_bf16(kf[7], qr[3], C1, 0, 0, 0),   P1[14], P1[15], 0.f, 0.f,       pw3[2] = PKW(P1, 12), pw3[3] = PKW(P1, 14), pw3); \
    l_reg += sacc; \
    if (GK) { DMA_K((t) + 3, sl_cur); } if (GV) { DMA_V((t) + 1, sl_next); } \
    _Pragma("unroll") for (int r = 0; r < 16; ++r) { C0[r] += nv_; C1[r] += nv_; } \
    CMASK(C0, C1, t); \
    { float a = MX3(C0[0], C0[1], C1[0]), b = MX3(C0[2], C0[3], C1[1]); a = MX3(a, C1[2], C1[3]); \
      _Pragma("unroll") for (int r = 4; r < 16; r += 4) { a = MX3(a, C0[r], C0[r + 1]); b = MX3(b, C0[r + 2], C0[r + 3]); a = MX3(a, C1[r], C1[r + 1]); b = MX3(b, C1[r + 2], C1[r + 3]); } \
      float rm = __builtin_fmaxf(a, b); { auto rr = __builtin_amdgcn_permlane32_swap(__float_as_uint(rm), __float_as_uint(rm), false, false); rm = __builtin_fmaxf(__uint_as_float(rr[0]), __uint_as_float(rr[1])); } \
      resc = false; \
      if (__builtin_expect(__any(rm > (float)THRL), 0)) { const float dl = __builtin_fmaxf(rm, 0.f); mhat += dl; \
        _Pragma("unroll") for (int r = 0; r < 16; ++r) { C0[r] -= dl; C1[r] -= dl; } \
        const float f = __builtin_amdgcn_exp2f(-dl); l_reg *= f; if (hi == 0) wsf[r32] = f; resc = true; } } \
    SBAR(); \
    GAPB(o[0] = __builtin_amdgcn_mfma_f32_32x32x16_bf16(PAF(0), VFR(0), o[0], 0, 0, 0), C0, 0); \
    GAPB(o[1] = __builtin_amdgcn_mfma_f32_32x32x16_bf16(PAF(0), VFR(4), o[1], 0, 0, 0), C0, 4); \
    KRD(GL, 0); GAPB(o[0] = __builtin_amdgcn_mfma_f32_32x32x16_bf16(PAF(1), VFR(1), o[0], 0, 0, 0), C0, 8); \
    KRD(GL, 1); GAPB(o[1] = __builtin_amdgcn_mfma_f32_32x32x16_bf16(PAF(1), VFR(5), o[1], 0, 0, 0), C0, 12); \
    KRD(GL, 2); GAPB(o[0] = __builtin_amdgcn_mfma_f32_32x32x16_bf16(PAF(2), VFR(2), o[0], 0, 0, 0), C1, 0); \
    KRD(GL, 3); GAPB(o[1] = __builtin_amdgcn_mfma_f32_32x32x16_bf16(PAF(2), VFR(6), o[1], 0, 0, 0), C1, 4); \
    GAPB(o[0] = __builtin_amdgcn_mfma_f32_32x32x16_bf16(PAF(3), VFR(3), o[0], 0, 0, 0), C1, 8); \
    GAPB(o[1] = __builtin_amdgcn_mfma_f32_32x32x16_bf16(PAF(3), VFR(7), o[1], 0, 0, 0), C1, 12); \
    } while (0)
  int t = 1;
  for (; t + 1 < NT; t += 2) {
    STEP(pB0, pB1, pA0, pA1, t, true, true, true);     WAIT_BAR(2); RESC(); ROT();
    STEP(pA0, pA1, pB0, pB1, t + 1, true, true, true); WAIT_BAR(2); RESC(); ROT();
  }
  STEP(pB0, pB1, pA0, pA1, NT - 1, true, true, true); WAIT_BAR(2); RESC();
  { float sacc = pB0[0] + pB0[1]; _Pragma("unroll") for (int r = 2; r < 16; ++r) sacc += pB0[r]; _Pragma("unroll") for (int r = 0; r < 16; ++r) sacc += pB1[r]; l_reg += sacc;
    pw0 = (u32x4){PKW(pB0, 0), PKW(pB0, 2), PKW(pB0, 4), PKW(pB0, 6)}; pw1 = (u32x4){PKW(pB0, 8), PKW(pB0, 10), PKW(pB0, 12), PKW(pB0, 14)}; pw2 = (u32x4){PKW(pB1, 0), PKW(pB1, 2), PKW(pB1, 4), PKW(pB1, 6)}; pw3 = (u32x4){PKW(pB1, 8), PKW(pB1, 10), PKW(pB1, 12), PKW(pB1, 14)};
    SBAR(); pv(o, vb0 + sl_cur, PAF(0), PAF(1), PAF(2), PAF(3)); }
  #undef PKW
  #undef PAF
  #undef VFR
  #undef PIN
  #undef MX3
  #undef GAPA
  #undef GAPB
  #undef EX
  #undef VRD
  #undef KRD
  #undef STEP
  { auto rr = __builtin_amdgcn_permlane32_swap(__float_as_uint(l_reg), __float_as_uint(l_reg), false, false); l_reg = __uint_as_float(rr[0]) + __uint_as_float(rr[1]); }
  if (hi == 0) wsf[32 + r32] = l_reg; asm volatile("s_waitcnt lgkmcnt(0)" ::: "memory");
  float rli[16];
  #pragma unroll
  for (int r = 0; r < 16; ++r) rli[r] = __builtin_amdgcn_rcpf(wsf[32 + crow(r, hi)]);
  bf16* Ow = MIX + (rowbase + q0 + wid * QBLK) * OP + 512 + h * D;
  { bf16* stg = (bf16*)(shm + LDS_OST) + wid * 2048;
    #pragma unroll
    for (int r = 0; r < 16; ++r) { const int orow = crow(r, hi);
      #pragma unroll
      for (int d0 = 0; d0 < 2; ++d0) stg[orow * 64 + d0 * 32 + r32] = __float2bfloat16(o[d0][r] * rli[r]); }
    asm volatile("s_waitcnt lgkmcnt(0)" ::: "memory");
    #pragma unroll
    for (int i = 0; i < 4; ++i) { const int row = i * 8 + (lane >> 3), ch = lane & 7; const u32x4 v = *(const u32x4*)(stg + row * 64 + ch * 8); *(u32x4*)(Ow + (long)row * OP + ch * 8) = v; } }
  asm volatile("s_waitcnt vmcnt(0) lgkmcnt(0)\n\ts_barrier" ::: "memory");
  #undef DMA_K
  #undef DMA_V
  #undef TM
  #undef CMASK
  #undef NVAL
  #undef START
  #undef RESC
  #undef ROT
}
#undef WAIT_BAR
}

namespace ret {
constexpr int KS_STR = 144, V_STR = 272;
constexpr int L_KS = 0, L_KH = 18432, L_VS = 36864, L_RT = 71680, L_END = 90112;
typedef short v4i16_t __attribute__((ext_vector_type(4)));
__device__ __forceinline__ s16x4 vtr(LAS const char* p) { return __builtin_bit_cast(s16x4, __builtin_amdgcn_ds_read_tr16_b64_v4i16((LAS v4i16_t*)p)); }
__device__ __forceinline__ bf16x8 cat8(s16x4 a, s16x4 b) { return (bf16x8){a[0], a[1], a[2], a[3], b[0], b[1], b[2], b[3]}; }

__device__ __forceinline__ void ret_unit(int b, int h, const bf16_t* PROJ, const float* rnw, bf16_t* MIX, LAS unsigned char* lds) {
    int tid_ = threadIdx.x; asm volatile("" : "+v"(tid_));
    const int tid = tid_, lane = tid & 63, c16 = lane & 15, g = lane >> 4; const int w = __builtin_amdgcn_readfirstlane(tid >> 6);
    const float log2g = log2f(1.0f - exp2f(-5.0f - (float)h));
    const float gC = exp2f(log2g * 128.0f);
    LAS unsigned char* Ks = lds + L_KS; LAS unsigned char* Kh = lds + L_KH; LAS unsigned char* Vs = lds + L_VS; LAS unsigned char* Rt = lds + L_RT;
    for (int i = tid; i < (L_END - L_RT) / 16; i += 512) *(LAS u32x4*)(Rt + i * 16) = (u32x4){0u, 0u, 0u, 0u};
    f32x4 Racc[4];
#pragma unroll
    for (int dt = 0; dt < 4; ++dt) Racc[dt] = (f32x4){0.f, 0.f, 0.f, 0.f};
    const size_t tokb = (size_t)b * SEQ;
    u32x4 kreg[2], vreg[4]; bf16x8 qn[2];
    const int krow0 = tid >> 3, kcc = tid & 7, vrow0 = tid >> 4, vcc = tid & 15;
#define RET_LOAD(c) do { const bf16_t* base = PROJ + (tokb + (size_t)(c) * 128) * DIN; \
        _Pragma("unroll") for (int i = 0; i < 2; ++i) kreg[i] = *(const u32x4*)(base + (size_t)(krow0 + 64 * i) * DIN + PC_RK + 64 * h + 8 * kcc); \
        _Pragma("unroll") for (int i = 0; i < 4; ++i) vreg[i] = *(const u32x4*)(base + (size_t)(vrow0 + 32 * i) * DIN + PC_RV + 128 * h + 8 * vcc); \
        _Pragma("unroll") for (int k2 = 0; k2 < 2; ++k2) qn[k2] = *(const bf16x8*)(base + (size_t)(16 * w + c16) * DIN + PC_RQ + 64 * h + 32 * k2 + 8 * g); } while (0)
    RET_LOAD(0);
    for (int c = 0; c < 16; ++c) {
#pragma unroll
        for (int i = 0; i < 2; ++i) { const int row = krow0 + 64 * i; *(LAS u32x4*)(Ks + row * KS_STR + kcc * 16) = kreg[i];
            const float z = exp2f(log2g * (float)(127 - row)); u32x4 s;
#pragma unroll
            for (int j = 0; j < 4; ++j) { const unsigned u = kreg[i][j]; s[j] = pk2(bf2f((unsigned short)(u & 0xffffu)) * z, bf2f((unsigned short)(u >> 16)) * z); }
            *(LAS u32x4*)(Kh + row * KS_STR + kcc * 16) = s; }
#pragma unroll
        for (int i = 0; i < 4; ++i) { const int row = vrow0 + 32 * i; *(LAS u32x4*)(Vs + row * V_STR + vcc * 16) = vreg[i]; }
        bf16x8 qf[2]; qf[0] = qn[0]; qf[1] = qn[1];
        __syncthreads();
        if (c + 1 < 16) RET_LOAD(c + 1);
        f32x4 oi[8], oc[8];
#pragma unroll
        for (int et = 0; et < 8; ++et) { oi[et] = (f32x4){0.f, 0.f, 0.f, 0.f}; oc[et] = (f32x4){0.f, 0.f, 0.f, 0.f}; }
        const int trq = c16 >> 2, trp = c16 & 3;
        const int nks = (w >> 1) + 1;
        LAS const char* ksb = (LAS const char*)Ks + c16 * KS_STR + g * 16;
        LAS const char* vtb = (LAS const char*)Vs + (4 * g + trq) * V_STR + trp * 8;
        LAS const char* khb = (LAS const char*)Kh + (4 * g + trq) * KS_STR + trp * 8;
        LAS const char* rtb = (LAS const char*)Rt + c16 * KS_STR + g * 16;
#pragma unroll 1
        for (int ks = 0; ks < nks; ++ks) {
            u32x4 pw;
#pragma unroll
            for (int half = 0; half < 2; ++half) { const int mt = 2 * ks + half; f32x4 st = (f32x4){0.f, 0.f, 0.f, 0.f};
                if (mt <= w) {
#pragma unroll
                    for (int k2 = 0; k2 < 2; ++k2) { const bf16x8 ka = *(const LAS bf16x8*)(ksb + mt * (16 * KS_STR) + k2 * 64);
                        st = __builtin_amdgcn_mfma_f32_16x16x32_bf16(ka, qf[k2], st, 0, 0, 0); } }
                float pv_[4];
#pragma unroll
                for (int r = 0; r < 4; ++r) { const int diff = (16 * w + c16) - (16 * mt + 4 * g + r); pv_[r] = diff >= 0 ? st[r] * exp2f(log2g * (float)diff) : 0.f; }
                pw[2 * half] = pk2(pv_[0], pv_[1]); pw[2 * half + 1] = pk2(pv_[2], pv_[3]); }
            const bf16x8 pf = __builtin_bit_cast(bf16x8, pw);
            LAS const char* vp = vtb + ks * (32 * V_STR);
#pragma unroll
            for (int et = 0; et < 8; ++et) { const bf16x8 vf = cat8(vtr(vp + et * 32), vtr(vp + et * 32 + 16 * V_STR));
                oi[et] = __builtin_amdgcn_mfma_f32_16x16x32_bf16(pf, vf, oi[et], 0, 0, 0); }
        }
#pragma unroll
        for (int k2 = 0; k2 < 2; ++k2)
#pragma unroll
            for (int et = 0; et < 8; ++et) { const bf16x8 rf = *(const LAS bf16x8*)(rtb + et * (16 * KS_STR) + k2 * 64);
                oc[et] = __builtin_amdgcn_mfma_f32_16x16x32_bf16(qf[k2], rf, oc[et], 0, 0, 0); }
        {
            float s1[4], s2[4], xi[4];
#pragma unroll
            for (int r = 0; r < 4; ++r) { xi[r] = exp2f(log2g * (float)(16 * w + 4 * g + r + 1)); s1[r] = 0.f; s2[r] = 0.f; }
#pragma unroll
            for (int et = 0; et < 8; ++et)
#pragma unroll
                for (int r = 0; r < 4; ++r) { const float x = oi[et][r] + xi[r] * oc[et][r]; oi[et][r] = x; s1[r] += x; s2[r] += x * x; }
#pragma unroll
            for (int r = 0; r < 4; ++r) {
#pragma unroll
                for (int o = 1; o < 16; o <<= 1) { s1[r] += __shfl_xor(s1[r], o); s2[r] += __shfl_xor(s2[r], o); }
                const float mu = s1[r] * (1.f / 128.f); const float var = fmaxf(s2[r] * (1.f / 128.f) - mu * mu, 0.f); s1[r] = mu; s2[r] = 1.0f / sqrtf(var + GN_EPS); }
            const size_t tok0 = tokb + (size_t)c * 128 + 16 * w + 4 * g;
#pragma unroll
            for (int et = 0; et < 8; ++et) { const int col = 128 * h + 16 * et + c16; const float wgt = rnw[col];
#pragma unroll
                for (int r = 0; r < 4; ++r) { const float gv = bf2f(PROJ[(tok0 + r) * DIN + PC_RG + col]);
                    const float sg = gv * __builtin_amdgcn_rcpf(1.f + __builtin_amdgcn_exp2f(-gv * 1.4426950408889634f));
                    MIX[(tok0 + r) * DM + col] = (bf16_t)f2bf((oi[et][r] - s1[r]) * s2[r] * wgt * sg); }
                if (et & 1) asm volatile("" ::: "memory"); }
        }
#pragma unroll
        for (int dt = 0; dt < 4; ++dt) Racc[dt] = Racc[dt] * gC;
#pragma unroll 1
        for (int ks = 0; ks < 4; ++ks) { LAS const char* vp = vtb + ks * (32 * V_STR) + w * 32;
            const bf16x8 vf = cat8(vtr(vp), vtr(vp + 16 * V_STR));
            LAS const char* kp = khb + ks * (32 * KS_STR);
#pragma unroll
            for (int dt = 0; dt < 4; ++dt) { const bf16x8 kfm = cat8(vtr(kp + dt * 32), vtr(kp + dt * 32 + 16 * KS_STR));
                Racc[dt] = __builtin_amdgcn_mfma_f32_16x16x32_bf16(kfm, vf, Racc[dt], 0, 0, 0); } }
        __syncthreads();
#pragma unroll
        for (int dt = 0; dt < 4; ++dt) { u32x2 o2; o2.x = pk2(Racc[dt][0], Racc[dt][1]); o2.y = pk2(Racc[dt][2], Racc[dt][3]);
            *(LAS u32x2*)(Rt + (16 * w + c16) * KS_STR + (16 * dt + 4 * g) * 2) = o2; }
    }
    __syncthreads();
#undef RET_LOAD
}
}

#define XB_TMO      128
#define XB_XCNT(j)  (256  + 64 * (j))
#define XB_XSUB(j)  (1280 + 64 * (j))
#define XB_XGEN(j)  (2304 + 64 * (j))
#define XB_TOP      3328
#define XB_TOPGEN   3392
#define XCD_BAR_WORDS 3456
#define XB_SPIN_CAP (1u << 18)
__device__ __forceinline__ unsigned xb_ld(unsigned* p)              { return __hip_atomic_load(p, __ATOMIC_RELAXED, __HIP_MEMORY_SCOPE_AGENT); }
__device__ __forceinline__ unsigned xb_add(unsigned* p, unsigned v) { return __hip_atomic_fetch_add(p, v, __ATOMIC_RELAXED, __HIP_MEMORY_SCOPE_AGENT); }
__device__ __forceinline__ unsigned xb_xcc_id() { return (unsigned)__builtin_amdgcn_s_getreg((3 << 11) | 20) & 0xFu; }
#define XB_SPIN(cond, bar) do { unsigned _sp = 0; while (cond) { __builtin_amdgcn_s_sleep(1); \
    if ((++_sp & 255u) == 0u) { if (xb_ld(&(bar)[XB_TMO])) break; if (_sp > XB_SPIN_CAP) { atomicAdd(&(bar)[XB_TMO], 1u); break; } } } } while (0)
struct XcdBarrier { unsigned* bar; unsigned x; volatile LAS unsigned* st; };
__device__ __forceinline__ XcdBarrier xcd_barrier_post(unsigned* bar, volatile LAS unsigned* st) {
    XcdBarrier b; b.bar = bar; b.x = xb_xcc_id(); b.st = st;
    if (threadIdx.x == 0) (void)xb_add(&bar[XB_XCNT(b.x)], 1u);
    return b;
}
__device__ __forceinline__ void xcd_barrier_complete(unsigned* bar, unsigned x, unsigned& nloc, unsigned& nx) {
    const unsigned G = gridDim.x * gridDim.y * gridDim.z;
    unsigned sum, cnt, mine, sp = 0u;
    for (;;) {
        sum = 0u; cnt = 0u; mine = 0u;
#pragma unroll
        for (unsigned j = 0; j < 16; ++j) { const unsigned c = xb_ld(&bar[XB_XCNT(j)]); sum += c; cnt += (c > 0u) ? 1u : 0u; mine = (j == x) ? c : mine; }
        if (sum == G) break;
        __builtin_amdgcn_s_sleep(1);
        if ((++sp & 255u) == 0u) { if (xb_ld(&bar[XB_TMO])) break; if (sp > XB_SPIN_CAP) { atomicAdd(&bar[XB_TMO], 1u); break; } }
    }
    nloc = mine > 0u ? mine : 1u; nx = cnt > 0u ? cnt : 1u;
}
__device__ __forceinline__ void xcd_barrier(const XcdBarrier& b) {
    asm volatile("s_waitcnt vmcnt(0)" ::: "memory");
    __syncthreads();
    if (threadIdx.x == 0) {
        unsigned* bar = b.bar;
        __builtin_amdgcn_s_waitcnt(0);
        unsigned nloc = b.st[0], nx = b.st[1];
        if (nloc == 0u) { xcd_barrier_complete(bar, b.x, nloc, nx); b.st[0] = nloc; b.st[1] = nx; }
        const unsigned old = xb_add(&bar[XB_XSUB(b.x)], 1u);
        const unsigned gen = old / nloc;
        if (old + 1u == (gen + 1u) * nloc) {
            __builtin_amdgcn_fence(__ATOMIC_RELEASE, "agent");
            asm volatile("s_waitcnt vmcnt(0)" ::: "memory");
            const unsigned og = xb_add(&bar[XB_TOP], 1u);
            const unsigned tg = og / nx;
            if (og + 1u == (tg + 1u) * nx) xb_add(&bar[XB_TOPGEN], 1u);
            else XB_SPIN(xb_ld(&bar[XB_TOPGEN]) == tg, bar);
            __builtin_amdgcn_fence(__ATOMIC_ACQUIRE, "agent");
            xb_add(&bar[XB_XGEN(b.x)], 1u);
            asm volatile("s_waitcnt vmcnt(0)" ::: "memory");
        } else {
            XB_SPIN(xb_ld(&bar[XB_XGEN(b.x)]) == gen, bar);
            __builtin_amdgcn_fence(__ATOMIC_ACQUIRE, "agent");
            asm volatile("s_waitcnt vmcnt(0)" ::: "memory");
        }
    }
    __syncthreads();
}

__device__ __forceinline__ float wave_sum(float v) {
#pragma unroll
    for (int o = 1; o < 64; o <<= 1) v += __shfl_xor(v, o);
    return v;
}
__device__ __forceinline__ int dst_row(int mode, int n) {
    if (mode == 1) {
        if (n < 512) { const int base = n & ~255, j = n & 255, hh = j >> 6, d = j & 63; return base + ((d < 32) ? (32 * hh + d) : (128 + 32 * hh + (d - 32))); }
        if (n >= PC_MQ && n < PC_MV) { const int d = n & 63; if (d < 16) { const int nn = d >> 3, fq = (d >> 2) & 1, e = d & 3; return (n & ~63) + 8 * fq + 4 * nn + e; } }
        return n;
    }
    if (mode == 2) { return (n < 1024) ? (256 * (n >> 7) + (n & 127)) : (256 * ((n - 1024) >> 7) + 128 + ((n - 1024) & 127)); }
    return n;
}
__device__ __forceinline__ void p0_transpose_item_fp8(const float* W, int K, int N, unsigned char* WT, int mode, float scale, LAS float* scr, int item, int lane) {
    const int nblk = N / 32, kb = item / nblk, nb = item % nblk, k0 = 64 * kb, n0 = 32 * nb;
#pragma unroll 8
    for (int i = 0; i < 32; ++i) { const int kk = 2 * i + (lane >> 5); scr[kk * 33 + (lane & 31)] = W[(size_t)(k0 + kk) * N + n0 + (lane & 31)] * scale; }
    LDS_WAIT(); asm volatile("" ::: "memory");
    const int c = lane & 7;
#pragma unroll
    for (int j = 0; j < 4; ++j) { const int n = (lane >> 3) + 8 * j; const LAS float* s = scr + (8 * c) * 33 + n;
        const u32x2 o = pack8_fp8((f32x4){s[0 * 33], s[1 * 33], s[2 * 33], s[3 * 33]}, (f32x4){s[4 * 33], s[5 * 33], s[6 * 33], s[7 * 33]});
        *(GAS u32x2*)(WT + (size_t)dst_row(mode, n0 + n) * K + k0 + 8 * c) = o; }
    LDS_WAIT(); asm volatile("" ::: "memory");
}
__device__ __forceinline__ void p0_transpose_item(const float* W, int K, int N, bf16_t* WT, int mode, LAS float* scr, int item, int lane) {
    const int nblk = N / 32, kb = item / nblk, nb = item % nblk, k0 = 64 * kb, n0 = 32 * nb;
#pragma unroll 8
    for (int i = 0; i < 32; ++i) { const int kk = 2 * i + (lane >> 5); scr[kk * 33 + (lane & 31)] = W[(size_t)(k0 + kk) * N + n0 + (lane & 31)]; }
    LDS_WAIT(); asm volatile("" ::: "memory");
    const int c = lane & 7;
#pragma unroll
    for (int j = 0; j < 4; ++j) { const int n = (lane >> 3) + 8 * j; const LAS float* s = scr + (8 * c) * 33 + n;
        u32x4 o; o.x = pk2(s[0 * 33], s[1 * 33]); o.y = pk2(s[2 * 33], s[3 * 33]); o.z = pk2(s[4 * 33], s[5 * 33]); o.w = pk2(s[6 * 33], s[7 * 33]);
        *(GAS u32x4*)(WT + (size_t)dst_row(mode, n0 + n) * K + k0 + 8 * c) = o; }
    LDS_WAIT(); asm volatile("" ::: "memory");
}
__device__ __forceinline__ void sincos_acc(float af, float& sn, float& cs) {
    const double a = (double)af; const double k = rint(a * 0.15915494309189535); double r = a - k * 6.283185307179586;
    double sgn = 1.0; if (r > 1.5707963267948966) { r = 3.141592653589793 - r; sgn = -1.0; } else if (r < -1.5707963267948966) { r = -3.141592653589793 - r; sgn = -1.0; }
    const double r2 = r * r;
    double s = -1.0 / 355687428096000.0; s = s * r2 + 1.0 / 1307674368000.0; s = s * r2 - 1.0 / 6227020800.0; s = s * r2 + 1.0 / 39916800.0; s = s * r2 - 1.0 / 362880.0; s = s * r2 + 1.0 / 5040.0; s = s * r2 - 1.0 / 120.0; s = s * r2 + 1.0 / 6.0; s = r - r * r2 * s;
    double c = 1.0 / 20922789888000.0; c = c * r2 - 1.0 / 87178291200.0; c = c * r2 + 1.0 / 479001600.0; c = c * r2 - 1.0 / 3628800.0; c = c * r2 + 1.0 / 40320.0; c = c * r2 - 1.0 / 720.0; c = c * r2 + 1.0 / 24.0; c = c * r2 - 0.5; c = 1.0 + c * r2;
    sn = (float)s; cs = (float)(sgn * c);
}

struct Args { const float* in[13]; float* out; unsigned char* ws; int ph_lo, ph_hi, li, pad; };
constexpr int N_PHASES = 8;

__global__ void __launch_bounds__(NWAVES * 64, 2) fwd_mega(Args args) {
    extern __shared__ __attribute__((aligned(16))) unsigned char lds_raw[];
    LAS unsigned char* lds = (LAS unsigned char*)lds_raw;
    volatile LAS unsigned* MISC = (volatile LAS unsigned*)(lds + MISC_OFF);
    LAS int* LTAB = (LAS int*)(lds + LTAB_OFF);
    const int tid = threadIdx.x, lane = tid & 63, wave = __builtin_amdgcn_readfirstlane(tid >> 6);
    const int G = gridDim.x, bx = blockIdx.x; const int vcu = (G % 8 == 0) ? (bx % 8) * (G / 8) + bx / 8 : bx;
    unsigned char* ws = args.ws;
    gu32* ctl = (gu32*)(ws + WS_CTL);
    const float* x = args.in[0]; const float* norm1_w = args.in[1]; const float* w_in = args.in[2]; const float* ret_norm_w = args.in[3]; const float* w_out = args.in[4];
    const float* norm2_w = args.in[5]; const float* w_router = args.in[6]; const float* b_router = args.in[7]; const float* w1 = args.in[8]; const float* b1 = args.in[9];
    const float* w2 = args.in[10]; const float* b2 = args.in[11]; const float* final_w = args.in[12];
    float* out = args.out;
    float* rope = (float*)(ws + WS_ROPE); float* rc = rope; float* rs = rope + SEQ * 32; float* mc = rope + 2 * SEQ * 32; float* ms = mc + SEQ * 8;
    float* ksum = (float*)(ws + WS_KSUM); bf16_t* wrf = (bf16_t*)(ws + WS_WRF); float* srstd = (float*)(ws + WS_SRSTD); float* sgate = (float*)(ws + WS_SGATE); int* slot = (int*)(ws + WS_SLOT);
    bf16_t* WinT = (bf16_t*)(ws + WS_WIN); bf16_t* WoutT = (bf16_t*)(ws + WS_WOUT); unsigned char* W2T = ws + WS_W2; unsigned char* W1T = ws + WS_W1;
    bf16_t* PROJ = (bf16_t*)(ws + WS_PROJ); bf16_t* MIX = (bf16_t*)(ws + WS_MIX); unsigned char* ACT = ws + WS_ACT; bf16_t* XN = (bf16_t*)(ws + WS_XN); unsigned char* H2q = ws + WS_XN; bf16_t* Y4 = (bf16_t*)(ws + WS_Y4);

    for (int u = tid; u < (LDS_BYTES - LDSCTL_OFF) / 4; u += NWAVES * 64) ((LAS unsigned*)(lds + LDSCTL_OFF))[u] = 0u;
    __syncthreads();
    const bool use_bar = (MK_N_LAUNCHES != N_PHASES);
    XcdBarrier bar; bar.bar = (unsigned*)(ctl + CW_BAR) + args.li * XCD_BAR_WORDS; bar.x = 0; bar.st = nullptr;
    if (use_bar) bar = xcd_barrier_post((unsigned*)(ctl + CW_BAR) + args.li * XCD_BAR_WORDS, MISC + 8);
    const int lo = args.ph_lo, hi = args.ph_hi;
#ifndef PHASE_MASK
#define PHASE_MASK 0xff
#endif
#ifndef PROBE_DUP
#define PROBE_DUP -1
#endif
#define NREP(k) ((PROBE_DUP) == (k) ? 2 : 1)
#define IN(k) ((((PHASE_MASK) >> (k)) & 1) && lo <= (k) && (k) < hi)
#define SEAM(k) do { if (IN(k) && IN((k) + 1)) xcd_barrier(bar); } while (0)

    if (IN(0)) for (int rep_ = 0; rep_ < NREP(0); ++rep_) {
        LAS float* scr = (LAS float*)(lds + wave * 16384);
        const int gw = vcu * NWAVES + wave, NGW = G * NWAVES;
        constexpr int I_IN = (DM / 64) * (DIN / 32), I_OUT = (DM / 64) * (DM / 32), I_1E = (DM / 64) * (2048 / 32), I_2E = (DM / 64) * (DM / 32);
        constexpr int I_1 = NEXP * I_1E, I_2 = NEXP * I_2E, NITEMS = I_IN + I_OUT + I_1 + I_2;
        for (int it = gw; it < NITEMS; it += NGW) {
            int r = it;
            if (r < I_1) { const int e = r / I_1E; p0_transpose_item_fp8(w1 + (size_t)e * DM * 2048, DM, 2048, W1T + (size_t)e * 2048 * DM, 2, 64.f, scr, r % I_1E, lane); continue; } r -= I_1;
            if (r < I_2) { const int e = r / I_2E; p0_transpose_item_fp8(w2 + (size_t)e * DM * DM, DM, DM, W2T + (size_t)e * DM * DM, 0, 64.f, scr, r % I_2E, lane); continue; } r -= I_2;
            if (r < I_IN) { p0_transpose_item(w_in, DM, DIN, WinT, 1, scr, r, lane); continue; } r -= I_IN;
            p0_transpose_item(w_out, DM, DM, WoutT, 0, scr, r, lane);
        }
        {
            f32x4 wv[4];
#pragma unroll
            for (int j = 0; j < 4; ++j) wv[j] = *((const f32x4*)norm1_w + lane + 64 * j);
            for (int m = gw; m < NTOK; m += NGW) {
                const f32x4* xr = (const f32x4*)(x + (size_t)m * DM) + lane; f32x4 v[4]; float s = 0.f;
#pragma unroll
                for (int j = 0; j < 4; ++j) { v[j] = xr[64 * j]; s += (v[j].x * v[j].x + v[j].y * v[j].y) + (v[j].z * v[j].z + v[j].w * v[j].w); }
                const float rstd = 1.0f / sqrtf(wave_sum(s) * (1.f / DM) + RMS_EPS);
                unsigned long long* o8 = (unsigned long long*)(XN + (size_t)m * DM) + lane;
#pragma unroll
                for (int j = 0; j < 4; ++j) { const f32x4 y = v[j] * rstd * wv[j]; o8[64 * j] = (unsigned long long)pk2(y.x, y.y) | ((unsigned long long)pk2(y.z, y.w) << 32); }
            }
        }
        {
            const int gt = vcu * (NWAVES * 64) + tid, NGT = G * NWAVES * 64;
            for (int idx = gt; idx < SEQ * 32 + SEQ * 8; idx += NGT) {
                if (idx < SEQ * 32) { const int s = idx >> 5, i = idx & 31; const float inv = (float)exp2(-(double)i / 32.0 * 13.287712379549449);
                    float sn, cs; sincos_acc((float)s * inv, sn, cs); rc[idx] = cs; rs[idx] = sn; }
                else { const int j = idx - SEQ * 32, s = j >> 3, i = j & 7; const float inv = (float)exp2(-(double)i / 8.0 * 18.931568569324174);
                    float sn, cs; sincos_acc((float)s * inv, sn, cs); mc[j] = cs; ms[j] = sn; }
            }
            for (int idx = gt; idx < 32 * 2 * 64 * 8; idx += NGT) {
                const int j = idx & 7, ln = (idx >> 3) & 63, eh = (idx >> 9) & 1, ks = idx >> 10;
                const int k = 32 * ks + 8 * (ln >> 4) + j, e = 16 * eh + (ln & 15);
                const float wv = w_router[(size_t)k * NEXP + e]; const unsigned hb = f2bf(wv); const float lof = wv - bf2f((unsigned short)hb);
                wrf[(((size_t)(ks * 2 + eh) * 2 + 0) * 64 + ln) * 8 + j] = (bf16_t)hb;
                wrf[(((size_t)(ks * 2 + eh) * 2 + 1) * 64 + ln) * 8 + j] = (bf16_t)f2bf(lof);
            }
        }
    }
    SEAM(0);

    if (IN(1)) for (int rep_ = 0; rep_ < NREP(1); ++rep_) {
        pg8::ProbInProj P; P.A = XN; P.Bt = WinT; P.nM = NTOK / 256; P.nN = DIN / 256; P.G = G; P.c = bx;
        P.PROJ = PROJ; P.rc = rc; P.rs = rs; P.mc = mc; P.ms = ms; P.ksum = ksum;
        pg8::gemm_phase<pg8::ProbInProj, true>(lds, P);
    }
    SEAM(1);

    if (IN(2)) for (int rep_ = 0; rep_ < NREP(2); ++rep_) {
        for (;;) {
            if (tid == 0) MISC[16] = __hip_atomic_fetch_add(ctl + CW_QUEUE + 64 * rep_, 1u, RLX_AGENT);
            __syncthreads();
            const int id = __builtin_amdgcn_readfirstlane((int)MISC[16]);
            __syncthreads();
            if (id >= 128 + 2048) break;
#ifndef NO_RET
            if (id < 128) ret::ret_unit(id >> 2, id & 3, PROJ, ret_norm_w, MIX, lds);
            else
#endif
#ifndef NO_MOBA
            { const int j = id - 128; const int qb = 7 - (j >> 8), bh = j & 255;
                moba::moba_unit<8>(bh >> 3, bh & 7, qb, (const moba::bf16*)PROJ, ksum, (moba::bf16*)MIX, (char*)lds_raw); }
#else
            {}
#endif
        }
    }
    SEAM(2);

    if (IN(3)) for (int rep_ = 0; rep_ < NREP(3); ++rep_) {
        pg8::ProbOutProj P; P.A = MIX; P.Bt = WoutT; P.nM = NTOK / 256; P.nN = DM / 256; P.G = G; P.c = bx; P.x = x; P.X1 = out;
        pg8::gemm_phase<pg8::ProbOutProj, true>(lds, P);
    }
    SEAM(3);

    if (IN(4)) {
        LAS float* lg = (LAS float*)(lds) + wave * (32 * 33);
        LAS unsigned* pinfo = (LAS unsigned*)(lds + 40960);
        LAS float* pgate = (LAS float*)(lds + 40960 + 4096);
        LAS unsigned* lcnt = (LAS unsigned*)(lds + 40960 + 8192);
        LAS unsigned* lbase = lcnt + 32;
        LAS float* prstd = (LAS float*)(lds + 40960 + 8192 + 256);
        const int c16 = lane & 15, g = lane >> 4;
        for (int blk = bx; blk < NTOK / 256; blk += G) {
            if (tid < 32) lcnt[tid] = 0u;
            __syncthreads();
            const int R0 = blk * 256 + wave * 32;
            f32x4 acc[2][2]; float ssq[2] = {0.f, 0.f};
#pragma unroll
            for (int tt = 0; tt < 2; ++tt)
#pragma unroll
                for (int eh = 0; eh < 2; ++eh) acc[tt][eh] = (f32x4){0.f, 0.f, 0.f, 0.f};
#pragma unroll 2
            for (int ks = 0; ks < 32; ++ks) {
                const f32x4 w0 = *(const f32x4*)(norm2_w + 32 * ks + 8 * g), w1v = *(const f32x4*)(norm2_w + 32 * ks + 8 * g + 4);
                bf16x8 bh[2], bl[2];
#pragma unroll
                for (int eh = 0; eh < 2; ++eh) { bh[eh] = *(const bf16x8*)(wrf + (((size_t)(ks * 2 + eh) * 2 + 0) * 64 + lane) * 8); bl[eh] = *(const bf16x8*)(wrf + (((size_t)(ks * 2 + eh) * 2 + 1) * 64 + lane) * 8); }
#pragma unroll
                for (int tt = 0; tt < 2; ++tt) { const size_t ro = (size_t)(R0 + 16 * tt + c16) * DM + 32 * ks + 8 * g;
                    const f32x4 a0 = *(const f32x4*)(out + ro), a1 = *(const f32x4*)(out + ro + 4);
                    ssq[tt] += (a0.x * a0.x + a0.y * a0.y) + (a0.z * a0.z + a0.w * a0.w) + (a1.x * a1.x + a1.y * a1.y) + (a1.z * a1.z + a1.w * a1.w);
                    const f32x4 v0 = a0 * w0, v1 = a1 * w1v; u32x4 hw, lw;
                    hw.x = pk2(v0.x, v0.y); hw.y = pk2(v0.z, v0.w); hw.z = pk2(v1.x, v1.y); hw.w = pk2(v1.z, v1.w);
                    lw.x = pk2(v0.x - __builtin_bit_cast(float, hw.x << 16), v0.y - __builtin_bit_cast(float, hw.x & 0xffff0000u)); lw.y = pk2(v0.z - __builtin_bit_cast(float, hw.y << 16), v0.w - __builtin_bit_cast(float, hw.y & 0xffff0000u));
                    lw.z = pk2(v1.x - __builtin_bit_cast(float, hw.z << 16), v1.y - __builtin_bit_cast(float, hw.z & 0xffff0000u)); lw.w = pk2(v1.z - __builtin_bit_cast(float, hw.w << 16), v1.w - __builtin_bit_cast(float, hw.w & 0xffff0000u));
                    *(u32x2*)(H2q + ro) = pack8_fp8(v0, v1);
                    const bf16x8 ah = __builtin_bit_cast(bf16x8, hw), al = __builtin_bit_cast(bf16x8, lw);
#pragma unroll
                    for (int eh = 0; eh < 2; ++eh) { acc[tt][eh] = __builtin_amdgcn_mfma_f32_16x16x32_bf16(ah, bh[eh], acc[tt][eh], 0, 0, 0);
                        acc[tt][eh] = __builtin_amdgcn_mfma_f32_16x16x32_bf16(al, bh[eh], acc[tt][eh], 0, 0, 0); acc[tt][eh] = __builtin_amdgcn_mfma_f32_16x16x32_bf16(ah, bl[eh], acc[tt][eh], 0, 0, 0); } }
            }
#pragma unroll
            for (int tt = 0; tt < 2; ++tt) { float s = ssq[tt]; s += __shfl_xor(s, 16); s += __shfl_xor(s, 32); const float rstd = 1.0f / sqrtf(s * (1.f / DM) + RMS_EPS);
                if (g == 0) prstd[wave * 32 + 16 * tt + c16] = rstd;
#pragma unroll
                for (int r = 0; r < 4; ++r) { const float rr = __shfl(rstd, 4 * g + r);
#pragma unroll
                    for (int eh = 0; eh < 2; ++eh) lg[(16 * tt + 4 * g + r) * 33 + 16 * eh + c16] = acc[tt][eh][r] * rr + b_router[16 * eh + c16]; } }
            LDS_WAIT(); asm volatile("" ::: "memory");
            if (lane < 32) {
                float v[32];
#pragma unroll
                for (int e = 0; e < 32; ++e) v[e] = lg[lane * 33 + e];
                float tv[4]; int te[4];
#pragma unroll
                for (int k = 0; k < 4; ++k) { float best = v[0]; int bi = 0;
#pragma unroll
                    for (int e = 1; e < 32; ++e) if (v[e] > best) { best = v[e]; bi = e; }
                    tv[k] = best; te[k] = bi;
#pragma unroll
                    for (int e = 0; e < 32; ++e) v[e] = (e == bi) ? -INFINITY : v[e]; }
                float ex[4], sum = 0.f;
#pragma unroll
                for (int k = 0; k < 4; ++k) { ex[k] = __expf(tv[k] - tv[0]); sum += ex[k]; }
                const float inv = 1.0f / sum;
#pragma unroll
                for (int k = 0; k < 4; ++k) { const unsigned lr = __hip_atomic_fetch_add(lcnt + te[k], 1u, __ATOMIC_RELAXED, __HIP_MEMORY_SCOPE_WORKGROUP);
                    const int p = (wave * 32 + lane) * 4 + k; pinfo[p] = (unsigned)te[k] | (lr << 8); pgate[p] = ex[k] * inv; }
            }
            __syncthreads();
            if (tid < 32) lbase[tid] = __hip_atomic_fetch_add(ctl + CW_GCNT + 64 * tid, lcnt[tid], RLX_AGENT);
            __syncthreads();
            for (int p = tid; p < 1024; p += NWAVES * 64) { const unsigned pi = pinfo[p]; const int e = pi & 255u; const unsigned pos = lbase[e] + (pi >> 8);
                const int pair = (blk * 256) * 4 + p; const size_t si = (size_t)e * NTOK + pos; slot[si] = pair; sgate[si] = pgate[p]; srstd[si] = prstd[p >> 2]; }
            __syncthreads();
        }
    }
    SEAM(4);

    if (IN(5) || IN(6)) {
        if (tid == 0) { int tp = 0, cp = 0;
            for (int e = 0; e < NEXP; ++e) { const int c = (int)__hip_atomic_load(ctl + CW_GCNT + 64 * e, RLX_AGENT); LTAB[e] = tp; LTAB[33 + e] = cp; tp += (c + 255) >> 8; cp += c; }
            LTAB[32] = tp; LTAB[33 + 32] = cp; }
        __syncthreads();
    }
    if (IN(5)) for (int rep_ = 0; rep_ < NREP(5); ++rep_) {
        pg8::ProbMoe1 P; P.T = LTAB[32]; P.NP = 8; P.G = G; P.c = bx; P.tpre = LTAB; P.cpre = LTAB + 33;
        P.H2 = H2q; P.W1T = W1T; P.slot = slot; P.srstd = srstd; P.b1 = b1; P.ACT = ACT;
        pg8::gemm_phase<pg8::ProbMoe1, true>(lds, P);
    }
    SEAM(5);
    if (IN(6)) {
        pg8::ProbMoe2 P; P.T = LTAB[32]; P.NP = 4; P.G = G; P.c = bx; P.tpre = LTAB; P.cpre = LTAB + 33;
        P.ACT = ACT; P.W2T = W2T; P.slot = slot; P.sgate = sgate; P.b2 = b2; P.Y4 = Y4;
        pg8::gemm_phase<pg8::ProbMoe2, true>(lds, P);
    }
    SEAM(6);

    if (IN(7)) {
        const int gw = vcu * NWAVES + wave, NGW = G * NWAVES;
        unsigned bad = __hip_atomic_load(ctl + CW_TMO, RLX_AGENT);
        for (int li = 0; li < (MK_N_LAUNCHES == N_PHASES ? 0 : MK_N_LAUNCHES); ++li) bad |= __hip_atomic_load(ctl + CW_BAR + li * XCD_BAR_WORDS + XB_TMO, RLX_AGENT);
        f32x4 wv[4];
#pragma unroll
        for (int j = 0; j < 4; ++j) wv[j] = *((const f32x4*)final_w + lane + 64 * j);
        for (int m = gw; m < NTOK; m += NGW) {
            f32x4* xr = (f32x4*)(out + (size_t)m * DM) + lane; f32x4 v[4]; float s = 0.f;
            const u32x2* y0 = (const u32x2*)(Y4 + (size_t)m * 4 * DM) + lane;
#pragma unroll
            for (int j = 0; j < 4; ++j) { v[j] = xr[64 * j];
#pragma unroll
                for (int k = 0; k < 4; ++k) { const u32x2 yy = y0[k * (DM / 4) + 64 * j];
                    v[j].x += __builtin_bit_cast(float, yy.x << 16); v[j].y += __builtin_bit_cast(float, yy.x & 0xffff0000u); v[j].z += __builtin_bit_cast(float, yy.y << 16); v[j].w += __builtin_bit_cast(float, yy.y & 0xffff0000u); }
                s += (v[j].x * v[j].x + v[j].y * v[j].y) + (v[j].z * v[j].z + v[j].w * v[j].w); }
            const float rstd = 1.0f / sqrtf(wave_sum(s) * (1.f / DM) + RMS_EPS);
#pragma unroll
            for (int j = 0; j < 4; ++j) { f32x4 y = v[j] * rstd * wv[j]; if (bad) { const float q = __builtin_nanf(""); y = (f32x4){q, q, q, q}; } xr[64 * j] = y; }
        }
    }
#undef IN
#undef SEAM
}

extern "C" void kernel_launch(void* const* d_in, const int* in_sizes, int n_in, void* d_out, int out_size, void* d_ws, size_t ws_size, hipStream_t stream) {
    static int grid = 0;
    if (grid == 0) {
        if (n_in != 13 || in_sizes[0] != NTOK * DM || out_size != NTOK * DM || ws_size < WS_END) { fprintf(stderr, "kernel_launch: unexpected shapes (n_in %d, in0 %d, out %d, ws %zu)\n", n_in, n_in > 0 ? in_sizes[0] : -1, out_size, ws_size); grid = -1; return; }
        int dev = 0, cus = 0;
        if (hipGetDevice(&dev) != hipSuccess || hipDeviceGetAttribute(&cus, hipDeviceAttributeMultiprocessorCount, dev) != hipSuccess) { grid = -1; return; }
        if (hipFuncSetAttribute((const void*)fwd_mega, hipFuncAttributeMaxDynamicSharedMemorySize, LDS_BYTES) != hipSuccess) { fprintf(stderr, "kernel_launch: hipFuncSetAttribute failed\n"); grid = -1; return; }
        int per_cu = 0;
        if (hipOccupancyMaxActiveBlocksPerMultiprocessor(&per_cu, (const void*)fwd_mega, NWAVES * 64, LDS_BYTES) != hipSuccess || per_cu < 1) fprintf(stderr, "kernel_launch: occupancy query says %d\n", per_cu);
        (void)hipGetLastError();
        grid = cus;
    }
    if (grid < 0) return;
    (void)hipMemsetAsync((char*)d_ws + WS_CTL, 0, CTL_ZERO_BYTES, stream);
    Args a{};
    for (int i = 0; i < 13; ++i) a.in[i] = (const float*)d_in[i];
    a.out = (float*)d_out; a.ws = (unsigned char*)d_ws;
    if (MK_N_LAUNCHES == 1) { a.ph_lo = 0; a.ph_hi = N_PHASES; a.li = 0; hipLaunchKernelGGL(fwd_mega, dim3(grid), dim3(NWAVES * 64), LDS_BYTES, stream, a); }
    else for (int li = 0; li < N_PHASES; ++li) { a.ph_lo = li; a.ph_hi = li + 1; a.li = 0; hipLaunchKernelGGL(fwd_mega, dim3(grid), dim3(NWAVES * 64), LDS_BYTES, stream, a); }
}
```

```cpp
#include <hip/hip_runtime.h>
#include <hip/hip_bf16.h>
#include <cstdio>
#include <cstdint>
#include <cmath>

#ifndef MOE_B6
#define MOE_B6 1
#endif
#ifndef MOE_A3
#define MOE_A3 1
#endif
#ifndef AUX_P5
#define AUX_P5 0
#endif
#ifndef AUX_P6
#define AUX_P6 0
#endif
#ifndef WGM_DENSE
#define WGM_DENSE 8
#endif
#ifndef WGM_MOE
#define WGM_MOE 4
#endif
#ifndef FULL_LINE
#define FULL_LINE 1
#endif
#ifndef CONV_IN_P2
#define CONV_IN_P2 1
#endif
#ifndef MK_N_LAUNCHES
#define MK_N_LAUNCHES 1
#endif

#define LAS __attribute__((address_space(3)))
#define GAS __attribute__((address_space(1)))
typedef unsigned short bf16_t;
typedef short bf16x8 __attribute__((ext_vector_type(8)));
typedef short s16x4 __attribute__((ext_vector_type(4)));
typedef float f32x4 __attribute__((ext_vector_type(4)));
typedef float f32x2 __attribute__((ext_vector_type(2)));
typedef float f32x16 __attribute__((ext_vector_type(16)));
typedef unsigned u32x4 __attribute__((ext_vector_type(4)));
typedef unsigned u32x2 __attribute__((ext_vector_type(2)));
typedef GAS unsigned gu32;
typedef int v8i __attribute__((ext_vector_type(8)));
typedef int v6i __attribute__((ext_vector_type(6)));
typedef int v12i __attribute__((ext_vector_type(12)));
typedef _Float16 v32h __attribute__((ext_vector_type(32)));
typedef unsigned v6u __attribute__((ext_vector_type(6)));

constexpr int NB = 32, SEQ = 2048, DM = 1024, NTOK = NB * SEQ;
constexpr int DIN = 3072;
constexpr int NEXP = 32, TOPK = 4, NPAIR = NTOK * TOPK;
constexpr float RMS_EPS = 1e-5f, GN_EPS = 1e-6f;
constexpr float QC2 = 0.125f * 1.4426950408889634f;
constexpr int PC_RQ = 0, PC_RK = 256, PC_RV = 512, PC_RG = 1024, PC_MQ = 1536, PC_MK = 2048, PC_MV = 2560;

constexpr size_t MiB = 1u << 20;
constexpr size_t WS_CTL = 0, CTL_ZERO_BYTES = 256 * 1024;
constexpr size_t WS_ROPE = 1 * MiB;
constexpr size_t WS_KSUM = 2 * MiB;
constexpr size_t WS_RSTD = 3 * MiB;
constexpr size_t WS_WRF = 3 * MiB + 512 * 1024;
constexpr size_t WS_GATE = 4 * MiB;
constexpr size_t WS_SLOT = 5 * MiB;
constexpr size_t WS_WIN = 16 * MiB, WS_WOUT = 22 * MiB, WS_SGATE = 16 * MiB;
constexpr size_t WS_W2 = 24 * MiB, WS_W1 = 56 * MiB;
constexpr size_t WS_XN = 120 * MiB, WS_DELTA = 792 * MiB;
constexpr size_t WS_H2Q = 632 * MiB;
constexpr size_t WS_PROJ = 248 * MiB, WS_MIX = 632 * MiB;
constexpr size_t WS_ACT = 248 * MiB;
constexpr size_t WS_SRSTD = 696 * MiB;
constexpr size_t WS_Y4 = 504 * MiB;
constexpr size_t WS_RST = 760 * MiB;
constexpr size_t WS_END = 1016 * MiB;
constexpr int CW_TMO = 0, CW_CODE = 1, CW_BAR = 4096, CW_QUEUE = 45056, CW_RDONE = 47104, CW_GCNT = 40960;

constexpr int RING_BYTES = 147456;
constexpr int LDSCTL_OFF = RING_BYTES, MISC_OFF = LDSCTL_OFF + 320, LTAB_OFF = LDSCTL_OFF + 512;
constexpr int LDS_BYTES = 163840;
constexpr int NWAVES = 8;

#define RLX_AGENT __ATOMIC_RELAXED, __HIP_MEMORY_SCOPE_AGENT
#define LDS_WAIT() asm volatile("s_waitcnt lgkmcnt(0)" ::: "memory")
#define VM_WAIT() asm volatile("s_waitcnt vmcnt(0)" ::: "memory")
#define LDS_BARRIER() asm volatile("s_waitcnt lgkmcnt(0)\n\ts_barrier" ::: "memory")

__device__ __forceinline__ unsigned f2bf(float f) { unsigned u = __builtin_bit_cast(unsigned, f); return (u + 0x7fffu + ((u >> 16) & 1u)) >> 16; }
__device__ __forceinline__ unsigned pk2(float lo, float hi) { return f2bf(lo) | (f2bf(hi) << 16); }
__device__ __forceinline__ float bf2f(unsigned short b) { return __builtin_bit_cast(float, (unsigned)b << 16); }
__device__ __forceinline__ unsigned cvt_pk_bf16(float lo, float hi) { unsigned r; asm volatile("v_cvt_pk_bf16_f32 %0, %1, %2" : "=v"(r) : "v"(lo), "v"(hi)); return r; }
__device__ __forceinline__ u32x4 pack8(f32x4 a, f32x4 b) { u32x4 w; w.x = cvt_pk_bf16(a[0], a[1]); w.y = cvt_pk_bf16(a[2], a[3]); w.z = cvt_pk_bf16(b[0], b[1]); w.w = cvt_pk_bf16(b[2], b[3]); return w; }

__device__ __forceinline__ unsigned f2fp6(float x) {
    const float v = fminf(fabsf(x), 7.5f);
    const float sc = v < 2.f ? 8.f : (v < 4.f ? 4.f : 2.f), off = v < 2.f ? 0.f : (v < 4.f ? 2.f : 4.f), base = v < 2.f ? 0.f : (v < 4.f ? 16.f : 24.f);
    const unsigned c = (unsigned)(base + __builtin_rintf((v - off) * sc));
    return c | ((__builtin_bit_cast(unsigned, x) >> 26) & 32u);
}
__device__ __forceinline__ void pack8_fp6(f32x4 a, f32x4 b, unsigned& lo, unsigned& hi) {
    const unsigned c0 = f2fp6(a[0]), c1 = f2fp6(a[1]), c2 = f2fp6(a[2]), c3 = f2fp6(a[3]), c4 = f2fp6(b[0]), c5 = f2fp6(b[1]), c6 = f2fp6(b[2]), c7 = f2fp6(b[3]);
    lo = c0 | (c1 << 6) | (c2 << 12) | (c3 << 18) | (c4 << 24) | (c5 << 30); hi = (c5 >> 2) | (c6 << 4) | (c7 << 10);
}
__device__ __forceinline__ u32x2 pack8_fp8(f32x4 a, f32x4 b) { u32x2 w; int t = 0;
    t = __builtin_amdgcn_cvt_pk_fp8_f32(a[0], a[1], t, false); t = __builtin_amdgcn_cvt_pk_fp8_f32(a[2], a[3], t, true); w.x = (unsigned)t; t = 0;
    t = __builtin_amdgcn_cvt_pk_fp8_f32(b[0], b[1], t, false); t = __builtin_amdgcn_cvt_pk_fp8_f32(b[2], b[3], t, true); w.y = (unsigned)t; return w; }

namespace pg8 {
constexpr int BM = 256, BK = 64, HALF = 128, HTB = HALF * BK * 2, STAGE_BYTES = 8 * HTB, NXCD = 8, WGM = 4;
constexpr int KD = 1024;
__device__ __forceinline__ int lds_byte(int r, int c) { const int st = (r >> 4) * 2 + (c >> 5), rr = r & 15, cc = c & 31, ob = rr * 64 + cc * 2; return st * 1024 + (ob ^ (((ob >> 9) & 1) << 5)); }
__device__ __forceinline__ void stage_rc(int b, int& R, int& C) { const int st = b / 1024, sb = b % 1024, swz = sb ^ (((sb >> 9) & 1) << 5); R = (st >> 1) * 16 + swz / 64; C = (st & 1) * 32 + (swz % 64) / 2; }
template <bool F8_> __device__ __forceinline__ int fl_sw(int r) { return F8_ ? ((r >> 1) & 5) : ((r >> 1) & 7); }
template <bool F8_> __device__ __forceinline__ void fl_stage_rc(int b, int& R, int& C) { const int p = b >> 4; R = p >> 3; C = ((p & 7) ^ fl_sw<F8_>(R)) * 8; }
__device__ __forceinline__ int perm32(int rho) { const int n = rho >> 4, i = rho & 15; return 8 * (i >> 2) + 4 * n + (i & 3); }

struct Unit { int pm, pn, e, row0, nrows, arow; };

template <int WGM_> __device__ __forceinline__ bool tile_order(int i, int G, int c, int nM, int nN, int& pm, int& pn) { constexpr int WGM = WGM_;
    const int nwg = nM * nN; const long L = (long)i * G + c; if (L >= nwg) return false;
    int wgid = (int)L; { const int q = nwg / NXCD, r = nwg % NXCD, xcd = wgid % NXCD, off = wgid / NXCD; wgid = (xcd < r ? xcd * (q + 1) : r * (q + 1) + (xcd - r) * q) + off; }
    const int nig = WGM * nN, gid = wgid / nig, fm = gid * WGM, gsz = (nM - fm) < WGM ? (nM - fm) : WGM;
    pm = fm + ((wgid % nig) % gsz); pn = (wgid % nig) / gsz; return true;
}

template <class P, bool ALIGN_EPI>
__device__ __forceinline__ void gemm_phase(LAS unsigned char* lds, const P& S) {
    const int tid = threadIdx.x, wid = __builtin_amdgcn_readfirstlane(tid >> 6), lane = tid & 63, wr = wid >> 2, wc = wid & 3, fr = lane & 15, fq = lane >> 4;
    constexpr int KB = P::FP8 ? KD : KD * 2;
    constexpr int nt = KB / 128;
    constexpr bool SW8 = P::FP8 && !P::B6;
    unsigned voffB[2]; int RA[2], CA[2];
#pragma unroll
    for (int i = 0; i < 2; ++i) { int R, C; if constexpr (FULL_LINE) fl_stage_rc<SW8>(tid * 16 + i * 8192, R, C); else stage_rc(tid * 16 + i * 8192, R, C); const int Rb = P::PERM ? ((R & ~31) + perm32(R & 31)) : R;
        voffB[i] = (unsigned)(Rb * KB + C * 2); RA[i] = R; CA[i] = C; }
    const size_t kstep = 128;
    const size_t hstep = (size_t)HALF * KB;
    const unsigned ldsw = (unsigned)wid * 1024u;
    constexpr size_t kstepB = P::B6 ? 24576 : 128;
    const unsigned tid16 = (unsigned)tid * 16u; const int b6o = ((wc * 32 + fr) * 4 + fq), b6q = ((wc * 16 + fr) * 4 + fq);
    int aoffk[2], boffk[2];
    if constexpr (FULL_LINE) { const int sws = fl_sw<SW8>(fr);
#pragma unroll
        for (int k = 0; k < 2; ++k) { const int ch = SW8 ? (2 * fq + k) : (fq + 4 * k); aoffk[k] = (wr * 64 + fr) * 128 + ((ch ^ sws) << 4); boffk[k] = (wc * 32 + fr) * 128 + ((ch ^ sws) << 4); } }
    else { const int a0 = P::FP8 ? lds_byte(wr * 64 + fr, fq * 16) : lds_byte(wr * 64 + fr, fq * 8), b0 = P::FP8 ? lds_byte(wc * 32 + fr, fq * 16) : lds_byte(wc * 32 + fr, fq * 8);
        aoffk[0] = a0; boffk[0] = b0; aoffk[1] = a0 + (P::FP8 ? 16 : 1024); boffk[1] = b0 + (P::FP8 ? 16 : 1024); }
#define PG8_SA(b, h) (((b) * 2 + (h)) * HTB)
#define PG8_SB(b, h) ((4 + (b) * 2 + (h)) * HTB)
#define PG8_SB6(b) (P::A3 ? (98304 + (b) * 24576) : PG8_SB(b, 0))
#define PG8_STAGE(bufoff, gbase, voff) do { _Pragma("unroll") for (int _i = 0; _i < 2; ++_i) \
        __builtin_amdgcn_global_load_lds((const unsigned*)((const char*)(gbase) + (voff)[_i]), (LAS unsigned*)(lds + (bufoff) + ldsw + _i * 8192), 16, 0, 0); } while (0)
    const int scw_ = P::SCW, scx_ = P::SCX;
#define PG8_STAGEA(bufoff, gbase, voff) do { _Pragma("unroll") for (int _i = 0; _i < 2; ++_i) \
        __builtin_amdgcn_global_load_lds((const unsigned*)((const char*)(gbase) + (voff)[_i]), (LAS unsigned*)(lds + (bufoff) + ldsw + _i * 8192), 16, 0, P::A_AUX); } while (0)
#define PG8_STAGEB(b, gsrc) do { if constexpr (P::B6) { _Pragma("unroll") for (int _i = 0; _i < 3; ++_i) \
        __builtin_amdgcn_global_load_lds((const unsigned*)((const char*)(gsrc) + tid16 + _i * 8192), (LAS unsigned*)(lds + PG8_SB6(b) + ldsw + _i * 8192), 16, 0, 0); } \
        else { PG8_STAGE(PG8_SB(b, 0), gsrc, voffB); PG8_STAGE(PG8_SB(b, 1), (gsrc) + hstep, voffB); } } while (0)
#define PG8_LDB6(dst, b, h) do { const u32x4 p0_ = *(const LAS u32x4*)(lds + PG8_SB6(b) + (h) * 12288 + b6o * 16), p1_ = *(const LAS u32x4*)(lds + PG8_SB6(b) + (h) * 12288 + b6o * 16 + 1024), \
        q_ = *(const LAS u32x4*)(lds + PG8_SB6(b) + (h) * 12288 + 8192 + b6q * 16); \
        dst##c = (v12i){(int)p0_.x, (int)p0_.y, (int)p0_.z, (int)p0_.w, (int)q_.x, (int)q_.y, (int)q_.z, (int)q_.w, (int)p1_.x, (int)p1_.y, (int)p1_.z, (int)p1_.w}; } while (0)
#define PG8_B6SEL(x, n) ((n) == 0 ? __builtin_shufflevector(x, x, 0, 1, 2, 3, 4, 5) : __builtin_shufflevector(x, x, 6, 7, 8, 9, 10, 11))
#define PG8_STAGEA3(sb, h, gbase, voff) do { _Pragma("unroll") for (int _i = 0; _i < 2; ++_i) \
        __builtin_amdgcn_global_load_lds((const unsigned*)((const char*)(gbase) + (voff)[_i]), (LAS unsigned*)(lds + (sb) + (h) * 16384 + ldsw + _i * 8192), 16, 0, P::A_AUX); } while (0)
#define PG8_LDA3(dst, sb, h) do { const LAS unsigned char* la_ = lds + (sb) + (h) * 16384; _Pragma("unroll") for (int m = 0; m < 4; ++m) _Pragma("unroll") for (int k = 0; k < 2; ++k) dst[m][k] = *(const LAS bf16x8*)(la_ + aoffk[k] + m * 2048); } while (0)
#define PG8_LDA(dst, b, h) do { _Pragma("unroll") for (int m = 0; m < 4; ++m) _Pragma("unroll") for (int k = 0; k < 2; ++k) dst[m][k] = *(const LAS bf16x8*)(lds + PG8_SA(b, h) + aoffk[k] + m * 2048); } while (0)
#define PG8_LDB(dst, b, h) do { if constexpr (P::B6) PG8_LDB6(dst, b, h); else PG8_LDB8(dst, b, h); } while (0)
#define PG8_LDB8(dst, b, h) do { _Pragma("unroll") for (int n = 0; n < 2; ++n) _Pragma("unroll") for (int k = 0; k < 2; ++k) dst[n][k] = *(const LAS bf16x8*)(lds + PG8_SB(b, h) + boffk[k] + n * 2048); } while (0)
#define PG8_CAT(x) __builtin_bit_cast(v8i, __builtin_shufflevector(x[0], x[1], 0, 1, 2, 3, 4, 5, 6, 7, 8, 9, 10, 11, 12, 13, 14, 15))
#define PG8_MMA(ai, bj, At, Bt) do { __builtin_amdgcn_s_setprio(1); _Pragma("unroll") for (int m = 0; m < 4; ++m) _Pragma("unroll") for (int n = 0; n < 2; ++n) { \
        if constexpr (P::B6) asm volatile("s_nop 1\n\tv_mfma_scale_f32_16x16x128_f8f6f4 %0, %1, %2, %0, %3, %4 op_sel_hi:[0,0,0] cbsz:2" : "+v"(acc[ai][bj][m][n]) : "v"(PG8_B6SEL(Bt##c, n)), "v"(PG8_CAT(At[m])), "v"(scw_), "v"(scx_)); \
        else if constexpr (P::FP8) asm volatile("v_mfma_scale_f32_16x16x128_f8f6f4 %0, %1, %2, %0, %3, %4 op_sel_hi:[0,0,0]" : "+v"(acc[ai][bj][m][n]) : "v"(PG8_CAT(Bt[n])), "v"(PG8_CAT(At[m])), "v"(scw_), "v"(scx_)); \
        else { _Pragma("unroll") for (int k = 0; k < 2; ++k) acc[ai][bj][m][n] = __builtin_amdgcn_mfma_f32_16x16x32_bf16(Bt[n][k], At[m][k], acc[ai][bj][m][n], 0, 0, 0); } } \
        __builtin_amdgcn_s_setprio(0); } while (0)
#define PG8_WAIT_V(n) asm volatile("s_waitcnt vmcnt(" #n ")" ::: "memory")
#define PG8_WAIT_VL do { if constexpr (P::B6) PG8_WAIT_V(7); else PG8_WAIT_V(8); PG8_WAIT_L(0); } while (0)
#define PG8_WAIT_L(n) asm volatile("s_waitcnt lgkmcnt(" #n ")" ::: "memory")
#define PG8_BAR __builtin_amdgcn_s_barrier()
#define PG8_SCHED __builtin_amdgcn_sched_barrier(0)
    Unit cur, nxt; int ui = 0;
    if (!S.next(0, cur)) return;
    if constexpr (P::STAGGER > 0) {
        const unsigned long long t0 = __builtin_amdgcn_s_memrealtime(); const unsigned long long dl = (unsigned long long)(((unsigned)blockIdx.x >> 3) & 3u) * (unsigned long long)P::STAGGER;
        while (__builtin_amdgcn_s_memrealtime() - t0 < dl) __builtin_amdgcn_s_sleep(8);
    }
    f32x4 acc[2][2][4][2];
#pragma unroll
    for (int a = 0; a < 2; ++a)
#pragma unroll
        for (int b = 0; b < 2; ++b)
#pragma unroll
            for (int m = 0; m < 4; ++m)
#pragma unroll
                for (int n = 0; n < 2; ++n) acc[a][b][m][n] = (f32x4){0.f, 0.f, 0.f, 0.f};
    bf16x8 At[4][2], B0[2][2], B1[2][2]; v12i B0c, B1c;
    unsigned vC[2][2], vN[2][2];
    S.a_voff(cur, RA, CA, vC);
    const char* cA = S.a_ptr(cur); const char* cB = S.b_ptr(cur);
    int s0 = 0;
    if constexpr (P::A3) {
        PG8_STAGEB(0, cB); PG8_STAGEA3(0, 0, cA, vC[0]); PG8_STAGEA3(0, 1, cA, vC[1]);
        if (wr == 1) PG8_BAR;
        PG8_WAIT_V(2); PG8_BAR;
        PG8_STAGEB(1, cB + kstepB); PG8_STAGEA3(32768, 0, cA + kstep, vC[0]); PG8_STAGEA3(32768, 1, cA + kstep, vC[1]); PG8_STAGEA3(65536, 0, cA + 2 * kstep, vC[0]);
        PG8_WAIT_V(9);
        PG8_BAR;
    } else {
    PG8_STAGEB(0, cB); PG8_STAGEA(PG8_SA(0, 0), cA, vC[0]); PG8_STAGEA(PG8_SA(0, 1), cA, vC[1]);
    if (wr == 1) PG8_BAR;
    PG8_WAIT_V(2); PG8_BAR;
    PG8_STAGEB(1, cB + kstepB); PG8_STAGEA(PG8_SA(1, 0), cA + kstep, vC[0]);
    if constexpr (P::B6) PG8_WAIT_V(5); else PG8_WAIT_V(6);
    PG8_BAR;
    }
    for (;;) {
        const bool has_next = S.next(ui + 1, nxt);
        const char* nA = cA; const char* nB = cB;
#pragma unroll
        for (int h = 0; h < 2; ++h)
#pragma unroll
            for (int i = 0; i < 2; ++i) vN[h][i] = vC[h][i];
        if (has_next) { nA = S.a_ptr(nxt); nB = S.b_ptr(nxt); if constexpr (!P::SIDE) S.a_voff(nxt, RA, CA, vN); }
        if constexpr (P::SIDE) S.side_issue(cur, nxt, has_next, ui, wid, lane, lds);
        if constexpr (P::A3) {
            static_assert(P::KREP == 1 && nt >= 4, "A3");
            for (int tt_ = 0; tt_ < nt; tt_ += 2) { const int t = tt_;
                const bool last = (tt_ == nt - 2), pre = (tt_ >= nt - 4);
                if constexpr (P::SIDE) { if (tt_ == nt - 4 && has_next) S.a_voff_side(nxt, ui + 1, RA, CA, vN, lds); }
                const int s1 = s0 == 65536 ? 0 : s0 + 32768, s2 = s1 == 65536 ? 0 : s1 + 32768;
                const char* a2 = last ? nA : cA + (size_t)(t + 2) * kstep;
                const char* a3 = last ? nA + kstep : cA + (size_t)(t + 3) * kstep;
                const char* a4 = last ? nA + 2 * kstep : (pre ? nA : cA + (size_t)(t + 4) * kstep);
                const char* b2 = last ? nB : cB + (size_t)(t + 2) * kstepB; const char* b3 = b2 + kstepB;
                unsigned vL[2][2], vP[2];
#pragma unroll
                for (int i = 0; i < 2; ++i) { vL[0][i] = last ? vN[0][i] : vC[0][i]; vL[1][i] = last ? vN[1][i] : vC[1][i]; vP[i] = pre ? vN[0][i] : vC[0][i]; }
                PG8_LDB(B0, 0, 0); PG8_LDB(B1, 0, 1); PG8_SCHED; PG8_LDA3(At, s0, 0); PG8_STAGEA3(s2, 1, a2, vL[1]);
                PG8_WAIT_V(14); PG8_WAIT_L(0); PG8_BAR; PG8_MMA(0, 0, At, B0); PG8_MMA(0, 1, At, B1); PG8_BAR; PG8_SCHED;
                PG8_LDA3(At, s0, 1); PG8_STAGEB(0, b2); PG8_STAGEA3(s0, 0, a3, vL[0]);
                PG8_WAIT_V(9); PG8_WAIT_L(0); PG8_BAR; PG8_MMA(1, 0, At, B0); PG8_MMA(1, 1, At, B1); PG8_BAR; PG8_SCHED;
                PG8_LDB(B0, 1, 0); PG8_LDB(B1, 1, 1); PG8_SCHED; PG8_LDA3(At, s1, 0); PG8_STAGEA3(s0, 1, a3, vL[1]);
                PG8_WAIT_V(14); PG8_WAIT_L(0); PG8_BAR; PG8_MMA(0, 0, At, B0); PG8_MMA(0, 1, At, B1); PG8_BAR; PG8_SCHED;
                PG8_LDA3(At, s1, 1); PG8_STAGEB(1, b3); PG8_STAGEA3(s1, 0, a4, vP);
                PG8_WAIT_V(9); PG8_WAIT_L(0); PG8_BAR; PG8_MMA(1, 0, At, B0); PG8_MMA(1, 1, At, B1); PG8_BAR; PG8_SCHED;
                s0 = s2;
            }
        } else
        for (int tt_ = 0; tt_ < nt * P::KREP; tt_ += 2) { const int t = tt_ & (nt - 1);
            const bool last = (tt_ == nt * P::KREP - 2);
            const char* a1 = cA + (size_t)(t + 1) * kstep;
            const char* a2 = last ? nA : cA + (size_t)((t + 2) & (nt - 1)) * kstep; const char* b2 = last ? nB : cB + (size_t)((t + 2) & (nt - 1)) * kstepB;
            const char* a3 = a2 + kstep; const char* b3 = b2 + kstepB;
            if constexpr (P::SIDE) { if (last && has_next) S.a_voff_side(nxt, ui + 1, RA, CA, vN, lds); }
            unsigned vS[2][2];
#pragma unroll
            for (int h = 0; h < 2; ++h)
#pragma unroll
                for (int i = 0; i < 2; ++i) vS[h][i] = last ? vN[h][i] : vC[h][i];
            PG8_LDB(B0, 0, 0); PG8_LDB(B1, 0, 1); PG8_SCHED; PG8_LDA(At, 0, 0); PG8_STAGEA(PG8_SA(1, 1), a1, vC[1]);
            PG8_WAIT_VL; PG8_BAR; PG8_MMA(0, 0, At, B0); PG8_MMA(0, 1, At, B1); PG8_BAR; PG8_SCHED;
            PG8_LDA(At, 0, 1); PG8_STAGEB(0, b2); PG8_STAGEA(PG8_SA(0, 0), a2, vS[0]);
            PG8_WAIT_VL; PG8_BAR; PG8_MMA(1, 0, At, B0); PG8_MMA(1, 1, At, B1); PG8_BAR; PG8_SCHED;
            PG8_LDB(B0, 1, 0); PG8_LDB(B1, 1, 1); PG8_SCHED; PG8_LDA(At, 1, 0); PG8_STAGEA(PG8_SA(0, 1), a2, vS[1]);
            PG8_WAIT_VL; PG8_BAR; PG8_MMA(0, 0, At, B0); PG8_MMA(0, 1, At, B1); PG8_BAR; PG8_SCHED;
            PG8_LDA(At, 1, 1); PG8_STAGEB(1, b3); PG8_STAGEA(PG8_SA(1, 0), a3, vS[0]);
            PG8_WAIT_VL; PG8_BAR; PG8_MMA(1, 0, At, B0); PG8_MMA(1, 1, At, B1); PG8_BAR; PG8_SCHED;
        }
        if constexpr (ALIGN_EPI) { if (wr == 0) PG8_BAR; }
        if constexpr (P::FP8) asm volatile("s_nop 15\n\ts_nop 7" ::: "memory");
        if constexpr (P::KREP == 2) {
#pragma unroll
            for (int a = 0; a < 2; ++a)
#pragma unroll
                for (int b = 0; b < 2; ++b)
#pragma unroll
                    for (int m = 0; m < 4; ++m)
#pragma unroll
                        for (int n = 0; n < 2; ++n) acc[a][b][m][n] = acc[a][b][m][n] * 0.5f; }
        S.epi(acc, cur, ui, wr, wc, fr, fq, lds);
#ifdef PROBE_EPI2
        if constexpr (P::IDEM) { asm volatile("" ::: "memory"); S.epi(acc, cur, ui, wr, wc, fr, fq, lds); }
#endif
        if (!has_next) break;
#pragma unroll
        for (int a = 0; a < 2; ++a)
#pragma unroll
            for (int b = 0; b < 2; ++b)
#pragma unroll
                for (int m = 0; m < 4; ++m)
#pragma unroll
                    for (int n = 0; n < 2; ++n) acc[a][b][m][n] = (f32x4){0.f, 0.f, 0.f, 0.f};
        cur = nxt; cA = nA; cB = nB; ++ui;
#pragma unroll
        for (int h = 0; h < 2; ++h)
#pragma unroll
            for (int i = 0; i < 2; ++i) vC[h][i] = vN[h][i];
        if constexpr (ALIGN_EPI) { if (wr == 1) PG8_BAR; }
    }
    PG8_WAIT_V(0);
    if constexpr (!ALIGN_EPI) { if (wr == 0) PG8_BAR; }
    PG8_BAR;
#undef PG8_SA
#undef PG8_SB
#undef PG8_STAGE
#undef PG8_STAGEA
#undef PG8_STAGEA3
#undef PG8_LDA3
#undef PG8_SB6
#undef PG8_STAGEB
#undef PG8_LDB6
#undef PG8_B6SEL
#undef PG8_LDB8
#undef PG8_WAIT_VL
#undef PG8_LDA
#undef PG8_LDB
#undef PG8_MMA
#undef PG8_CAT
#undef PG8_WAIT_V
#undef PG8_WAIT_L
#undef PG8_BAR
#undef PG8_SCHED
}

struct DenseBase {
    const bf16_t* A; const bf16_t* Bt; int nM, nN, G, c;
    __device__ __forceinline__ bool next(int i, Unit& u) const { int pm, pn; if (!tile_order<WGM_DENSE>(i, G, c, nM, nN, pm, pn)) return false; u.pm = pm; u.pn = pn; u.e = 0; u.row0 = 0; u.nrows = 256; u.arow = pm * 256; return true; }
    __device__ __forceinline__ const char* a_ptr(const Unit& u) const { return (const char*)A + (size_t)u.pm * (size_t)(BM * KD * 2); }
    __device__ __forceinline__ const char* b_ptr(const Unit& u) const { return (const char*)Bt + (size_t)u.pn * (size_t)(BM * KD * 2); }
    __device__ __forceinline__ void a_voff(const Unit&, const int (&RA)[2], const int (&CA)[2], unsigned (&v)[2][2]) const {
#pragma unroll
        for (int h = 0; h < 2; ++h)
#pragma unroll
            for (int i = 0; i < 2; ++i) v[h][i] = (unsigned)((RA[i] + HALF * h) * KD + CA[i]) * 2u; }
};

struct ProbInProj : DenseBase {
    static constexpr bool PERM = true;
#ifdef PROBE_KX2_ProbInProj
    static constexpr int KREP = 2;
#else
    static constexpr int KREP = 1;
#endif
    static constexpr bool SIDE = false, IDEM = false, FP8 = false; static constexpr int SCW = 0, SCX = 0;
#ifndef STG_P1
#define STG_P1 0
#endif
    static constexpr int STAGGER = STG_P1, A_AUX = 0; static constexpr bool B6 = false, A3 = false;
    bf16_t* PROJ; const float* rc; const float* rs; const float* mc; const float* ms; float* ksum;
    __device__ __forceinline__ void epi(const f32x4 (&acc)[2][2][4][2], const Unit& u, int, int wr, int wc, int fr, int fq, LAS unsigned char*) const {
        const int pn = u.pn; const int rowt = u.pm * BM + wr * 64 + fr;
        if (pn <= 1) {
            const float sc = pn == 0 ? 1.f : 0.125f;
#pragma unroll
            for (int ai = 0; ai < 2; ++ai)
#pragma unroll
                for (int m = 0; m < 4; ++m) { const int row = rowt + ai * HALF + m * 16, s = row & (SEQ - 1);
                    const f32x4 c0 = *(const f32x4*)(rc + s * 32 + 8 * fq), c1 = *(const f32x4*)(rc + s * 32 + 8 * fq + 4);
                    const f32x4 s0 = *(const f32x4*)(rs + s * 32 + 8 * fq), s1 = *(const f32x4*)(rs + s * 32 + 8 * fq + 4);
                    const f32x4 a0 = acc[ai][0][m][0], a1 = acc[ai][0][m][1], b0 = acc[ai][1][m][0], b1 = acc[ai][1][m][1];
                    const f32x4 o10 = (a0 * c0 - b0 * s0) * sc, o11 = (a1 * c1 - b1 * s1) * sc, o20 = (a0 * s0 + b0 * c0) * sc, o21 = (a1 * s1 + b1 * c1) * sc;
                    bf16_t* dst = PROJ + (size_t)row * DIN + pn * 256 + 64 * wc + 8 * fq;
                    *(u32x4*)dst = pack8(o10, o11); *(u32x4*)(dst + 32) = pack8(o20, o21); asm volatile("" ::: "memory"); }
        } else if (pn >= 6 && pn <= 9) {
            const bool rot = ((wc & 1) == 0) && (fq < 2); const float sc = pn < 8 ? QC2 : 1.f; const bool isk = pn >= 8;
            f32x4 ks[2][2];
#pragma unroll
            for (int bj = 0; bj < 2; ++bj)
#pragma unroll
                for (int n = 0; n < 2; ++n) ks[bj][n] = (f32x4){0.f, 0.f, 0.f, 0.f};
#pragma unroll
            for (int ai = 0; ai < 2; ++ai)
#pragma unroll
                for (int m = 0; m < 4; ++m) { const int row = rowt + ai * HALF + m * 16, s = row & (SEQ - 1);
                    f32x4 c = *(const f32x4*)(mc + s * 8 + 4 * (fq & 1)), sn = *(const f32x4*)(ms + s * 8 + 4 * (fq & 1));
                    if (!rot) { c = (f32x4){1.f, 1.f, 1.f, 1.f}; sn = (f32x4){0.f, 0.f, 0.f, 0.f}; }
#pragma unroll
                    for (int bj = 0; bj < 2; ++bj) { const f32x4 v0 = acc[ai][bj][m][0], v1 = acc[ai][bj][m][1];
                        const f32x4 n0 = (v0 * c - v1 * sn) * sc, n1 = (v0 * sn + v1 * c) * sc;
                        if (isk) { ks[bj][0] += n0; ks[bj][1] += n1; asm volatile("" : "+v"(ks[bj][0]), "+v"(ks[bj][1])); }
                        *(u32x4*)(PROJ + (size_t)row * DIN + pn * 256 + bj * HALF + 32 * wc + 8 * fq) = pack8(n0, n1); }
                    asm volatile("" ::: "memory"); }
            if (isk) {
#pragma unroll
                for (int bj = 0; bj < 2; ++bj)
#pragma unroll
                    for (int n = 0; n < 2; ++n)
#pragma unroll
                        for (int e = 0; e < 4; ++e) { float v = ks[bj][n][e]; v += __shfl_xor(v, 1); v += __shfl_xor(v, 2); v += __shfl_xor(v, 4); v += __shfl_xor(v, 8); ks[bj][n][e] = v; }
                if (fr == 0) {
#pragma unroll
                    for (int bj = 0; bj < 2; ++bj)
#pragma unroll
                        for (int n = 0; n < 2; ++n) *(f32x4*)(ksum + ((size_t)u.pm * 2 + wr) * 512 + (pn - 8) * 256 + bj * HALF + 32 * wc + 8 * fq + 4 * n) = ks[bj][n]; }
            }
        } else {
#pragma unroll
            for (int ai = 0; ai < 2; ++ai)
#pragma unroll
                for (int m = 0; m < 4; ++m) { const int row = rowt + ai * HALF + m * 16;
#pragma unroll
                    for (int bj = 0; bj < 2; ++bj) *(u32x4*)(PROJ + (size_t)row * DIN + pn * 256 + bj * HALF + 32 * wc + 8 * fq) = pack8(acc[ai][bj][m][0], acc[ai][bj][m][1]); }
        }
    }
};

struct ProbOutProj : DenseBase {
    static constexpr bool PERM = true;
#ifdef PROBE_KX2_ProbOutProj
    static constexpr int KREP = 2;
#else
    static constexpr int KREP = 1;
#endif
    static constexpr bool SIDE = false, IDEM = false, FP8 = false; static constexpr int SCW = 0, SCX = 0, STAGGER = 0, A_AUX = 0; static constexpr bool B6 = false, A3 = false;
    bf16_t* D;
    __device__ __forceinline__ void epi(const f32x4 (&acc)[2][2][4][2], const Unit& u, int, int wr, int wc, int fr, int fq, LAS unsigned char*) const {
        const int row0 = u.pm * BM + wr * 64 + fr, col0 = u.pn * BM + wc * 32 + 8 * fq;
#pragma unroll
        for (int ai = 0; ai < 2; ++ai)
#pragma unroll
            for (int m = 0; m < 4; ++m) { bf16_t* p = D + (size_t)(row0 + ai * HALF + m * 16) * DM + col0;
#pragma unroll
                for (int bj = 0; bj < 2; ++bj) *(u32x4*)(p + bj * HALF) = pack8(acc[ai][bj][m][0], acc[ai][bj][m][1]); }
    }
};

struct MoeBase {
    int T, NP, G, c; int tp_lane, cp_lane;
    __device__ __forceinline__ void load_tables(const LAS int* tpre, const LAS int* cpre) { const int l = (int)(threadIdx.x & 63), i = l < 32 ? l : 32; tp_lane = tpre[i]; cp_lane = cpre[i]; }
    __device__ __forceinline__ bool next(int i, Unit& u) const {
        int pm, pn; if (!tile_order<WGM_MOE>(i, G, c, T, NP, pm, pn)) return false;
        const unsigned long long m = __ballot(tp_lane <= pm) & 0x1ffffffffull;
        int e = __builtin_popcountll(m) - 1; e = e > NEXP - 1 ? NEXP - 1 : e;
        const int t0 = __builtin_amdgcn_readlane(tp_lane, e), c0 = __builtin_amdgcn_readlane(cp_lane, e), c1 = __builtin_amdgcn_readlane(cp_lane, e + 1);
        u.pm = pm; u.pn = pn; u.e = e; u.row0 = (pm - t0) * 256; const int rem = (c1 - c0) - u.row0; u.nrows = rem < 256 ? rem : 256; u.arow = c0 + u.row0; return true;
    }
};
constexpr int SIDE_OFF = RING_BYTES + 1024, SIDE_PAR = 4096, SD_SLOT = 0, SD_ROW = 1024, SD_BIAS = 2048;
__device__ __forceinline__ void side_dma(const void* gsrc_lane, LAS unsigned char* dst_wave) { __builtin_amdgcn_global_load_lds((const unsigned*)gsrc_lane, (LAS unsigned*)dst_wave, 16, 0, 0); }
struct ProbMoe1 : MoeBase {
    static constexpr bool PERM = true, SIDE = true, IDEM = true, FP8 = true;
    static constexpr int SCW = 0x79797979, SCX = 0x7f7f7f7f;
#ifndef STG_P5
#define STG_P5 0
#endif
    static constexpr int STAGGER = STG_P5, A_AUX = AUX_P5; static constexpr bool B6 = (MOE_B6 != 0), A3 = B6 && (MOE_A3 != 0);
#ifdef PROBE_KX2_ProbMoe1
    static constexpr int KREP = 2;
#else
    static constexpr int KREP = 1;
#endif
    const unsigned char* H2; const unsigned char* W1T; const int* slot; const float* srstd; const float* b1; unsigned char* ACT;
    __device__ __forceinline__ const char* a_ptr(const Unit&) const { return (const char*)H2; }
    __device__ __forceinline__ const char* b_ptr(const Unit& u) const { return (const char*)W1T + ((size_t)u.e * 2048 + (size_t)u.pn * 256) * (size_t)(B6 ? 768 : KD); }
    __device__ __forceinline__ void a_voff(const Unit& u, const int (&RA)[2], const int (&CA)[2], unsigned (&v)[2][2]) const {
#pragma unroll
        for (int h = 0; h < 2; ++h)
#pragma unroll
            for (int i = 0; i < 2; ++i) { int r = RA[i] + HALF * h; r = r < u.nrows ? r : u.nrows - 1; const int pair = slot[(size_t)u.e * NTOK + u.row0 + r]; v[h][i] = (unsigned)(pair >> 2) * (unsigned)KD + (unsigned)CA[i] * 2u; } }
    __device__ __forceinline__ void a_voff_side(const Unit& u, int uin, const int (&RA)[2], const int (&CA)[2], unsigned (&v)[2][2], LAS unsigned char* lds) const {
        const LAS int* sb = (const LAS int*)(lds + SIDE_OFF + (uin & 1) * SIDE_PAR + SD_SLOT);
#pragma unroll
        for (int h = 0; h < 2; ++h)
#pragma unroll
            for (int i = 0; i < 2; ++i) { int r = RA[i] + HALF * h; r = r < u.nrows ? r : u.nrows - 1; const int pair = sb[r]; v[h][i] = (unsigned)(pair >> 2) * (unsigned)KD + (unsigned)CA[i] * 2u; } }
    __device__ __forceinline__ void side_issue(const Unit& cur, const Unit& nxt, bool has_next, int ui, int wid, int lane, LAS unsigned char* lds) const {
        if (wid == 0) { if (has_next) side_dma(slot + (size_t)nxt.e * NTOK + nxt.row0 + 4 * lane, lds + SIDE_OFF + ((ui + 1) & 1) * SIDE_PAR + SD_SLOT); }
        else if (wid == 1) side_dma(srstd + (size_t)cur.e * NTOK + cur.row0 + 4 * lane, lds + SIDE_OFF + (ui & 1) * SIDE_PAR + SD_ROW);
        else if (wid == 2) side_dma(b1 + (size_t)cur.e * 2048 + 128 * cur.pn + ((lane >> 5) * 1024) + 4 * (lane & 31), lds + SIDE_OFF + (ui & 1) * SIDE_PAR + SD_BIAS);
    }
    __device__ __forceinline__ void epi(const f32x4 (&acc)[2][2][4][2], const Unit& u, int ui, int wr, int wc, int fr, int fq, LAS unsigned char* lds) const {
        const LAS unsigned char* sd = lds + SIDE_OFF + (ui & 1) * SIDE_PAR;
        const int cc0 = 32 * wc + 8 * fq; const LAS float* bb = (const LAS float*)(sd + SD_BIAS) + cc0; const LAS float* rsb = (const LAS float*)(sd + SD_ROW);
        constexpr float CE = -1.702f * 1.4426950408889634f, K4 = 4.0f / CE;
        const f32x4 bg0 = *(const LAS f32x4*)bb * CE, bg1 = *(const LAS f32x4*)(bb + 4) * CE, bl0 = *(const LAS f32x4*)(bb + 128), bl1 = *(const LAS f32x4*)(bb + 132);
        const f32x4 tlo = (f32x4){7.f * CE, 7.f * CE, 7.f * CE, 7.f * CE}, one4 = (f32x4){1.f, 1.f, 1.f, 1.f}, k4 = (f32x4){K4, K4, K4, K4};
#pragma unroll
        for (int ai = 0; ai < 2; ++ai)
#pragma unroll
            for (int m = 0; m < 4; ++m) { const int r = ai * HALF + wr * 64 + m * 16 + fr; const bool valid = r < u.nrows;
                const float rs = rsb[r], rsc = rs * CE;
                f32x4 o[2];
#pragma unroll
                for (int n = 0; n < 2; ++n) { f32x4 t = __builtin_elementwise_max(acc[ai][0][m][n] * rsc + (n ? bg1 : bg0), tlo), l = acc[ai][1][m][n] * rs + (n ? bl1 : bl0), e, sg;
#pragma unroll
                    for (int q = 0; q < 4; ++q) { e[q] = __builtin_amdgcn_exp2f(t[q]); l[q] = __builtin_amdgcn_fmed3f(l[q], -7.f, 7.f); }
                    e = e + one4;
#pragma unroll
                    for (int q = 0; q < 4; ++q) sg[q] = __builtin_amdgcn_rcpf(e[q]);
                    o[n] = (t * sg) * (l * k4 + k4); }
                if (valid) *(u32x2*)(ACT + (size_t)(u.arow + r) * DM + 128 * u.pn + cc0) = pack8_fp8(o[0], o[1]); }
    }
};
struct ProbMoe2 : MoeBase {
    static constexpr bool PERM = true, SIDE = true, IDEM = true, FP8 = true;
    static constexpr int SCW = 0x79797979, SCX = 0x7d7d7d7d;
#ifndef STG_P6
#define STG_P6 0
#endif
    static constexpr int STAGGER = STG_P6, A_AUX = AUX_P6; static constexpr bool B6 = (MOE_B6 != 0), A3 = B6 && (MOE_A3 != 0);
#ifdef PROBE_KX2_ProbMoe2
    static constexpr int KREP = 2;
#else
    static constexpr int KREP = 1;
#endif
    const unsigned char* ACT; const unsigned char* W2T; const int* slot; const float* sgate; const float* b2; unsigned char* Y4;
    __device__ __forceinline__ const char* a_ptr(const Unit& u) const { return (const char*)ACT + (size_t)u.arow * (size_t)KD; }
    __device__ __forceinline__ const char* b_ptr(const Unit& u) const { return (const char*)W2T + ((size_t)u.e * 1024 + (size_t)u.pn * 256) * (size_t)(B6 ? 768 : KD); }
    __device__ __forceinline__ void a_voff(const Unit& u, const int (&RA)[2], const int (&CA)[2], unsigned (&v)[2][2]) const {
#pragma unroll
        for (int h = 0; h < 2; ++h)
#pragma unroll
            for (int i = 0; i < 2; ++i) { int r = RA[i] + HALF * h; r = r < u.nrows ? r : u.nrows - 1; v[h][i] = (unsigned)(r * KD + CA[i] * 2); } }
    __device__ __forceinline__ void a_voff_side(const Unit& u, int, const int (&RA)[2], const int (&CA)[2], unsigned (&v)[2][2], LAS unsigned char*) const { a_voff(u, RA, CA, v); }
    __device__ __forceinline__ void side_issue(const Unit& cur, const Unit&, bool, int ui, int wid, int lane, LAS unsigned char* lds) const {
        if (wid == 0) side_dma(slot + (size_t)cur.e * NTOK + cur.row0 + 4 * lane, lds + SIDE_OFF + (ui & 1) * SIDE_PAR + SD_SLOT);
        else if (wid == 1) side_dma(sgate + (size_t)cur.e * NTOK + cur.row0 + 4 * lane, lds + SIDE_OFF + (ui & 1) * SIDE_PAR + SD_ROW);
        else if (wid == 2) side_dma(b2 + (size_t)cur.e * 1024 + 256 * cur.pn + 4 * lane, lds + SIDE_OFF + (ui & 1) * SIDE_PAR + SD_BIAS);
    }
    __device__ __forceinline__ void epi(const f32x4 (&acc)[2][2][4][2], const Unit& u, int ui, int wr, int wc, int fr, int fq, LAS unsigned char* lds) const {
        const LAS unsigned char* sd = lds + SIDE_OFF + (ui & 1) * SIDE_PAR;
        const int cl0 = 32 * wc + 8 * fq, col0 = u.pn * BM + cl0; const LAS float* bb = (const LAS float*)(sd + SD_BIAS) + cl0;
        const LAS int* psb = (const LAS int*)(sd + SD_SLOT); const LAS float* gsb = (const LAS float*)(sd + SD_ROW);
        f32x4 bv[2][2];
#pragma unroll
        for (int bj = 0; bj < 2; ++bj)
#pragma unroll
            for (int n = 0; n < 2; ++n) bv[bj][n] = *(const LAS f32x4*)(bb + bj * HALF + 4 * n);
#pragma unroll
        for (int ai = 0; ai < 2; ++ai)
#pragma unroll
            for (int m = 0; m < 4; ++m) { const int r = ai * HALF + wr * 64 + m * 16 + fr; const bool valid = r < u.nrows;
                const int pair = psb[r]; const float gt = gsb[r] * 8.f;
                if (valid) { unsigned char* p = Y4 + (size_t)pair * DM + col0;
#pragma unroll
                    for (int bj = 0; bj < 2; ++bj) *(u32x2*)(p + bj * HALF) = pack8_fp8((acc[ai][bj][m][0] + bv[bj][0]) * gt, (acc[ai][bj][m][1] + bv[bj][1]) * gt); } }
    }
};
}

namespace moba {
using bf16 = __hip_bfloat16;
constexpr int D = 64, PP = DIN, OP = DM;
constexpr int NW = 8, QBLK = 32, QB = QBLK * NW, KVBLK = 64;
__device__ __forceinline__ int crow(int r, int hi) { return (r & 3) + 8 * (r >> 2) + 4 * hi; }
#define SBAR() __builtin_amdgcn_sched_barrier(0)
__device__ __forceinline__ void cmask(f32x16& p0, f32x16& p1, int jb, int qrel, int hi) {
  const float NEG = -INFINITY; int kb = 64 * jb + 4 * hi;
  #pragma unroll
  for (int r = 0; r < 16; ++r) { int kv = kb + (r & 3) + 8 * (r >> 2); if (kv > qrel) p0[r] = NEG; if (kv + 32 > qrel) p1[r] = NEG; }
}
constexpr int NSLOT = 3, SLOTB = 8192;
constexpr int LDS_K = 0, LDS_V = NSLOT * SLOTB, LDS_WS = 2 * NSLOT * SLOTB, LDS_OST = LDS_WS + NW * 64 * 4, LDS_BYTES_A = LDS_OST + NW * 4096;
__device__ __forceinline__ void glds16s(const void* sbase, unsigned voff, unsigned lds_dst) { unsigned keep;
  asm volatile("s_mov_b32 %0, m0\n\ts_mov_b32 m0, %3\n\ts_nop 4\n\tglobal_load_lds_dwordx4 %1, %2\n\ts_mov_b32 m0, %0" : "=&s"(keep) : "v"(voff), "s"(sbase), "s"(lds_dst) : "memory"); }
__device__ __forceinline__ float max3f(float a, float b, float c) { float r; asm("v_max3_f32 %0, %1, %2, %3" : "=v"(r) : "v"(a), "v"(b), "v"(c)); return r; }
__device__ __forceinline__ float max2f(float a, float b) { float r; asm("v_max_f32_e32 %0, %1, %2" : "=v"(r) : "v"(a), "v"(b)); return r; }
__device__ __forceinline__ float fadd_s(float a, float b) { float r; asm("v_add_f32_e32 %0, %1, %2" : "=v"(r) : "v"(a), "v"(b)); return r; }
__device__ __forceinline__ float fsub_s(float a, float b) { float r; asm("v_sub_f32_e32 %0, %1, %2" : "=v"(r) : "v"(a), "v"(b)); return r; }
typedef __bf16 bf16x2_t __attribute__((ext_vector_type(2)));
__device__ __forceinline__ unsigned cvtpk_s(float lo, float hi) { f32x2 v = {lo, hi}; bf16x2_t b = __builtin_convertvector(v, bf16x2_t); return __builtin_bit_cast(unsigned, b); }
#define WAIT_BAR(N) asm volatile("s_waitcnt vmcnt(" #N ") lgkmcnt(0)\n\ts_barrier" ::: "memory")
__device__ __forceinline__ void qkt(f32x16& p0, f32x16& p1, const char* Kslot, const bf16x8* qr, const f32x16& negm, int r32, int hi) {
  const char* kb = Kslot + hi * 1024 + r32 * 16;
  #pragma unroll
  for (int d0 = 0; d0 < 4; ++d0) {
    const bf16x8 b0 = *reinterpret_cast<const bf16x8*>(kb + d0 * 2048);
    const bf16x8 b1 = *reinterpret_cast<const bf16x8*>(kb + d0 * 2048 + 512);
    if (d0 == 0) { p0 = __builtin_amdgcn_mfma_f32_32x32x16_bf16(b0, qr[0], negm, 0, 0, 0); p1 = __builtin_amdgcn_mfma_f32_32x32x16_bf16(b1, qr[0], negm, 0, 0, 0); }
    else { p0 = __builtin_amdgcn_mfma_f32_32x32x16_bf16(b0, qr[d0], p0, 0, 0, 0); p1 = __builtin_amdgcn_mfma_f32_32x32x16_bf16(b1, qr[d0], p1, 0, 0, 0); } }
}
typedef LAS const char* lds_cptr;
typedef short v4i16_t __attribute__((ext_vector_type(4)));
__device__ __forceinline__ void kload8(bf16x8* kf, lds_cptr kp) {
  kf[0] = *(const LAS bf16x8*)(kp);        kf[1] = *(const LAS bf16x8*)(kp + 512);
  kf[2] = *(const LAS bf16x8*)(kp + 2048); kf[3] = *(const LAS bf16x8*)(kp + 2560);
  kf[4] = *(const LAS bf16x8*)(kp + 4096); kf[5] = *(const LAS bf16x8*)(kp + 4608);
  kf[6] = *(const LAS bf16x8*)(kp + 6144); kf[7] = *(const LAS bf16x8*)(kp + 6656);
}
__device__ __forceinline__ void kload2(bf16x8* kf, lds_cptr kp, int j) { kf[2 * j] = *(const LAS bf16x8*)(kp + j * 2048); kf[2 * j + 1] = *(const LAS bf16x8*)(kp + j * 2048 + 512); }
__device__ __forceinline__ s16x4 vtr(lds_cptr p) { return __builtin_bit_cast(s16x4, __builtin_amdgcn_ds_read_tr16_b64_v4i16((LAS v4i16_t*)p)); }
__device__ __forceinline__ float rowmax(const f32x16& p0, const f32x16& p1) {
  float a = max3f(p0[0], p0[1], p1[0]), b = max3f(p0[2], p0[3], p1[1]); a = max3f(a, p1[2], p1[3]);
  #pragma unroll
  for (int r = 4; r < 16; r += 4) { a = max3f(a, p0[r], p0[r + 1]); b = max3f(b, p0[r + 2], p0[r + 3]); a = max3f(a, p1[r], p1[r + 1]); b = max3f(b, p1[r + 2], p1[r + 3]); }
  const float m = max2f(a, b);
  auto rr = __builtin_amdgcn_permlane32_swap(__float_as_uint(m), __float_as_uint(m), false, false);
  return max2f(__uint_as_float(rr[0]), __uint_as_float(rr[1]));
}
__device__ __forceinline__ void pv(f32x16* o, int vb, bf16x8 pa0, bf16x8 pa1, bf16x8 pa2, bf16x8 pa3) {
  #pragma unroll
  for (int d0 = 0; d0 < 2; ++d0) { s16x4 lo[4], hi[4];
    #pragma unroll
    for (int ks = 0; ks < 4; ++ks) {
      asm volatile("ds_read_b64_tr_b16 %0,%1 offset:%c2" : "=&v"(lo[ks]) : "v"(vb), "i"(d0 * 4096 + ks * 1024) : "memory");
      asm volatile("ds_read_b64_tr_b16 %0,%1 offset:%c2" : "=&v"(hi[ks]) : "v"(vb), "i"(d0 * 4096 + ks * 1024 + 512) : "memory"); }
    asm volatile("s_waitcnt lgkmcnt(0)" ::: "memory"); SBAR();
    #define PK(k) (bf16x8){lo[k][0], lo[k][1], lo[k][2], lo[k][3], hi[k][0], hi[k][1], hi[k][2], hi[k][3]}
    o[d0] = __builtin_amdgcn_mfma_f32_32x32x16_bf16(pa0, PK(0), o[d0], 0, 0, 0);
    o[d0] = __builtin_amdgcn_mfma_f32_32x32x16_bf16(pa1, PK(1), o[d0], 0, 0, 0);
    o[d0] = __builtin_amdgcn_mfma_f32_32x32x16_bf16(pa2, PK(2), o[d0], 0, 0, 0);
    o[d0] = __builtin_amdgcn_mfma_f32_32x32x16_bf16(pa3, PK(3), o[d0], 0, 0, 0);
    #undef PK
  }
}

template <int THRL> __device__ __forceinline__ void moba_unit(int b, int h, int qb, const bf16* PROJ, const float* ksum, bf16* MIX, char* shm, volatile LAS unsigned* nidp, unsigned nid, volatile LAS unsigned* tsw = nullptr) {
#ifdef PROBE_TS
  const unsigned long long ts0_ = __builtin_amdgcn_s_memrealtime();
#endif
  int tid_ = threadIdx.x; asm volatile("" : "+v"(tid_));
  const int tid = tid_, lane = tid & 63, r32 = lane & 31, hi = lane >> 5; const int wid = __builtin_amdgcn_readfirstlane(tid >> 6);
  const long rowbase = (long)b * SEQ; const int q0 = qb * QB;
  const bf16* Qw = PROJ + (rowbase + q0 + wid * QBLK) * PP + PC_MQ + h * D;
  const bf16* Kh = PROJ + rowbase * PP + PC_MK + h * D, *Vh = PROJ + rowbase * PP + PC_MV + h * D;
  const unsigned lds0 = (unsigned)(uintptr_t)shm;
  float* wsf = (float*)(shm + LDS_WS) + wid * 64;
  const unsigned kvo = (unsigned)(lane * PP + wid * 8) * 2u;
  const unsigned vvo = (unsigned)((16 * (wid & 3) + (lane >> 2)) * PP + (wid >> 2) * 32 + (lane & 3) * 8) * 2u;
  const unsigned kdst = lds0 + LDS_K + wid * 1024, vdst = lds0 + LDS_V + wid * 1024;
  const int tb4 = 4 * qb, NT = tb4 + 4;
  #define TM(t) (((t) < 4) ? (tb4 + (t)) : ((t) - 4))
  const unsigned dump = lds0 + (unsigned)(RING_BYTES + 1024) + wid * 1024;
  #define DMA_K(t, slot) glds16s(Kh + (long)TM(t) * KVBLK * PP, kvo, (unsigned)__builtin_amdgcn_readfirstlane(((t) < NT) ? kdst + (slot) : dump))
  #define DMA_V(t, slot) glds16s(Vh + (long)TM(t) * KVBLK * PP, vvo, (unsigned)__builtin_amdgcn_readfirstlane(((t) < NT) ? vdst + (slot) : dump))
  const int vb0 = (int)(lds0 + LDS_V) + ((lane >> 4) & 1) * 32 + (lane & 3) * 8 + (4 * hi + ((lane & 15) >> 2)) * 64;
  const char* Kbase = shm + LDS_K; bf16x8 kf[8];
  const lds_cptr shm3 = (lds_cptr)shm; const lds_cptr kp0 = shm3 + LDS_K + hi * 1024 + r32 * 16; const lds_cptr vp0 = shm3 + LDS_V + ((lane >> 4) & 1) * 32 + (lane & 3) * 8 + (4 * hi + ((lane & 15) >> 2)) * 64;
  DMA_K(0, 0); DMA_V(0, 0); DMA_K(1, SLOTB);
  bf16x8 qr[4];
  #pragma unroll
  for (int d0 = 0; d0 < 4; ++d0) qr[d0] = *reinterpret_cast<const bf16x8*>(&Qw[(long)r32 * PP + d0 * 16 + hi * 8]);
  unsigned sel = (1u << qb) - 1u;
  if (qb > 3) {
    f32x16 gt = f32x16{};
    #pragma unroll
    for (int d0 = 0; d0 < 4; ++d0) {
      f32x4 a0 = (f32x4){0.f, 0.f, 0.f, 0.f}, a1 = a0;
      if (r32 < qb) { const float* k0 = ksum + ((size_t)(b * 8 + r32) * 2) * 512 + h * D + 16 * d0 + 8 * hi;
        a0 = *(const f32x4*)k0 + *(const f32x4*)(k0 + 512); a1 = *(const f32x4*)(k0 + 4) + *(const f32x4*)(k0 + 516); }
      u32x4 hw, lw;
      hw.x = pk2(a0.x, a0.y); hw.y = pk2(a0.z, a0.w); hw.z = pk2(a1.x, a1.y); hw.w = pk2(a1.z, a1.w);
      lw.x = pk2(a0.x - __builtin_bit_cast(float, hw.x << 16), a0.y - __builtin_bit_cast(float, hw.x & 0xffff0000u)); lw.y = pk2(a0.z - __builtin_bit_cast(float, hw.y << 16), a0.w - __builtin_bit_cast(float, hw.y & 0xffff0000u));
      lw.z = pk2(a1.x - __builtin_bit_cast(float, hw.z << 16), a1.y - __builtin_bit_cast(float, hw.z & 0xffff0000u)); lw.w = pk2(a1.z - __builtin_bit_cast(float, hw.w << 16), a1.w - __builtin_bit_cast(float, hw.w & 0xffff0000u));
      gt = __builtin_amdgcn_mfma_f32_32x32x16_bf16(__builtin_bit_cast(bf16x8, hw), qr[d0], gt, 0, 0, 0);
      gt = __builtin_amdgcn_mfma_f32_32x32x16_bf16(__builtin_bit_cast(bf16x8, lw), qr[d0], gt, 0, 0, 0);
    }
    float gl[4], gh[4];
    #pragma unroll
    for (int r = 0; r < 4; ++r) { const float mine = gt[r], oth = __shfl_xor(mine, 32); gl[r] = hi ? oth : mine; gh[r] = hi ? mine : oth; }
    float v1 = -INFINITY, v2 = -INFINITY, v3 = -INFINITY; int i1 = 0, i2 = 0, i3 = 0;
    #pragma unroll
    for (int j = 0; j < 8; ++j) { const float p = (j < 4) ? gl[j & 3] : gh[j & 3];
      if (j < qb) { if (p > v1) { v3 = v2; i3 = i2; v2 = v1; i2 = i1; v1 = p; i1 = j; } else if (p > v2) { v3 = v2; i3 = i2; v2 = p; i2 = j; } else if (p > v3) { v3 = p; i3 = j; } } }
    sel = (1u << i1) | (1u << i2) | (1u << i3);
  }
  float mhat = 0.f, l_reg = 0.f; f32x16 o[2]; o[0] = f32x16{}; o[1] = f32x16{}; const f32x16 zero16 = f32x16{};
  const int qrel = wid * QBLK + r32;
  #define CMASK(P0, P1, t) do { if ((t) < 4) cmask(P0, P1, (t), qrel, hi); } while (0)
  #define NVAL(t) (((t) >= 4 && !((sel >> (((t) - 4) >> 2)) & 1u)) ? -INFINITY : -mhat)
  bool resc = false;
  #define START(P0, P1) do { const float rm = rowmax(P0, P1); resc = false; \
    { const float dl = rm; mhat = fadd_s(mhat, dl); \
      _Pragma("unroll") for (int r = 0; r < 16; ++r) { P0[r] = fsub_s(P0[r], dl); P1[r] = fsub_s(P1[r], dl); } } \
    _Pragma("unroll") for (int r = 0; r < 16; ++r) P0[r] = __builtin_amdgcn_exp2f(P0[r]); } while (0)
  #define RESC() do { if (resc) { asm volatile("s_waitcnt lgkmcnt(0)" ::: "memory"); \
      _Pragma("unroll") for (int d_ = 0; d_ < 2; ++d_) _Pragma("unroll") for (int r = 0; r < 16; ++r) o[d_][r] *= wsf[crow(r, hi)]; } } while (0)
  f32x16 pA0, pA1, pB0, pB1;
  int sl_prev = 0, sl_cur = 0, sl_next = SLOTB;
  #define ROT() do { sl_prev = sl_cur; sl_cur = sl_next; sl_next = (sl_next == (NSLOT - 1) * SLOTB) ? 0 : sl_next + SLOTB; } while (0)
  DMA_K(2, 2 * SLOTB);
  WAIT_BAR(3);
  qkt(pA0, pA1, Kbase, qr, zero16, r32, hi); asm volatile("s_nop 15\n\ts_nop 7" : "+v"(pA0), "+v"(pA1)); CMASK(pA0, pA1, 0);
  START(pA0, pA1);
  _Pragma("unroll") for (int r = 0; r < 16; ++r) pA1[r] = __builtin_amdgcn_exp2f(pA1[r]);
  WAIT_BAR(0);
  DMA_K(3, 0); DMA_V(1, SLOTB);
  ROT();
  kload8(kf, kp0 + sl_cur);
  WAIT_BAR(2);
  s16x4 vlo[8], vhi[8]; u32x4 pw0, pw1, pw2, pw3;
  #define PKW(P, B) cvtpk_s(P[B], P[B + 1])
  #define PAF(k) __builtin_bit_cast(bf16x8, pw##k)
  #define VFR(i) (bf16x8){vlo[i][0], vlo[i][1], vlo[i][2], vlo[i][3], vhi[i][0], vhi[i][1], vhi[i][2], vhi[i][3]}
  #define PIN(x) asm volatile("" : "+v"(x))
  #define MX3(a, b, c) __builtin_fmaxf(__builtin_fmaxf((a), (b)), (c))
  #define GAPA(MF, A0, A1, A2, A3, W0, W1, PW) do { MF; sacc += A0; sacc += A1; sacc += A2; sacc += A3; PIN(sacc); W0; W1; PIN(PW); SBAR(); } while (0)
  #define EX(v) __builtin_amdgcn_exp2f(v)
  #define GAPB(MF, X, B) do { MF; X[B] = EX(X[B]); X[B + 1] = EX(X[B + 1]); X[B + 2] = EX(X[B + 2]); X[B + 3] = EX(X[B + 3]); PIN(X); SBAR(); } while (0)
  #define VRD(i) do { vlo[i] = vtr(vp_ + (((i) >> 2) * 4096 + ((i) & 3) * 1024)); vhi[i] = vtr(vp_ + (((i) >> 2) * 4096 + ((i) & 3) * 1024 + 512)); } while (0)
  #define KRD(G, j) do { if (G) { kload2(kf, kp0 + sl_next, j); SBAR(); } } while (0)
  #define STEP(C0, C1, P0, P1, t, GK, GV, GL) do { const float nv_ = NVAL(t); SBAR(); \
    const lds_cptr vp_ = vp0 + sl_prev; \
    VRD(0); SBAR(); float sacc = (P0[0] + P0[1]); \
    GAPA(C0 = __builtin_amdgcn_mfma_f32_32x32x16_bf16(kf[0], qr[0], zero16, 0, 0, 0), P0[2], P0[3], P0[4], P0[5],     pw0[0] = PKW(P0, 0), pw0[1] = PKW(P0, 2), pw0); \
    VRD(4); SBAR(); GAPA(C1 = __builtin_amdgcn_mfma_f32_32x32x16_bf16(kf[1], qr[0], zero16, 0, 0, 0), P0[6], P0[7], P0[8], P0[9],     pw0[2] = PKW(P0, 4), pw0[3] = PKW(P0, 6), pw0); \
    VRD(1); SBAR(); GAPA(C0 = __builtin_amdgcn_mfma_f32_32x32x16_bf16(kf[2], qr[1], C0, 0, 0, 0),   P0[10], P0[11], P0[12], P0[13], pw1[0] = PKW(P0, 8), pw1[1] = PKW(P0, 10), pw1); \
    VRD(5); SBAR(); GAPA(C1 = __builtin_amdgcn_mfma_f32_32x32x16_bf16(kf[3], qr[1], C1, 0, 0, 0),   P0[14], P0[15], P1[0], P1[1],   pw1[2] = PKW(P0, 12), pw1[3] = PKW(P0, 14), pw1); \
    VRD(2); SBAR(); GAPA(C0 = __builtin_amdgcn_mfma_f32_32x32x16_bf16(kf[4], qr[2], C0, 0, 0, 0),   P1[2], P1[3], P1[4], P1[5],     pw2[0] = PKW(P1, 0), pw2[1] = PKW(P1, 2), pw2); \
    VRD(6); SBAR(); GAPA(C1 = __builtin_amdgcn_mfma_f32_32x32x16_bf16(kf[5], qr[2], C1, 0, 0, 0),   P1[6], P1[7], P1[8], P1[9],     pw2[2] = PKW(P1, 4), pw2[3] = PKW(P1, 6), pw2); \
    VRD(3); SBAR(); GAPA(C0 = __builtin_amdgcn_mfma_f32_32x32x16_bf16(kf[6], qr[3], C0, 0, 0, 0),   P1[10], P1[11], P1[12], P1[13], pw3[0] = PKW(P1, 8), pw3[1] = PKW(P1, 10), pw3); \
    VRD(7); SBAR(); GAPA(C1 = __builtin_amdgcn_mfma_f32_32x32x16_bf16(kf[7], qr[3], C1, 0, 0, 0),   P1[14], P1[15], 0.f, 0.f,       pw3[2] = PKW(P1, 12), pw3[3] = PKW(P1, 14), pw3); \
    l_reg += sacc; \
    if (GK) { DMA_K((t) + 3, sl_cur); } if (GV) { DMA_V((t) + 1, sl_next); } \
    _Pragma("unroll") for (int r = 0; r < 16; ++r) { C0[r] += nv_; C1[r] += nv_; } \
    CMASK(C0, C1, t); \
    { float a = MX3(C0[0], C0[1], C1[0]), b = MX3(C0[2], C0[3], C1[1]); a = MX3(a, C1[2], C1[3]); \
      _Pragma("unroll") for (int r = 4; r < 16; r += 4) { a = MX3(a, C0[r], C0[r + 1]); b = MX3(b, C0[r + 2], C0[r + 3]); a = MX3(a, C1[r], C1[r + 1]); b = MX3(b, C1[r + 2], C1[r + 3]); } \
      float rm = __builtin_fmaxf(a, b); { auto rr = __builtin_amdgcn_permlane32_swap(__float_as_uint(rm), __float_as_uint(rm), false, false); rm = __builtin_fmaxf(__uint_as_float(rr[0]), __uint_as_float(rr[1])); } \
      resc = false; \
      if (__builtin_expect(__any(rm > (float)THRL), 0)) { const float dl = __builtin_fmaxf(rm, 0.f); mhat += dl; \
        _Pragma("unroll") for (int r = 0; r < 16; ++r) { C0[r] -= dl; C1[r] -= dl; } \
        const float f = __builtin_amdgcn_exp2f(-dl); l_reg *= f; if (hi == 0) wsf[r32] = f; resc = true; } } \
    SBAR(); \
    GAPB(o[0] = __builtin_amdgcn_mfma_f32_32x32x16_bf16(PAF(0), VFR(0), o[0], 0, 0, 0), C0, 0); \
    GAPB(o[1] = __builtin_amdgcn_mfma_f32_32x32x16_bf16(PAF(0), VFR(4), o[1], 0, 0, 0), C0, 4); \
    KRD(GL, 0); GAPB(o[0] = __builtin_amdgcn_mfma_f32_32x32x16_bf16(PAF(1), VFR(1), o[0], 0, 0, 0), C0, 8); \
    KRD(GL, 1); GAPB(o[1] = __builtin_amdgcn_mfma_f32_32x32x16_bf16(PAF(1), VFR(5), o[1], 0, 0, 0), C0, 12); \
    KRD(GL, 2); GAPB(o[0] = __builtin_amdgcn_mfma_f32_32x32x16_bf16(PAF(2), VFR(2), o[0], 0, 0, 0), C1, 0); \
    KRD(GL, 3); GAPB(o[1] = __builtin_amdgcn_mfma_f32_32x32x16_bf16(PAF(2), VFR(6), o[1], 0, 0, 0), C1, 4); \
    GAPB(o[0] = __builtin_amdgcn_mfma_f32_32x32x16_bf16(PAF(3), VFR(3), o[0], 0, 0, 0), C1, 8); \
    GAPB(o[1] = __builtin_amdgcn_mfma_f32_32x32x16_bf16(PAF(3), VFR(7), o[1], 0, 0, 0), C1, 12); \
    } while (0)
#ifdef PROBE_TS
  const unsigned long long ts1_ = __builtin_amdgcn_s_memrealtime();
#endif
  int t = 1;
  for (; t + 1 < NT; t += 2) {
    STEP(pB0, pB1, pA0, pA1, t, true, true, true);     WAIT_BAR(2); RESC(); ROT();
    STEP(pA0, pA1, pB0, pB1, t + 1, true, true, true); WAIT_BAR(2); RESC(); ROT();
  }
  STEP(pB0, pB1, pA0, pA1, NT - 1, true, true, true); WAIT_BAR(2); RESC();
  if (threadIdx.x == 0) *nidp = nid;
#ifdef PROBE_TS
  const unsigned long long ts2_ = __builtin_amdgcn_s_memrealtime();
#endif
  { float sacc = pB0[0] + pB0[1]; _Pragma("unroll") for (int r = 2; r < 16; ++r) sacc += pB0[r]; _Pragma("unroll") for (int r = 0; r < 16; ++r) sacc += pB1[r]; l_reg += sacc;
    pw0 = (u32x4){PKW(pB0, 0), PKW(pB0, 2), PKW(pB0, 4), PKW(pB0, 6)}; pw1 = (u32x4){PKW(pB0, 8), PKW(pB0, 10), PKW(pB0, 12), PKW(pB0, 14)}; pw2 = (u32x4){PKW(pB1, 0), PKW(pB1, 2), PKW(pB1, 4), PKW(pB1, 6)}; pw3 = (u32x4){PKW(pB1, 8), PKW(pB1, 10), PKW(pB1, 12), PKW(pB1, 14)};
    SBAR(); pv(o, vb0 + sl_cur, PAF(0), PAF(1), PAF(2), PAF(3)); }
  #undef PKW
  #undef PAF
  #undef VFR
  #undef PIN
  #undef MX3
  #undef GAPA
  #undef GAPB
  #undef EX
  #undef VRD
  #undef KRD
  #undef STEP
  { auto rr = __builtin_amdgcn_permlane32_swap(__float_as_uint(l_reg), __float_as_uint(l_reg), false, false); l_reg = __uint_as_float(rr[0]) + __uint_as_float(rr[1]); }
  if (hi == 0) wsf[32 + r32] = l_reg; asm volatile("s_waitcnt lgkmcnt(0)" ::: "memory");
  float rli[16];
  #pragma unroll
  for (int r = 0; r < 16; ++r) rli[r] = __builtin_amdgcn_rcpf(wsf[32 + crow(r, hi)]);
  bf16* Ow = MIX + (rowbase + q0 + wid * QBLK) * OP + 512 + h * D;
  { bf16* stg = (bf16*)(shm + LDS_OST) + wid * 2048;
    #pragma unroll
    for (int r = 0; r < 16; ++r) { const int orow = crow(r, hi);
      #pragma unroll
      for (int d0 = 0; d0 < 2; ++d0) stg[orow * 64 + d0 * 32 + r32] = __float2bfloat16(o[d0][r] * rli[r]); }
    asm volatile("s_waitcnt lgkmcnt(0)" ::: "memory");
    #pragma unroll
    for (int i = 0; i < 4; ++i) { const int row = i * 8 + (lane >> 3), ch = lane & 7; const u32x4 v = *(const u32x4*)(stg + row * 64 + ch * 8); *(u32x4*)(Ow + (long)row * OP + ch * 8) = v; } }
  asm volatile("s_waitcnt lgkmcnt(0)\n\ts_barrier" ::: "memory");
#ifdef PROBE_TS
  if (tsw && threadIdx.x == 0) { const unsigned long long ts3_ = __builtin_amdgcn_s_memrealtime(); tsw[0] += (unsigned)(ts1_ - ts0_); tsw[1] += (unsigned)(ts2_ - ts1_); tsw[2] += (unsigned)(ts3_ - ts2_); tsw[3] += (unsigned)(NT - 1); tsw[4] += 1u; }
#endif
  #undef DMA_K
  #undef DMA_V
  #undef TM
  #undef CMASK
  #undef NVAL
  #undef START
  #undef RESC
  #undef ROT
}
#undef WAIT_BAR
}

namespace ret {
constexpr int KS_STR = 144, V_STR = 272;
constexpr int L_KS = 0, L_KH = 18432, L_VS = 36864, L_RT = 71680, L_GS = 90112, L_END = 122880;
typedef short v4i16_t __attribute__((ext_vector_type(4)));
__device__ __forceinline__ s16x4 vtr(LAS const char* p) { return __builtin_bit_cast(s16x4, __builtin_amdgcn_ds_read_tr16_b64_v4i16((LAS v4i16_t*)p)); }
__device__ __forceinline__ bf16x8 cat8(s16x4 a, s16x4 b) { return (bf16x8){a[0], a[1], a[2], a[3], b[0], b[1], b[2], b[3]}; }
__device__ __forceinline__ float red16(float v) {
    v += __builtin_bit_cast(float, __builtin_amdgcn_update_dpp(0, __builtin_bit_cast(int, v), 0xB1, 0xF, 0xF, true));
    v += __builtin_bit_cast(float, __builtin_amdgcn_update_dpp(0, __builtin_bit_cast(int, v), 0x4E, 0xF, 0xF, true));
    v += __builtin_bit_cast(float, __builtin_amdgcn_update_dpp(0, __builtin_bit_cast(int, v), 0x141, 0xF, 0xF, true));
    v += __builtin_bit_cast(float, __builtin_amdgcn_update_dpp(0, __builtin_bit_cast(int, v), 0x140, 0xF, 0xF, true));
    return v;
}

__device__ __forceinline__ void ret_state_unit(int b, int h, const bf16_t* PROJ, bf16_t* RST, LAS unsigned char* lds) {
    int tid_ = threadIdx.x; asm volatile("" : "+v"(tid_));
    const int tid = tid_, lane = tid & 63, c16 = lane & 15, g = lane >> 4; const int w = __builtin_amdgcn_readfirstlane(tid >> 6);
    const float log2g = log2f(1.0f - exp2f(-5.0f - (float)h));
    const float gC = exp2f(log2g * 128.0f);
    LAS unsigned char* Kh = lds + L_KH; LAS unsigned char* Vs = lds + L_VS;
    f32x4 Racc[4];
#pragma unroll
    for (int dt = 0; dt < 4; ++dt) Racc[dt] = (f32x4){0.f, 0.f, 0.f, 0.f};
    const size_t tokb = (size_t)b * SEQ;
    u32x4 kreg[2], vreg[4];
    const int krow0 = tid >> 3, kcc = tid & 7, vrow0 = tid >> 4, vcc = tid & 15;
#define RS_LOAD(c) do { const bf16_t* base = PROJ + (tokb + (size_t)(c) * 128) * DIN; \
        _Pragma("unroll") for (int i = 0; i < 2; ++i) kreg[i] = *(const u32x4*)(base + (size_t)(krow0 + 64 * i) * DIN + PC_RK + 64 * h + 8 * kcc); \
        _Pragma("unroll") for (int i = 0; i < 4; ++i) vreg[i] = *(const u32x4*)(base + (size_t)(vrow0 + 32 * i) * DIN + PC_RV + 128 * h + 8 * vcc); } while (0)
    RS_LOAD(0);
    const int trq = c16 >> 2, trp = c16 & 3;
    LAS const char* vtb = (LAS const char*)Vs + (4 * g + trq) * V_STR + trp * 8;
    LAS const char* khb = (LAS const char*)Kh + (4 * g + trq) * KS_STR + trp * 8;
    bf16_t* rst = RST + ((size_t)(b * 4 + h) * 16) * (128 * 64) + (size_t)(16 * w + c16) * 64 + 4 * g;
    for (int c = 0; c < 16; ++c) {
#pragma unroll
        for (int i = 0; i < 2; ++i) { const int row = krow0 + 64 * i; const float z = __builtin_amdgcn_exp2f(log2g * (float)(127 - row)); u32x4 sc;
#pragma unroll
            for (int j = 0; j < 4; ++j) { const unsigned u = kreg[i][j]; sc[j] = pk2(bf2f((unsigned short)(u & 0xffffu)) * z, bf2f((unsigned short)(u >> 16)) * z); }
            *(LAS u32x4*)(Kh + row * KS_STR + kcc * 16) = sc; }
#pragma unroll
        for (int i = 0; i < 4; ++i) { const int row = vrow0 + 32 * i; *(LAS u32x4*)(Vs + row * V_STR + vcc * 16) = vreg[i]; }
        LDS_BARRIER();
        if (c + 1 < 16) RS_LOAD(c + 1);
#pragma unroll
        for (int dt = 0; dt < 4; ++dt) { u32x2 o2; o2.x = pk2(Racc[dt][0], Racc[dt][1]); o2.y = pk2(Racc[dt][2], Racc[dt][3]);
            *(u32x2*)(rst + (size_t)c * (128 * 64) + 16 * dt) = o2; }
#pragma unroll
        for (int dt = 0; dt < 4; ++dt) Racc[dt] = Racc[dt] * gC;
#pragma unroll 1
        for (int ks = 0; ks < 4; ++ks) { LAS const char* vp = vtb + ks * (32 * V_STR) + w * 32;
            const bf16x8 vf = cat8(vtr(vp), vtr(vp + 16 * V_STR));
            LAS const char* kp = khb + ks * (32 * KS_STR);
#pragma unroll
            for (int dt = 0; dt < 4; ++dt) { const bf16x8 kfm = cat8(vtr(kp + dt * 32), vtr(kp + dt * 32 + 16 * KS_STR));
                Racc[dt] = __builtin_amdgcn_mfma_f32_16x16x32_bf16(kfm, vf, Racc[dt], 0, 0, 0); } }
        LDS_BARRIER();
    }
#undef RS_LOAD
}

__device__ __forceinline__ void ret_out_unit(int b, int h, int c, const bf16_t* PROJ, const bf16_t* RST, const float* rnw, bf16_t* MIX, LAS unsigned char* lds, volatile LAS unsigned* nidp, unsigned nid) {
    int tid_ = threadIdx.x; asm volatile("" : "+v"(tid_));
    const int tid = tid_, lane = tid & 63, c16 = lane & 15, g = lane >> 4; const int w = __builtin_amdgcn_readfirstlane(tid >> 6);
    const float log2g = log2f(1.0f - exp2f(-5.0f - (float)h));
    LAS unsigned char* Ks = lds + L_KS; LAS unsigned char* Vs = lds + L_VS; LAS unsigned char* Rt = lds + L_RT; LAS unsigned char* Gs = lds + L_GS;
    LAS float* Wn = (LAS float*)(lds + L_END);
    const size_t tok0c = (size_t)b * SEQ + (size_t)c * 128;
    const bf16_t* base = PROJ + tok0c * DIN;
    { const bf16_t* gb = base + PC_RG + 128 * h;
#pragma unroll
        for (int i = 0; i < 4; ++i) { const int q = tid + 512 * i;
            __builtin_amdgcn_global_load_lds((const unsigned*)(gb + (size_t)(q >> 4) * DIN + 8 * (q & 15)), (LAS unsigned*)(Gs + (size_t)(w * 64 + 512 * i) * 16), 16, 0, 0); } }
    u32x4 kreg[2], vreg[4], rreg[2]; bf16x8 qf[2];
    const int krow0 = tid >> 3, kcc = tid & 7, vrow0 = tid >> 4, vcc = tid & 15;
    const bf16_t* rsrc = RST + ((size_t)(b * 4 + h) * 16 + c) * (128 * 64);
#pragma unroll
    for (int i = 0; i < 2; ++i) kreg[i] = *(const u32x4*)(base + (size_t)(krow0 + 64 * i) * DIN + PC_RK + 64 * h + 8 * kcc);
#pragma unroll
    for (int i = 0; i < 4; ++i) vreg[i] = *(const u32x4*)(base + (size_t)(vrow0 + 32 * i) * DIN + PC_RV + 128 * h + 8 * vcc);
#pragma unroll
    for (int i = 0; i < 2; ++i) rreg[i] = *(const u32x4*)(rsrc + (size_t)(krow0 + 64 * i) * 64 + 8 * kcc);
#pragma unroll
    for (int k2 = 0; k2 < 2; ++k2) qf[k2] = *(const bf16x8*)(base + (size_t)(16 * w + c16) * DIN + PC_RQ + 64 * h + 32 * k2 + 8 * g);
    if (tid < 128) Wn[tid] = rnw[128 * h + tid];
#pragma unroll
    for (int i = 0; i < 2; ++i) { const int row = krow0 + 64 * i; *(LAS u32x4*)(Ks + row * KS_STR + kcc * 16) = kreg[i]; *(LAS u32x4*)(Rt + row * KS_STR + kcc * 16) = rreg[i]; }
#pragma unroll
    for (int i = 0; i < 4; ++i) { const int row = vrow0 + 32 * i; *(LAS u32x4*)(Vs + row * V_STR + vcc * 16) = vreg[i]; }
    __syncthreads();
    if (tid == 0) *nidp = nid;
    f32x4 oi[8], oc[8];
#pragma unroll
    for (int et = 0; et < 8; ++et) { oi[et] = (f32x4){0.f, 0.f, 0.f, 0.f}; oc[et] = (f32x4){0.f, 0.f, 0.f, 0.f}; }
    const int trq = c16 >> 2, trp = c16 & 3;
    const int nks = (w >> 1) + 1;
    LAS const char* ksb = (LAS const char*)Ks + c16 * KS_STR + g * 16;
    LAS const char* vtb = (LAS const char*)Vs + (4 * g + trq) * V_STR + trp * 8;
    LAS const char* rtb = (LAS const char*)Rt + c16 * KS_STR + g * 16;
#pragma unroll 1
    for (int ks = 0; ks < nks; ++ks) {
        u32x4 pw;
#pragma unroll
        for (int half = 0; half < 2; ++half) { const int mt = 2 * ks + half; f32x4 st = (f32x4){0.f, 0.f, 0.f, 0.f};
            if (mt <= w) {
#pragma unroll
                for (int k2 = 0; k2 < 2; ++k2) { const bf16x8 ka = *(const LAS bf16x8*)(ksb + mt * (16 * KS_STR) + k2 * 64);
                    st = __builtin_amdgcn_mfma_f32_16x16x32_bf16(ka, qf[k2], st, 0, 0, 0); } }
            float pv_[4];
#pragma unroll
            for (int r = 0; r < 4; ++r) { const int diff = (16 * w + c16) - (16 * mt + 4 * g + r); pv_[r] = diff >= 0 ? st[r] * __builtin_amdgcn_exp2f(log2g * (float)diff) : 0.f; }
            pw[2 * half] = pk2(pv_[0], pv_[1]); pw[2 * half + 1] = pk2(pv_[2], pv_[3]); }
        const bf16x8 pf = __builtin_bit_cast(bf16x8, pw);
        LAS const char* vp = vtb + ks * (32 * V_STR);
#pragma unroll
        for (int et = 0; et < 8; ++et) { const bf16x8 vf = cat8(vtr(vp + et * 32), vtr(vp + et * 32 + 16 * V_STR));
            oi[et] = __builtin_amdgcn_mfma_f32_16x16x32_bf16(pf, vf, oi[et], 0, 0, 0); }
    }
#pragma unroll
    for (int k2 = 0; k2 < 2; ++k2)
#pragma unroll
        for (int et = 0; et < 8; ++et) { const bf16x8 rf = *(const LAS bf16x8*)(rtb + et * (16 * KS_STR) + k2 * 64);
            oc[et] = __builtin_amdgcn_mfma_f32_16x16x32_bf16(qf[k2], rf, oc[et], 0, 0, 0); }
    {
        float s1[4], s2[4], xi[4];
#pragma unroll
        for (int r = 0; r < 4; ++r) { xi[r] = __builtin_amdgcn_exp2f(log2g * (float)(16 * w + 4 * g + r + 1)); s1[r] = 0.f; s2[r] = 0.f; }
#pragma unroll
        for (int et = 0; et < 8; ++et)
#pragma unroll
            for (int r = 0; r < 4; ++r) { const float x = oi[et][r] + xi[r] * oc[et][r]; oi[et][r] = x; s1[r] += x; s2[r] += x * x; }
#pragma unroll
        for (int r = 0; r < 4; ++r) { s1[r] = red16(s1[r]); s2[r] = red16(s2[r]);
            const float mu = s1[r] * (1.f / 128.f); const float var = fmaxf(s2[r] * (1.f / 128.f) - mu * mu, 0.f); s1[r] = mu; s2[r] = 1.0f / sqrtf(var + GN_EPS); }
        LAS unsigned short* gl = (LAS unsigned short*)Gs + (16 * w + 4 * g) * 128 + c16;
        unsigned short gq[8][4];
#pragma unroll
        for (int et = 0; et < 8; ++et)
#pragma unroll
            for (int r = 0; r < 4; ++r) gq[et][r] = gl[r * 128 + 16 * et];
        LDS_WAIT(); asm volatile("" ::: "memory");
#pragma unroll
        for (int et = 0; et < 8; ++et) { const float wgt = Wn[16 * et + c16];
#pragma unroll
            for (int r = 0; r < 4; ++r) { const float gv = bf2f(gq[et][r]);
                const float sg = gv * __builtin_amdgcn_rcpf(1.f + __builtin_amdgcn_exp2f(-gv * 1.4426950408889634f));
                oi[et][r] = (oi[et][r] - s1[r]) * s2[r] * wgt * sg; } }
#pragma unroll
        for (int et = 0; et < 8; ++et)
#pragma unroll
            for (int r = 0; r < 4; ++r) gl[r * 128 + 16 * et] = (unsigned short)f2bf(oi[et][r]);
    }
    LDS_BARRIER();
    { bf16_t* ob = MIX + tok0c * DM + 128 * h;
#pragma unroll
        for (int i = 0; i < 4; ++i) { const int q = tid + 512 * i; *(u32x4*)(ob + (size_t)(q >> 4) * DM + 8 * (q & 15)) = *(const LAS u32x4*)(Gs + q * 16); } }
    LDS_BARRIER();
}
}

#define XB_TMO      128
#define XB_XCNT(j)  (256  + 64 * (j))
#define XB_XSUB(j)  (1280 + 64 * (j))
#define XB_XGEN(j)  (2304 + 64 * (j))
#define XB_TOP      3328
#define XB_TOPGEN   3392
#define XCD_BAR_WORDS 3456
#define XB_SPIN_CAP (1u << 18)
__device__ __forceinline__ unsigned xb_ld(unsigned* p)              { return __hip_atomic_load(p, __ATOMIC_RELAXED, __HIP_MEMORY_SCOPE_AGENT); }
__device__ __forceinline__ unsigned xb_add(unsigned* p, unsigned v) { return __hip_atomic_fetch_add(p, v, __ATOMIC_RELAXED, __HIP_MEMORY_SCOPE_AGENT); }
__device__ __forceinline__ unsigned xb_xcc_id() { return (unsigned)__builtin_amdgcn_s_getreg((3 << 11) | 20) & 0xFu; }
#define XB_SPIN(cond, bar) do { unsigned _sp = 0; while (cond) { __builtin_amdgcn_s_sleep(1); \
    if ((++_sp & 255u) == 0u) { if (xb_ld(&(bar)[XB_TMO])) break; if (_sp > XB_SPIN_CAP) { atomicAdd(&(bar)[XB_TMO], 1u); break; } } } } while (0)
struct XcdBarrier { unsigned* bar; unsigned x; volatile LAS unsigned* st; };
__device__ __forceinline__ XcdBarrier xcd_barrier_post(unsigned* bar, volatile LAS unsigned* st) {
    XcdBarrier b; b.bar = bar; b.x = xb_xcc_id(); b.st = st;
    if (threadIdx.x == 0) (void)xb_add(&bar[XB_XCNT(b.x)], 1u);
    return b;
}
__device__ __forceinline__ void xcd_barrier_complete(unsigned* bar, unsigned x, unsigned& nloc, unsigned& nx) {
    const unsigned G = gridDim.x * gridDim.y * gridDim.z;
    unsigned sum, cnt, mine, sp = 0u;
    for (;;) {
        sum = 0u; cnt = 0u; mine = 0u;
#pragma unroll
        for (unsigned j = 0; j < 16; ++j) { const unsigned c = xb_ld(&bar[XB_XCNT(j)]); sum += c; cnt += (c > 0u) ? 1u : 0u; mine = (j == x) ? c : mine; }
        if (sum == G) break;
        __builtin_amdgcn_s_sleep(1);
        if ((++sp & 255u) == 0u) { if (xb_ld(&bar[XB_TMO])) break; if (sp > XB_SPIN_CAP) { atomicAdd(&bar[XB_TMO], 1u); break; } }
    }
    nloc = mine > 0u ? mine : 1u; nx = cnt > 0u ? cnt : 1u;
}
__device__ __forceinline__ void xcd_barrier(const XcdBarrier& b) {
    asm volatile("s_waitcnt vmcnt(0)" ::: "memory");
    __syncthreads();
    if (threadIdx.x == 0) {
        unsigned* bar = b.bar;
        __builtin_amdgcn_s_waitcnt(0);
        unsigned nloc = b.st[0], nx = b.st[1];
        if (nloc == 0u) { xcd_barrier_complete(bar, b.x, nloc, nx); b.st[0] = nloc; b.st[1] = nx; }
        const unsigned old = xb_add(&bar[XB_XSUB(b.x)], 1u);
        const unsigned gen = old / nloc;
        if (old + 1u == (gen + 1u) * nloc) {
            __builtin_amdgcn_fence(__ATOMIC_RELEASE, "agent");
            asm volatile("s_waitcnt vmcnt(0)" ::: "memory");
            const unsigned og = xb_add(&bar[XB_TOP], 1u);
            const unsigned tg = og / nx;
            if (og + 1u == (tg + 1u) * nx) xb_add(&bar[XB_TOPGEN], 1u);
            else XB_SPIN(xb_ld(&bar[XB_TOPGEN]) == tg, bar);
            __builtin_amdgcn_fence(__ATOMIC_ACQUIRE, "agent");
            xb_add(&bar[XB_XGEN(b.x)], 1u);
            asm volatile("s_waitcnt vmcnt(0)" ::: "memory");
        } else {
            XB_SPIN(xb_ld(&bar[XB_XGEN(b.x)]) == gen, bar);
            __builtin_amdgcn_fence(__ATOMIC_ACQUIRE, "agent");
            asm volatile("s_waitcnt vmcnt(0)" ::: "memory");
        }
    }
    __syncthreads();
}

__device__ __forceinline__ float wave_sum(float v) {
#pragma unroll
    for (int o = 1; o < 64; o <<= 1) v += __shfl_xor(v, o);
    return v;
}
__device__ __forceinline__ int dst_row(int mode, int n) {
    if (mode == 1) {
        if (n < 512) { const int base = n & ~255, j = n & 255, hh = j >> 6, d = j & 63; return base + ((d < 32) ? (32 * hh + d) : (128 + 32 * hh + (d - 32))); }
        if (n >= PC_MQ && n < PC_MV) { const int d = n & 63; if (d < 16) { const int nn = d >> 3, fq = (d >> 2) & 1, e = d & 3; return (n & ~63) + 8 * fq + 4 * nn + e; } }
        return n;
    }
    if (mode == 2) { return (n < 1024) ? (256 * (n >> 7) + (n & 127)) : (256 * ((n - 1024) >> 7) + 128 + ((n - 1024) & 127)); }
    return n;
}
__device__ __forceinline__ void p0_load(f32x4 (&v)[8], const float* W, int N, int item, int lane) {
    const int nblk = N / 32, kb = item / nblk, nb = item % nblk, k0 = 64 * kb, n0 = 32 * nb;
#pragma unroll
    for (int j = 0; j < 8; ++j) v[j] = __builtin_nontemporal_load((const f32x4*)(W + (size_t)(k0 + 8 * j + (lane >> 3)) * N + n0 + 4 * (lane & 7)));
}
template <bool FP8_>
__device__ __forceinline__ void p0_finish(const f32x4 (&v)[8], int K, int N, void* WTv, int mode, float scale, LAS float* scr, int item, int lane) {
    const int nblk = N / 32, kb = item / nblk, nb = item % nblk, k0 = 64 * kb, n0 = 32 * nb;
#pragma unroll
    for (int j = 0; j < 8; ++j) { LAS float* d = scr + (8 * j + (lane >> 3)) * 33 + 4 * (lane & 7); d[0] = v[j].x * scale; d[1] = v[j].y * scale; d[2] = v[j].z * scale; d[3] = v[j].w * scale; }
    LDS_WAIT(); asm volatile("" ::: "memory");
    const int c = lane & 7;
#pragma unroll
    for (int j = 0; j < 4; ++j) { const int n = (lane >> 3) + 8 * j; const LAS float* s = scr + (8 * c) * 33 + n;
        const f32x4 a = (f32x4){s[0 * 33], s[1 * 33], s[2 * 33], s[3 * 33]}, b = (f32x4){s[4 * 33], s[5 * 33], s[6 * 33], s[7 * 33]};
        if constexpr (FP8_) *(GAS u32x2*)((unsigned char*)WTv + (size_t)dst_row(mode, n0 + n) * K + k0 + 8 * c) = pack8_fp8(a, b);
        else { u32x4 o; o.x = pk2(a[0], a[1]); o.y = pk2(a[2], a[3]); o.z = pk2(b[0], b[1]); o.w = pk2(b[2], b[3]); *(GAS u32x4*)((bf16_t*)WTv + (size_t)dst_row(mode, n0 + n) * K + k0 + 8 * c) = o; } }
    LDS_WAIT(); asm volatile("" ::: "memory");
}
__device__ __forceinline__ void p0_finish6(const f32x4 (&v)[8], int N, unsigned char* W6, int mode, float scale, LAS float* scr, int item, int lane) {
    const int nblk = N / 32, kb = item / nblk, nb = item % nblk, k0 = 64 * kb, n0 = 32 * nb;
#pragma unroll
    for (int j = 0; j < 8; ++j) { LAS float* d = scr + (8 * j + (lane >> 3)) * 33 + 4 * (lane & 7); d[0] = v[j].x * scale; d[1] = v[j].y * scale; d[2] = v[j].z * scale; d[3] = v[j].w * scale; }
    LDS_WAIT(); asm volatile("" ::: "memory");
    const int nl = lane & 31, blk = lane >> 5; const LAS float* s = scr + (32 * blk) * 33 + nl;
    v32h hv;
#pragma unroll
    for (int i = 0; i < 32; ++i) hv[i] = (_Float16)s[i * 33];
    const v6u dd = __builtin_amdgcn_cvt_scalef32_pk32_fp6_f16(hv, 1.0f);
    const int row = dst_row(mode, n0 + nl), pn = row >> 8, h = (row >> 7) & 1, s128 = row & 127, sg_ = s128 & 31, rr = (s128 & ~31) + 16 * ((sg_ >> 2) & 1) + 4 * (sg_ >> 3) + (sg_ & 3);
    const int kt = k0 >> 7, fq = ((k0 >> 6) & 1) * 2 + blk;
    unsigned char* img = W6 + (size_t)(pn * 8 + kt) * 24576 + h * 12288;
    const unsigned d0 = dd[0], d1 = dd[1], d2 = dd[2], d3 = dd[3], d4 = dd[4], d5 = dd[5];
    const bool n1 = (rr >> 4) & 1;
    u32x4 o16; o16.x = n1 ? d2 : d0; o16.y = n1 ? d3 : d1; o16.z = n1 ? d4 : d2; o16.w = n1 ? d5 : d3;
    u32x2 o8; o8.x = n1 ? d0 : d4; o8.y = n1 ? d1 : d5;
    *(GAS u32x4*)(img + (rr * 4 + fq) * 16) = o16; *(GAS u32x2*)(img + 8192 + ((((rr >> 5) * 16 + (rr & 15)) * 4 + fq) * 16) + (n1 ? 8 : 0)) = o8;
    LDS_WAIT(); asm volatile("" ::: "memory");
}
template <bool FP8_>
__device__ __forceinline__ void p0_item(const float* W, int K, int N, void* WTv, int mode, float scale, LAS float* scr, int item, int lane) {
    f32x4 v[8]; p0_load(v, W, N, item, lane); p0_finish<FP8_>(v, K, N, WTv, mode, scale, scr, item, lane);
}
__device__ __forceinline__ void sincos_acc(float af, float& sn, float& cs) {
    const double a = (double)af; const double k = rint(a * 0.15915494309189535); double r = a - k * 6.283185307179586;
    double sgn = 1.0; if (r > 1.5707963267948966) { r = 3.141592653589793 - r; sgn = -1.0; } else if (r < -1.5707963267948966) { r = -3.141592653589793 - r; sgn = -1.0; }
    const double r2 = r * r;
    double s = -1.0 / 355687428096000.0; s = s * r2 + 1.0 / 1307674368000.0; s = s * r2 - 1.0 / 6227020800.0; s = s * r2 + 1.0 / 39916800.0; s = s * r2 - 1.0 / 362880.0; s = s * r2 + 1.0 / 5040.0; s = s * r2 - 1.0 / 120.0; s = s * r2 + 1.0 / 6.0; s = r - r * r2 * s;
    double c = 1.0 / 20922789888000.0; c = c * r2 - 1.0 / 87178291200.0; c = c * r2 + 1.0 / 479001600.0; c = c * r2 - 1.0 / 3628800.0; c = c * r2 + 1.0 / 40320.0; c = c * r2 - 1.0 / 720.0; c = c * r2 + 1.0 / 24.0; c = c * r2 - 0.5; c = 1.0 + c * r2;
    sn = (float)s; cs = (float)(sgn * c);
}


#ifdef PROBE_CHECK
__device__ __forceinline__ void probe_check(int c, const float* x, const float* nw1, const float* w_in, const float* rnw, const bf16_t* MIX, float* SC, gu32* res, LAS unsigned char* lds) {
    const int tid = threadIdx.x;
    const int tt[8] = {2047, 1300, 777, 300, 1999, 1024, 255, 1535};
    const int b = (5 * c + 3) & 31, t = tt[c & 7], hr = c & 3, hm = (3 * c + 1) & 7, blk = t >> 8;
    LAS float* L = (LAS float*)lds;
    const size_t tok0 = (size_t)b * SEQ;
    for (int s_ = tid; s_ <= t; s_ += 512) {
        const float* xr = x + (tok0 + s_) * DM; float ss = 0.f;
        for (int k = 0; k < DM; ++k) ss += xr[k] * xr[k];
        const float rstd = 1.0f / sqrtf(ss * (1.f / DM) + RMS_EPS);
        for (int cc = 0; cc < 20; ++cc) {
            const int cb = cc < 4 ? 256 + 64 * hr + 16 * cc : cc < 12 ? 512 + 128 * hr + 16 * (cc - 4) : cc < 16 ? 2048 + 64 * hm + 16 * (cc - 12) : 2560 + 64 * hm + 16 * (cc - 16);
            float acc[16];
#pragma unroll
            for (int j = 0; j < 16; ++j) acc[j] = 0.f;
            for (int k = 0; k < DM; ++k) { const float hv = xr[k] * rstd * nw1[k]; const float* wr_ = w_in + (size_t)k * DIN + cb;
#pragma unroll
                for (int j = 0; j < 16; ++j) acc[j] += hv * wr_[j]; }
#pragma unroll
            for (int j = 0; j < 16; ++j) SC[(size_t)s_ * 320 + 16 * cc + j] = acc[j];
        }
        float* kr = SC + (size_t)s_ * 320;
        for (int i = 0; i < 32; ++i) { const float inv = (float)exp2(-(double)i / 32.0 * 13.287712379549449); float sn, cs; sincos_acc((float)s_ * inv, sn, cs);
            const float a = kr[i], bb = kr[32 + i]; kr[i] = (a * cs - bb * sn) * 0.125f; kr[32 + i] = (a * sn + bb * cs) * 0.125f; }
        float* km = SC + (size_t)s_ * 320 + 192;
        for (int i = 0; i < 8; ++i) { const float inv = (float)exp2(-(double)i / 8.0 * 18.931568569324174); float sn, cs; sincos_acc((float)s_ * inv, sn, cs);
            const float a = km[i], bb = km[8 + i]; km[i] = a * cs - bb * sn; km[8 + i] = a * sn + bb * cs; }
    }
    { const float* xr = x + (tok0 + t) * DM; float ss = 0.f; for (int k = 0; k < DM; ++k) ss += xr[k] * xr[k]; const float rstd = 1.0f / sqrtf(ss * (1.f / DM) + RMS_EPS);
      for (int k = tid; k < DM; k += 512) L[k] = xr[k] * rstd * nw1[k]; }
    __threadfence(); __syncthreads();
    if (tid < 256) { const int col = tid < 64 ? 64 * hr + tid : tid < 128 ? 1536 + 64 * hm + (tid - 64) : 1024 + 128 * hr + (tid - 128); float a = 0.f;
        for (int k = 0; k < DM; ++k) a += L[k] * w_in[(size_t)k * DIN + col];
        L[1024 + tid] = a; }
    __syncthreads();
    if (tid < 32) { const float inv = (float)exp2(-(double)tid / 32.0 * 13.287712379549449); float sn, cs; sincos_acc((float)t * inv, sn, cs);
        const float a = L[1024 + tid], bb = L[1024 + 32 + tid]; L[1024 + tid] = a * cs - bb * sn; L[1024 + 32 + tid] = a * sn + bb * cs; }
    if (tid >= 64 && tid < 72) { const int i = tid - 64; const float inv = (float)exp2(-(double)i / 8.0 * 18.931568569324174); float sn, cs; sincos_acc((float)t * inv, sn, cs);
        const float a = L[1024 + 64 + i], bb = L[1024 + 64 + 8 + i]; L[1024 + 64 + i] = a * cs - bb * sn; L[1024 + 64 + 8 + i] = a * sn + bb * cs; }
    __syncthreads();
    const float lg2 = log2f(1.0f - exp2f(-5.0f - (float)hr));
    for (int s_ = tid; s_ < SEQ; s_ += 512) { float w_ = 0.f; if (s_ <= t) { const float* kr = SC + (size_t)s_ * 320; float d = 0.f; for (int i = 0; i < 64; ++i) d += L[1024 + i] * kr[i]; w_ = d * exp2f(lg2 * (float)(t - s_)); } L[2048 + s_] = w_; }
    __syncthreads();
    if (tid < 128) { float a = 0.f; for (int s_ = 0; s_ <= t; ++s_) a += L[2048 + s_] * SC[(size_t)s_ * 320 + 64 + tid]; L[4096 + tid] = a; }
    __syncthreads();
    if (tid == 0) { float mu = 0.f; for (int e = 0; e < 128; ++e) mu += L[4096 + e]; mu *= (1.f / 128.f); float var = 0.f; for (int e = 0; e < 128; ++e) { const float d = L[4096 + e] - mu; var += d * d; } var *= (1.f / 128.f); L[4300] = mu; L[4301] = 1.0f / sqrtf(var + GN_EPS); }
    __syncthreads();
    if (tid < 128) { const float gv = L[1024 + 128 + tid]; const float ref = (L[4096 + tid] - L[4300]) * L[4301] * rnw[128 * hr + tid] * (gv / (1.f + expf(-gv)));
        const float got = bf2f(MIX[(tok0 + t) * DM + 128 * hr + tid]); L[4400 + tid] = fabsf(ref - got); L[4600 + tid] = fabsf(ref); }
    __syncthreads();
    if (tid == 0) { float me = 0.f, mr = 1e-20f; for (int e = 0; e < 128; ++e) { me = fmaxf(me, L[4400 + e]); mr = fmaxf(mr, L[4600 + e]); } atomicMax((unsigned*)res, __float_as_uint(me / mr)); }
    __syncthreads();
    for (int i = tid; i < blk * 64; i += 512) { const int j = i >> 6, d = i & 63; float a = 0.f; for (int s_ = 256 * j; s_ < 256 * j + 256; ++s_) a += SC[(size_t)s_ * 320 + 192 + d]; L[4800 + i] = a * (1.f / 256.f); }
    __syncthreads();
    if (tid < 8) { float gsum = -INFINITY; if (tid < blk) { gsum = 0.f; for (int d = 0; d < 64; ++d) gsum += L[1024 + 64 + d] * L[4800 + tid * 64 + d]; } L[5400 + tid] = gsum; }
    __syncthreads();
    if (tid == 0) { unsigned sel = 0u; const int ns = blk < 3 ? blk : 3; float g8[8]; for (int j = 0; j < 8; ++j) g8[j] = L[5400 + j];
        for (int r = 0; r < ns; ++r) { int bi = -1; float bv = -INFINITY; for (int j = 0; j < blk; ++j) if (!((sel >> j) & 1u) && g8[j] > bv) { bv = g8[j]; bi = j; } if (bi >= 0) sel |= 1u << bi; }
        L[5420] = __uint_as_float(sel); }
    __syncthreads();
    const unsigned selm = __float_as_uint(L[5420]);
    for (int s_ = tid; s_ < SEQ; s_ += 512) { float lgt = -INFINITY; const int sb = s_ >> 8;
        if (s_ <= t && (sb == blk || ((selm >> sb) & 1u))) { const float* km = SC + (size_t)s_ * 320 + 192; float d = 0.f; for (int i = 0; i < 64; ++i) d += L[1024 + 64 + i] * km[i]; lgt = d * 0.125f; }
        L[2048 + s_] = lgt; }
    __syncthreads();
    if (tid == 0) { float mx = -INFINITY; for (int s_ = 0; s_ <= t; ++s_) mx = fmaxf(mx, L[2048 + s_]); L[5430] = mx; }
    __syncthreads();
    for (int s_ = tid; s_ < SEQ; s_ += 512) L[2048 + s_] = (s_ <= t) ? expf(L[2048 + s_] - L[5430]) : 0.f;
    __syncthreads();
    if (tid == 0) { float sm = 0.f; for (int s_ = 0; s_ <= t; ++s_) sm += L[2048 + s_]; L[5431] = sm; }
    __syncthreads();
    if (tid < 64) { float a = 0.f; for (int s_ = 0; s_ <= t; ++s_) a += L[2048 + s_] * SC[(size_t)s_ * 320 + 256 + tid]; const float ref = a / L[5431];
        const float got = bf2f(MIX[(tok0 + t) * DM + 512 + 64 * hm + tid]); L[4400 + tid] = fabsf(ref - got); L[4600 + tid] = fabsf(ref); }
    __syncthreads();
    if (tid == 0) { float me = 0.f, mr = 1e-20f; for (int e = 0; e < 64; ++e) { me = fmaxf(me, L[4400 + e]); mr = fmaxf(mr, L[4600 + e]); } atomicMax((unsigned*)res + 64, __float_as_uint(me / mr)); }
    __syncthreads();
}
#endif

struct Args { const float* in[13]; float* out; unsigned char* ws; int ph_lo, ph_hi, li, pad; };
constexpr int N_PHASES = 8;

__global__ void __launch_bounds__(NWAVES * 64, 2) fwd_mega(Args args) {
    extern __shared__ __attribute__((aligned(16))) unsigned char lds_raw[];
    LAS unsigned char* lds = (LAS unsigned char*)lds_raw;
    volatile LAS unsigned* MISC = (volatile LAS unsigned*)(lds + MISC_OFF);
    LAS int* LTAB = (LAS int*)(lds + LTAB_OFF);
#define PHASE_IDS() int tid_o_ = threadIdx.x; asm volatile("" : "+v"(tid_o_)); const int tid = tid_o_, lane = tid & 63, wave = __builtin_amdgcn_readfirstlane(tid >> 6); (void)lane; (void)wave
    const int G = gridDim.x, bx = blockIdx.x; const int vcu = (G % 8 == 0) ? (bx % 8) * (G / 8) + bx / 8 : bx;
    unsigned char* ws = args.ws;
    gu32* ctl = (gu32*)(ws + WS_CTL);
    const float* x = args.in[0]; const float* norm1_w = args.in[1]; const float* w_in = args.in[2]; const float* ret_norm_w = args.in[3]; const float* w_out = args.in[4];
    const float* norm2_w = args.in[5]; const float* w_router = args.in[6]; const float* b_router = args.in[7]; const float* w1 = args.in[8]; const float* b1 = args.in[9];
    const float* w2 = args.in[10]; const float* b2 = args.in[11]; const float* final_w = args.in[12];
    float* out = args.out;
    float* rope = (float*)(ws + WS_ROPE); float* rc = rope; float* rs = rope + SEQ * 32; float* mc = rope + 2 * SEQ * 32; float* ms = mc + SEQ * 8;
    float* ksum = (float*)(ws + WS_KSUM); float* rstd1 = (float*)(ws + WS_RSTD); float* inw1 = (float*)(ws + WS_RSTD + 262144);
    bf16_t* wrf = (bf16_t*)(ws + WS_WRF); float* srstd = (float*)(ws + WS_SRSTD); float* sgate = (float*)(ws + WS_SGATE); int* slot = (int*)(ws + WS_SLOT);
    bf16_t* WinT = (bf16_t*)(ws + WS_WIN); bf16_t* WoutT = (bf16_t*)(ws + WS_WOUT); unsigned char* W2T = ws + WS_W2; unsigned char* W1T = ws + WS_W1;
    bf16_t* PROJ = (bf16_t*)(ws + WS_PROJ); bf16_t* MIX = (bf16_t*)(ws + WS_MIX); unsigned char* ACT = ws + WS_ACT; bf16_t* XN = (bf16_t*)(ws + WS_XN); unsigned char* H2q = ws + WS_H2Q; bf16_t* DELTA = (bf16_t*)(ws + WS_DELTA); unsigned char* Y4 = ws + WS_Y4; bf16_t* RST = (bf16_t*)(ws + WS_RST);

    { PHASE_IDS(); for (int u = tid; u < (LDS_BYTES - LDSCTL_OFF) / 4; u += NWAVES * 64) ((LAS unsigned*)(lds + LDSCTL_OFF))[u] = 0u; }
    __syncthreads();
    const bool use_bar = (MK_N_LAUNCHES != N_PHASES);
    XcdBarrier bar; bar.bar = (unsigned*)(ctl + CW_BAR) + args.li * XCD_BAR_WORDS; bar.x = 0; bar.st = nullptr;
    if (use_bar) bar = xcd_barrier_post((unsigned*)(ctl + CW_BAR) + args.li * XCD_BAR_WORDS, MISC + 8);
    const int lo = args.ph_lo, hi = args.ph_hi;
#ifndef PHASE_MASK
#define PHASE_MASK 0xff
#endif
#ifndef PROBE_DUP
#define PROBE_DUP -1
#endif
#define NREP(k) ((PROBE_DUP) == (k) ? 2 : 1)
#define IN(k) ((((PHASE_MASK) >> (k)) & 1) && lo <= (k) && (k) < hi)
#define SEAM(k) do { if (IN(k) && IN((k) + 1)) xcd_barrier(bar); } while (0)

    if (IN(0)) for (int rep_ = 0; rep_ < NREP(0); ++rep_) { PHASE_IDS();
        LAS float* scr = (LAS float*)(lds + wave * 16384);
        const int gw = vcu * NWAVES + wave, NGW = G * NWAVES;
        constexpr int I_IN = (DM / 64) * (DIN / 32), I_OUT = (DM / 64) * (DM / 32), I_1E = (DM / 64) * (2048 / 32), I_2E = (DM / 64) * (DM / 32);
        constexpr int I_1 = NEXP * I_1E, I_2 = NEXP * I_2E, NITEMS = I_IN + I_OUT + I_1 + I_2;
        {
            auto src_of = [&](int r, const float*& W, int& N, int& loc) { if (r < I_1) { const int e = r / I_1E; W = w1 + (size_t)e * DM * 2048; N = 2048; loc = r % I_1E; } else { r -= I_1; const int e = r / I_2E; W = w2 + (size_t)e * DM * DM; N = DM; loc = r % I_2E; } };
            f32x4 vc[8], vn[8]; int it = gw + (CONV_IN_P2 ? (I_1 + I_2) : 0);
            if (it < I_1 + I_2) { const float* W; int N, loc; src_of(it, W, N, loc); p0_load(vc, W, N, loc, lane); }
            for (; it < I_1 + I_2; it += NGW) {
                const int nx = it + NGW;
                if (nx < I_1 + I_2) { const float* W; int N, loc; src_of(nx, W, N, loc); p0_load(vn, W, N, loc, lane); }
                if (it < I_1) { const int e = it / I_1E; if constexpr (MOE_B6) p0_finish6(vc, 2048, W1T + (size_t)e * 2048 * 768, 2, 64.f, scr, it % I_1E, lane); else p0_finish<true>(vc, DM, 2048, W1T + (size_t)e * 2048 * DM, 2, 64.f, scr, it % I_1E, lane); }
                else { const int r = it - I_1, e = r / I_2E; if constexpr (MOE_B6) p0_finish6(vc, DM, W2T + (size_t)e * DM * 768, 0, 64.f, scr, r % I_2E, lane); else p0_finish<true>(vc, DM, DM, W2T + (size_t)e * DM * DM, 0, 64.f, scr, r % I_2E, lane); }
#pragma unroll
                for (int j = 0; j < 8; ++j) vc[j] = vn[j];
            }
        }
        for (int it = gw; it < I_IN + I_OUT; it += NGW) {
            if (it < I_IN) p0_item<false>(w_in, DM, DIN, WinT, 1, 1.f, scr, it, lane);
            else p0_item<false>(w_out, DM, DM, WoutT, 0, 1.f, scr, it - I_IN, lane);
        }
        {
            f32x4 wv[4];
#pragma unroll
            for (int j = 0; j < 4; ++j) wv[j] = *((const f32x4*)norm1_w + lane + 64 * j);
            for (int m = gw; m < NTOK; m += 2 * NGW) {
                const int m1 = (m + NGW < NTOK) ? m + NGW : m;
                const f32x4* xr0 = (const f32x4*)(x + (size_t)m * DM) + lane; const f32x4* xr1 = (const f32x4*)(x + (size_t)m1 * DM) + lane; f32x4 v0[4], v1[4]; float s0 = 0.f, s1 = 0.f;
#pragma unroll
                for (int j = 0; j < 4; ++j) { v0[j] = __builtin_nontemporal_load(xr0 + 64 * j); v1[j] = __builtin_nontemporal_load(xr1 + 64 * j); }
#pragma unroll
                for (int j = 0; j < 4; ++j) { s0 += (v0[j].x * v0[j].x + v0[j].y * v0[j].y) + (v0[j].z * v0[j].z + v0[j].w * v0[j].w); s1 += (v1[j].x * v1[j].x + v1[j].y * v1[j].y) + (v1[j].z * v1[j].z + v1[j].w * v1[j].w); }
                const float r0 = 1.0f / sqrtf(wave_sum(s0) * (1.f / DM) + RMS_EPS), r1 = 1.0f / sqrtf(wave_sum(s1) * (1.f / DM) + RMS_EPS);
                if (lane == 0) { rstd1[m] = r0; rstd1[m1] = r1; }
                unsigned long long* o0 = (unsigned long long*)(XN + (size_t)m * DM) + lane; unsigned long long* o1 = (unsigned long long*)(XN + (size_t)m1 * DM) + lane;
#pragma unroll
                for (int j = 0; j < 4; ++j) { const f32x4 y = v0[j] * r0 * wv[j]; o0[64 * j] = (unsigned long long)pk2(y.x, y.y) | ((unsigned long long)pk2(y.z, y.w) << 32); }
                if (m1 != m) {
#pragma unroll
                    for (int j = 0; j < 4; ++j) { const f32x4 y = v1[j] * r1 * wv[j]; o1[64 * j] = (unsigned long long)pk2(y.x, y.y) | ((unsigned long long)pk2(y.z, y.w) << 32); } }
            }
        }
        {
            const int gt = vcu * (NWAVES * 64) + tid, NGT = G * NWAVES * 64;
            for (int idx = gt; idx < SEQ * 32 + SEQ * 8; idx += NGT) {
                if (idx < SEQ * 32) { const int s = idx >> 5, i = idx & 31; const float inv = (float)exp2(-(double)i / 32.0 * 13.287712379549449);
                    float sn, cs; sincos_acc((float)s * inv, sn, cs); rc[idx] = cs; rs[idx] = sn; }
                else { const int j = idx - SEQ * 32, s = j >> 3, i = j & 7; const float inv = (float)exp2(-(double)i / 8.0 * 18.931568569324174);
                    float sn, cs; sincos_acc((float)s * inv, sn, cs); mc[j] = cs; ms[j] = sn; }
            }
            for (int idx = gt; idx < DM; idx += NGT) inw1[idx] = 1.0f / norm1_w[idx];
            for (int idx = gt; idx < 32 * 2 * 64 * 8; idx += NGT) {
                const int j = idx & 7, ln = (idx >> 3) & 63, eh = (idx >> 9) & 1, ks = idx >> 10;
                const int k = 32 * ks + 8 * (ln >> 4) + j, e = 16 * eh + (ln & 15);
                const float wv = w_router[(size_t)k * NEXP + e]; const unsigned hb = f2bf(wv); const float lof = wv - bf2f((unsigned short)hb);
                wrf[(((size_t)(ks * 2 + eh) * 2 + 0) * 64 + ln) * 8 + j] = (bf16_t)hb;
                wrf[(((size_t)(ks * 2 + eh) * 2 + 1) * 64 + ln) * 8 + j] = (bf16_t)f2bf(lof);
            }
        }
    }
    SEAM(0);

    if (IN(1)) for (int rep_ = 0; rep_ < NREP(1); ++rep_) {
        pg8::ProbInProj P; P.A = XN; P.Bt = WinT; P.nM = NTOK / 256; P.nN = DIN / 256; P.G = G; P.c = bx;
        P.PROJ = PROJ; P.rc = rc; P.rs = rs; P.mc = mc; P.ms = ms; P.ksum = ksum;
        pg8::gemm_phase<pg8::ProbInProj, true>(lds, P);
    }
    SEAM(1);

    if (IN(2)) for (int rep_ = 0; rep_ < NREP(2); ++rep_) { PHASE_IDS();
        constexpr int QLEN = 528 + (CONV_IN_P2 ? 128 : 0);
#ifdef PROBE_TS
        const unsigned long long tp0_ = __builtin_amdgcn_s_memrealtime();
#endif
        int q = (int)(xb_xcc_id() & 7u), tried = 0; unsigned ready_mask = 0u, steal = 0u;
        if (tid == 0) MISC[16] = __hip_atomic_fetch_add(ctl + CW_QUEUE + 64 * (8 * rep_ + q), 1u, RLX_AGENT);
        __syncthreads();
        int id = __builtin_amdgcn_readfirstlane((int)MISC[16]);
        for (;;) {
            if (id >= QLEN) {
                if (tried == 0) { __syncthreads();
                    if (tid == 0) { unsigned cnt[8]; unsigned m = 0u;
#pragma unroll
                        for (int k = 0; k < 8; ++k) cnt[k] = __hip_atomic_load(ctl + CW_QUEUE + 64 * (8 * rep_ + k), RLX_AGENT);
#pragma unroll
                        for (int k = 0; k < 8; ++k) m |= (cnt[k] < (unsigned)QLEN ? 1u : 0u) << k;
                        MISC[18] = m; }
                    __syncthreads(); steal = MISC[18]; }
                ++tried; int nq = -1;
                for (int k = 1; k < 8; ++k) { const int qq = (q + k) & 7; if ((steal >> qq) & 1u) { nq = qq; break; } }
                if (nq < 0) break;
                steal &= ~(1u << nq); q = nq;
                __syncthreads();
                if (tid == 0) MISC[16] = __hip_atomic_fetch_add(ctl + CW_QUEUE + 64 * (8 * rep_ + q), 1u, RLX_AGENT);
                __syncthreads();
                id = __builtin_amdgcn_readfirstlane((int)MISC[16]);
                continue;
            }
            unsigned nid = 0u; if (tid == 0) nid = __hip_atomic_fetch_add(ctl + CW_QUEUE + 64 * (8 * rep_ + q), 1u, RLX_AGENT);
#ifdef PROBE_KIND
            if (rep_ == 1 && !((PROBE_KIND == 1 && id < 16) || (PROBE_KIND == 2 && id >= 16 && id < 272) || (PROBE_KIND == 3 && id >= 272))) { if (tid == 0) MISC[16] = nid; __syncthreads(); id = __builtin_amdgcn_readfirstlane((int)MISC[16]); __syncthreads(); continue; }
#endif
#ifdef PROBE_TS
            const unsigned long long tu0_ = __builtin_amdgcn_s_memrealtime();
#endif
            if (id < 16) {
                const int bh = 16 * q + id;
                ret::ret_state_unit(bh >> 2, bh & 3, PROJ, RST, lds);
                asm volatile("s_waitcnt vmcnt(0)" ::: "memory");
                __syncthreads();
                if (tid == 0) { __builtin_amdgcn_fence(__ATOMIC_RELEASE, "agent"); asm volatile("s_waitcnt vmcnt(0)" ::: "memory");
                    __hip_atomic_fetch_add(ctl + CW_RDONE + 64 * (8 * rep_ + q), 1u, RLX_AGENT); }
            } else if (id >= QLEN - 256) {
                if (!((ready_mask >> q) & 1u)) {
                    if (tid == 0) { unsigned sp = 0;
                        while (__hip_atomic_load(ctl + CW_RDONE + 64 * (8 * rep_ + q), RLX_AGENT) < 16u) { __builtin_amdgcn_s_sleep(8);
                            if (++sp > (1u << 20)) { __hip_atomic_store(ctl + CW_TMO, 1u, RLX_AGENT); break; } }
                        __builtin_amdgcn_fence(__ATOMIC_ACQUIRE, "agent"); asm volatile("s_waitcnt vmcnt(0)" ::: "memory"); }
                    __syncthreads();
                    ready_mask |= 1u << q;
                }
                const int u = id - (QLEN - 256), bh = 16 * q + (u >> 4); ret::ret_out_unit(bh >> 2, bh & 3, u & 15, PROJ, RST, ret_norm_w, MIX, lds, MISC + 16, nid);
            } else if (CONV_IN_P2 && (id - 16) % 3 == 2) {
                int t2_ = threadIdx.x; asm volatile("" : "+v"(t2_)); const int lane2 = t2_ & 63, wave2 = __builtin_amdgcn_readfirstlane(t2_ >> 6);
                constexpr int I_1E = (DM / 64) * (2048 / 32), I_2E = (DM / 64) * (DM / 32), I_1 = NEXP * I_1E;
                LAS float* scr = (LAS float*)(lds + wave2 * 16384);
                const int cu = 128 * q + (id - 16) / 3, it0 = cu * 48 + wave2 * 6;
                auto src_of = [&](int r, const float*& W, int& N, int& loc) { if (r < I_1) { const int e = r / I_1E; W = w1 + (size_t)e * DM * 2048; N = 2048; loc = r % I_1E; } else { r -= I_1; const int e = r / I_2E; W = w2 + (size_t)e * DM * DM; N = DM; loc = r % I_2E; } };
                auto ld = [&](f32x4 (&v)[8], int it) { const float* W; int N, loc; src_of(it, W, N, loc); p0_load(v, W, N, loc, lane2); };
                auto fin = [&](const f32x4 (&v)[8], int it) {
                    if (it < I_1) { const int e = it / I_1E; if constexpr (MOE_B6) p0_finish6(v, 2048, W1T + (size_t)e * 2048 * 768, 2, 64.f, scr, it % I_1E, lane2); else p0_finish<true>(v, DM, 2048, W1T + (size_t)e * 2048 * DM, 2, 64.f, scr, it % I_1E, lane2); }
                    else { const int r = it - I_1, e = r / I_2E; if constexpr (MOE_B6) p0_finish6(v, DM, W2T + (size_t)e * DM * 768, 0, 64.f, scr, r % I_2E, lane2); else p0_finish<true>(v, DM, DM, W2T + (size_t)e * DM * DM, 0, 64.f, scr, r % I_2E, lane2); } };
                f32x4 v0[8], v1[8], v2[8]; ld(v0, it0); ld(v1, it0 + 1);
#pragma unroll 1
                for (int k = 0; k < 6; k += 3) { const int it = it0 + k;
                    ld(v2, it + 2); fin(v0, it);
                    if (k == 0) ld(v0, it + 3);
                    fin(v1, it + 1);
                    if (k == 0) ld(v1, it + 4);
                    fin(v2, it + 2); }
                if (tid == 0) MISC[16] = nid;
                LDS_BARRIER();
            } else { const int jm = id - 16, j = CONV_IN_P2 ? (jm / 3) * 2 + (jm % 3) : jm, bh = 32 * q + (j >> 3), qb = 7 - (j & 7);
                moba::moba_unit<8>(bh >> 3, bh & 7, qb, (const moba::bf16*)PROJ, ksum, (moba::bf16*)MIX, (char*)lds_raw, MISC + 16, nid, MISC + 20); }
#ifdef PROBE_TS
            if (tid == 0) { const unsigned dt_ = (unsigned)(__builtin_amdgcn_s_memrealtime() - tu0_); if (id < 16) MISC[25] += dt_; else if (id >= 272) MISC[26] += dt_; else MISC[28] += dt_; }
#endif
            if (id < 16 && tid == 0) MISC[16] = nid;
            LDS_BARRIER();
            id = __builtin_amdgcn_readfirstlane((int)MISC[16]);
        }
#ifdef PROBE_TS
        if (tid == 0) { const unsigned lt_ = (unsigned)(__builtin_amdgcn_s_memrealtime() - tp0_); MISC[27] = lt_; atomicMax((unsigned*)(ctl + 49152 + 128), lt_); atomicMin((unsigned*)(ctl + 49152 + 192), lt_ ^ 0x7fffffffu ? lt_ : lt_); atomicAdd((unsigned*)(ctl + 49152 + 256), lt_ >> 8); }
#endif
    }
    SEAM(2);
#ifdef PROBE_CHECK
    if (IN(2) && bx < 8) probe_check(bx, x, norm1_w, w_in, ret_norm_w, MIX, (float*)(ws + 920 * MiB) + (size_t)bx * (1u << 20), ctl + 49152, lds);
    if (IN(2)) xcd_barrier(bar);
#endif

    if (IN(3)) for (int rep_ = 0; rep_ < NREP(3); ++rep_) {
        pg8::ProbOutProj P; P.A = MIX; P.Bt = WoutT; P.nM = NTOK / 256; P.nN = DM / 256; P.G = G; P.c = bx; P.D = DELTA;
        pg8::gemm_phase<pg8::ProbOutProj, true>(lds, P);
    }
    SEAM(3);

    if (IN(4)) { PHASE_IDS();
        LAS float* lg = (LAS float*)(lds) + wave * (32 * 33);
        LAS unsigned* pinfo = (LAS unsigned*)(lds + 40960);
        LAS float* pgate = (LAS float*)(lds + 40960 + 4096);
        LAS unsigned* lcnt = (LAS unsigned*)(lds + 40960 + 8192);
        LAS unsigned* lbase = lcnt + 32;
        LAS float* prstd = (LAS float*)(lds + 40960 + 8192 + 256);
        const int c16 = lane & 15, g = lane >> 4;
        for (int blk = bx; blk < NTOK / 256; blk += G) {
            if (tid < 32) lcnt[tid] = 0u;
            __syncthreads();
            const int R0 = blk * 256 + wave * 32;
            f32x4 acc[2][2]; float ssq[2] = {0.f, 0.f}; float irs[2];
#pragma unroll
            for (int tt = 0; tt < 2; ++tt) irs[tt] = 1.0f / rstd1[R0 + 16 * tt + c16];
#pragma unroll
            for (int tt = 0; tt < 2; ++tt)
#pragma unroll
                for (int eh = 0; eh < 2; ++eh) acc[tt][eh] = (f32x4){0.f, 0.f, 0.f, 0.f};
#pragma unroll 4
            for (int ks = 0; ks < 32; ++ks) {
                const f32x4 w0 = *(const f32x4*)(norm2_w + 32 * ks + 8 * g), w1v = *(const f32x4*)(norm2_w + 32 * ks + 8 * g + 4);
                bf16x8 bh[2], bl[2];
#pragma unroll
                for (int eh = 0; eh < 2; ++eh) { bh[eh] = *(const bf16x8*)(wrf + (((size_t)(ks * 2 + eh) * 2 + 0) * 64 + lane) * 8); bl[eh] = *(const bf16x8*)(wrf + (((size_t)(ks * 2 + eh) * 2 + 1) * 64 + lane) * 8); }
#pragma unroll
                for (int tt = 0; tt < 2; ++tt) { const size_t ro = (size_t)(R0 + 16 * tt + c16) * DM + 32 * ks + 8 * g;
                    f32x4 a0, a1; { const u32x4 xx = *(const u32x4*)(XN + ro); const f32x4 i0 = *(const f32x4*)(inw1 + 32 * ks + 8 * g) * irs[tt], i1 = *(const f32x4*)(inw1 + 32 * ks + 8 * g + 4) * irs[tt];
                        a0.x = __builtin_bit_cast(float, xx.x << 16) * i0.x; a0.y = __builtin_bit_cast(float, xx.x & 0xffff0000u) * i0.y; a0.z = __builtin_bit_cast(float, xx.y << 16) * i0.z; a0.w = __builtin_bit_cast(float, xx.y & 0xffff0000u) * i0.w;
                        a1.x = __builtin_bit_cast(float, xx.z << 16) * i1.x; a1.y = __builtin_bit_cast(float, xx.z & 0xffff0000u) * i1.y; a1.z = __builtin_bit_cast(float, xx.w << 16) * i1.z; a1.w = __builtin_bit_cast(float, xx.w & 0xffff0000u) * i1.w; }
                    { const u32x4 dd = *(const u32x4*)(DELTA + ro);
                        a0.x += __builtin_bit_cast(float, dd.x << 16); a0.y += __builtin_bit_cast(float, dd.x & 0xffff0000u); a0.z += __builtin_bit_cast(float, dd.y << 16); a0.w += __builtin_bit_cast(float, dd.y & 0xffff0000u);
                        a1.x += __builtin_bit_cast(float, dd.z << 16); a1.y += __builtin_bit_cast(float, dd.z & 0xffff0000u); a1.z += __builtin_bit_cast(float, dd.w << 16); a1.w += __builtin_bit_cast(float, dd.w & 0xffff0000u); }
                    ssq[tt] += (a0.x * a0.x + a0.y * a0.y) + (a0.z * a0.z + a0.w * a0.w) + (a1.x * a1.x + a1.y * a1.y) + (a1.z * a1.z + a1.w * a1.w);
                    const f32x4 v0 = a0 * w0, v1 = a1 * w1v; u32x4 hw, lw;
                    hw.x = pk2(v0.x, v0.y); hw.y = pk2(v0.z, v0.w); hw.z = pk2(v1.x, v1.y); hw.w = pk2(v1.z, v1.w);
                    lw.x = pk2(v0.x - __builtin_bit_cast(float, hw.x << 16), v0.y - __builtin_bit_cast(float, hw.x & 0xffff0000u)); lw.y = pk2(v0.z - __builtin_bit_cast(float, hw.y << 16), v0.w - __builtin_bit_cast(float, hw.y & 0xffff0000u));
                    lw.z = pk2(v1.x - __builtin_bit_cast(float, hw.z << 16), v1.y - __builtin_bit_cast(float, hw.z & 0xffff0000u)); lw.w = pk2(v1.z - __builtin_bit_cast(float, hw.w << 16), v1.w - __builtin_bit_cast(float, hw.w & 0xffff0000u));
                    *(u32x2*)(H2q + ro) = pack8_fp8(v0, v1);
                    const bf16x8 ah = __builtin_bit_cast(bf16x8, hw), al = __builtin_bit_cast(bf16x8, lw);
#pragma unroll
                    for (int eh = 0; eh < 2; ++eh) { acc[tt][eh] = __builtin_amdgcn_mfma_f32_16x16x32_bf16(ah, bh[eh], acc[tt][eh], 0, 0, 0);
                        acc[tt][eh] = __builtin_amdgcn_mfma_f32_16x16x32_bf16(al, bh[eh], acc[tt][eh], 0, 0, 0); acc[tt][eh] = __builtin_amdgcn_mfma_f32_16x16x32_bf16(ah, bl[eh], acc[tt][eh], 0, 0, 0); } }
            }
#pragma unroll
            for (int tt = 0; tt < 2; ++tt) { float s = ssq[tt]; s += __shfl_xor(s, 16); s += __shfl_xor(s, 32); const float rstd = 1.0f / sqrtf(s * (1.f / DM) + RMS_EPS);
                if (g == 0) prstd[wave * 32 + 16 * tt + c16] = rstd;
#pragma unroll
                for (int r = 0; r < 4; ++r) { const float rr = __shfl(rstd, 4 * g + r);
#pragma unroll
                    for (int eh = 0; eh < 2; ++eh) lg[(16 * tt + 4 * g + r) * 33 + 16 * eh + c16] = acc[tt][eh][r] * rr + b_router[16 * eh + c16]; } }
            LDS_WAIT(); asm volatile("" ::: "memory");
            if (lane < 32) {
                float v[32];
#pragma unroll
                for (int e = 0; e < 32; ++e) v[e] = lg[lane * 33 + e];
                float tv[4]; int te[4];
#pragma unroll
                for (int k = 0; k < 4; ++k) { float best = v[0]; int bi = 0;
#pragma unroll
                    for (int e = 1; e < 32; ++e) if (v[e] > best) { best = v[e]; bi = e; }
                    tv[k] = best; te[k] = bi;
#pragma unroll
                    for (int e = 0; e < 32; ++e) v[e] = (e == bi) ? -INFINITY : v[e]; }
                float ex[4], sum = 0.f;
#pragma unroll
                for (int k = 0; k < 4; ++k) { ex[k] = __expf(tv[k] - tv[0]); sum += ex[k]; }
                const float inv = 1.0f / sum;
#pragma unroll
                for (int k = 0; k < 4; ++k) { const unsigned lr = __hip_atomic_fetch_add(lcnt + te[k], 1u, __ATOMIC_RELAXED, __HIP_MEMORY_SCOPE_WORKGROUP);
                    const int p = (wave * 32 + lane) * 4 + k; pinfo[p] = (unsigned)te[k] | (lr << 8); pgate[p] = ex[k] * inv; }
            }
            LDS_BARRIER();
            if (tid < 32) lbase[tid] = __hip_atomic_fetch_add(ctl + CW_GCNT + 64 * tid, lcnt[tid], RLX_AGENT);
            LDS_BARRIER();
            for (int p = tid; p < 1024; p += NWAVES * 64) { const unsigned pi = pinfo[p]; const int e = pi & 255u; const unsigned pos = lbase[e] + (pi >> 8);
                const int pair = (blk * 256) * 4 + p; const size_t si = (size_t)e * NTOK + pos; slot[si] = pair; sgate[si] = pgate[p]; srstd[si] = prstd[p >> 2]; }
            LDS_BARRIER();
        }
    }
    SEAM(4);

    if (IN(5) || IN(6)) { PHASE_IDS();
        if (tid == 0) { int tp = 0, cp = 0;
            for (int e = 0; e < NEXP; ++e) { const int c = (int)__hip_atomic_load(ctl + CW_GCNT + 64 * e, RLX_AGENT); LTAB[e] = tp; LTAB[33 + e] = cp; tp += (c + 255) >> 8; cp += c; }
            LTAB[32] = tp; LTAB[33 + 32] = cp; }
        __syncthreads();
    }
    if (IN(5)) for (int rep_ = 0; rep_ < NREP(5); ++rep_) {
        pg8::ProbMoe1 P; P.T = LTAB[32]; P.NP = 8; P.G = G; P.c = bx; P.load_tables(LTAB, LTAB + 33);
        P.H2 = H2q; P.W1T = W1T; P.slot = slot; P.srstd = srstd; P.b1 = b1; P.ACT = ACT;
        pg8::gemm_phase<pg8::ProbMoe1, true>(lds, P);
    }
    SEAM(5);
    if (IN(6)) for (int rep_ = 0; rep_ < NREP(6); ++rep_) {
        pg8::ProbMoe2 P; P.T = LTAB[32]; P.NP = 4; P.G = G; P.c = bx; P.load_tables(LTAB, LTAB + 33);
        P.ACT = ACT; P.W2T = W2T; P.slot = slot; P.sgate = sgate; P.b2 = b2; P.Y4 = Y4;
        pg8::gemm_phase<pg8::ProbMoe2, true>(lds, P);
    }
    SEAM(6);

    if (IN(7)) for (int rep_ = 0; rep_ < NREP(7); ++rep_) { PHASE_IDS();
        const int gw = vcu * NWAVES + wave, NGW = G * NWAVES;
        unsigned bad = __hip_atomic_load(ctl + CW_TMO, RLX_AGENT);
        for (int li = 0; li < (MK_N_LAUNCHES == N_PHASES ? 0 : MK_N_LAUNCHES); ++li) bad |= __hip_atomic_load(ctl + CW_BAR + li * XCD_BAR_WORDS + XB_TMO, RLX_AGENT);
        f32x4 wv[4];
#pragma unroll
        for (int j = 0; j < 4; ++j) wv[j] = *((const f32x4*)final_w + lane + 64 * j);
        f32x4 iw[4];
#pragma unroll
        for (int j = 0; j < 4; ++j) iw[j] = *((const f32x4*)inw1 + lane + 64 * j);
        for (int mm = gw; mm < NTOK; mm += 2 * NGW) {
            f32x4 v[2][4]; u32x2 xq[2][4], dd[2][4]; unsigned yy[2][4][4]; int mr[2]; float irs[2]; mr[0] = mm; mr[1] = (mm + NGW < NTOK) ? mm + NGW : mm;
#pragma unroll
            for (int r = 0; r < 2; ++r) { const u32x2* xi = (const u32x2*)(XN + (size_t)mr[r] * DM) + lane; irs[r] = rstd1[mr[r]]; const unsigned* y0 = (const unsigned*)(Y4 + (size_t)mr[r] * 4 * DM) + lane; const u32x2* dl = (const u32x2*)(DELTA + (size_t)mr[r] * DM) + lane;
#pragma unroll
                for (int j = 0; j < 4; ++j) { xq[r][j] = __builtin_nontemporal_load(xi + 64 * j); dd[r][j] = __builtin_nontemporal_load(dl + 64 * j);
#pragma unroll
                    for (int k = 0; k < 4; ++k) yy[r][j][k] = __builtin_nontemporal_load(y0 + k * (DM / 4) + 64 * j); } }
#pragma unroll
            for (int r = 0; r < 2; ++r) { float s = 0.f; const float ir = 1.0f / irs[r];
#pragma unroll
                for (int j = 0; j < 4; ++j) { f32x4 a; { const u32x2 q = xq[r][j]; a.x = __builtin_bit_cast(float, q.x << 16); a.y = __builtin_bit_cast(float, q.x & 0xffff0000u); a.z = __builtin_bit_cast(float, q.y << 16); a.w = __builtin_bit_cast(float, q.y & 0xffff0000u); a = a * iw[j] * ir; }
                    { const u32x2 q = dd[r][j];
                        a.x += __builtin_bit_cast(float, q.x << 16); a.y += __builtin_bit_cast(float, q.x & 0xffff0000u); a.z += __builtin_bit_cast(float, q.y << 16); a.w += __builtin_bit_cast(float, q.y & 0xffff0000u); }
                    f32x4 ys = (f32x4){0.f, 0.f, 0.f, 0.f};
#pragma unroll
                    for (int k = 0; k < 4; ++k) { const f32x2 lo = __builtin_amdgcn_cvt_pk_f32_fp8((int)yy[r][j][k], false), hi = __builtin_amdgcn_cvt_pk_f32_fp8((int)yy[r][j][k], true);
                        ys.x += lo.x; ys.y += lo.y; ys.z += hi.x; ys.w += hi.y; }
                    a = a + ys * (1.f / 8.f);
                    v[r][j] = a; s += (a.x * a.x + a.y * a.y) + (a.z * a.z + a.w * a.w); }
                const float rstd = 1.0f / sqrtf(wave_sum(s) * (1.f / DM) + RMS_EPS);
                if (r == 0 || mr[1] != mr[0]) { f32x4* xr = (f32x4*)(out + (size_t)mr[r] * DM) + lane;
#pragma unroll
                    for (int j = 0; j < 4; ++j) { f32x4 y = v[r][j] * rstd * wv[j]; if (bad) { const float q = __builtin_nanf(""); y = (f32x4){q, q, q, q}; } xr[64 * j] = y; } }
            }
        }
    }
#ifdef PROBE_F6MAP
    __syncthreads();
    if (bx == 0 && threadIdx.x < 64) {
        const int l = (int)threadIdx.x, fr = l & 15, fq = l >> 4;
        const int pa[16] = {0, 0, 0, 0, 0, 0, 0, 1, 1, 2, 2, 3, 3, 3, 1, 2}, pb[16] = {0, 1, 4, 15, 16, 17, 31, 0, 16, 0, 16, 0, 16, 31, 5, 21};
        int a_ = 0, b_ = 0;
#pragma unroll
        for (int r = 0; r < 16; ++r) if (fr == r) { a_ = pa[r]; b_ = pb[r]; }
        v8i A8;
#pragma unroll
        for (int w = 0; w < 8; ++w) A8[w] = (fq == a_ && (b_ >> 2) == w) ? (0x38 << (8 * (b_ & 3))) : 0;
        unsigned long long lo64 = 0, mid64 = 0, hi64 = 0;
        const bool on = (fr < 8) && (fq == (fr & 3));
#pragma unroll
        for (int i = 0; i < 32; ++i) { const unsigned long long c = on ? (unsigned long long)((fr < 4) ? i : ((i + 1) & 31)) : 0ull; const int bit = 6 * i;
            if (bit < 64) { lo64 |= c << bit; if (bit > 58) mid64 |= c >> (64 - bit); }
            else if (bit < 128) { mid64 |= c << (bit - 64); if (bit > 122) hi64 |= c >> (128 - bit); }
            else hi64 |= c << (bit - 128); }
        v6i B6v = (v6i){(int)(unsigned)lo64, (int)(unsigned)(lo64 >> 32), (int)(unsigned)mid64, (int)(unsigned)(mid64 >> 32), (int)(unsigned)hi64, (int)(unsigned)(hi64 >> 32)};
        f32x4 d = (f32x4){0.f, 0.f, 0.f, 0.f}; const int one_ = 0x7f7f7f7f;
        asm volatile("s_nop 7\n\tv_mfma_scale_f32_16x16x128_f8f6f4 %0, %1, %2, %0, %3, %3 op_sel_hi:[0,0,0] cbsz:2\n\ts_nop 15\n\ts_nop 7" : "+v"(d) : "v"(B6v), "v"(A8), "v"(one_));
        LAS float* Dm = (LAS float*)lds;
#pragma unroll
        for (int r = 0; r < 4; ++r) Dm[(4 * fq + r) * 16 + fr] = d[r];
        asm volatile("s_waitcnt lgkmcnt(0)" ::: "memory");
        if (l < 16) { int found = -1, cnt = 0;
            for (int j = 0; j < 8; ++j) { const float v = Dm[j * 16 + l]; if (v != 0.f) { const float av = fabsf(v); const int code = av < 2.f ? (int)(av * 8.f + 0.5f) : (av < 4.f ? 16 + (int)((av - 2.f) * 4.f + 0.5f) : 24 + (int)((av - 4.f) * 2.f + 0.5f));
                    const int ip = (j < 4) ? code : ((code - 1) & 31); const int idx = 32 * (j & 3) + ip; if (found < 0 || found == idx) found = idx; else found = 255; ++cnt; } }
            if (found < 0) found = 254;
            ((LAS int*)lds)[512 + l] = found; }
        asm volatile("s_waitcnt lgkmcnt(0)" ::: "memory");
        if (l == 0) { const LAS int* R = (const LAS int*)lds + 512; bool h1 = true, h2 = true, h3 = true;
            for (int r = 0; r < 16; ++r) { const int a = pa[r], b = pb[r], idx = R[r]; const int fqp = idx >> 5, ip = idx & 31;
                if (idx != 32 * a + b) h1 = false;
                const int k8 = b < 16 ? 16 * a + b : 64 + 16 * a + (b - 16); if (idx != k8) h2 = false;
                const int k6 = ip < 16 ? 16 * fqp + ip : 64 + 16 * fqp + (ip - 16); if (idx > 127 || k6 != 32 * a + b) h3 = false; }
            const int hyp = h1 ? 1 : (h2 ? 2 : (h3 ? 3 : 0));
            const int sel = (PROBE_F6MAP) - 1;
            const unsigned long long ticks = sel < 0 ? (unsigned long long)(hyp + 1) * 30000ull : (unsigned long long)(R[sel] + 1) * 10000ull;
            const unsigned long long t0 = __builtin_amdgcn_s_memrealtime(); while (__builtin_amdgcn_s_memrealtime() - t0 < ticks) __builtin_amdgcn_s_sleep(8); }
    }
#endif
#ifdef PROBE_CHECK
    if (bx == 0 && threadIdx.x == 0) { const float rel = __uint_as_float(__hip_atomic_load(ctl + 49152 + 64 * ((PROBE_CHECK) - 1), RLX_AGENT)); unsigned long long ticks = (unsigned long long)(fminf(rel, 1.f) * 2.0e7f);
        const unsigned long long t0 = __builtin_amdgcn_s_memrealtime(); while (__builtin_amdgcn_s_memrealtime() - t0 < ticks) __builtin_amdgcn_s_sleep(8); }
#endif
#ifdef PROBE_TS
    if (bx == 0 && threadIdx.x == 0) { const unsigned val = (PROBE_TS) == 9 ? __hip_atomic_load(ctl + 49152 + 128, RLX_AGENT) : (PROBE_TS) == 10 ? __hip_atomic_load(ctl + 49152 + 256, RLX_AGENT) : MISC[20 + ((PROBE_TS) & 15)]; const unsigned long long t0 = __builtin_amdgcn_s_memrealtime(); while (__builtin_amdgcn_s_memrealtime() - t0 < (unsigned long long)val * 2ull) __builtin_amdgcn_s_sleep(8); }
#endif
#undef IN
#undef SEAM
}

extern "C" void kernel_launch(void* const* d_in, const int* in_sizes, int n_in, void* d_out, int out_size, void* d_ws, size_t ws_size, hipStream_t stream) {
    static int grid = 0;
    if (grid == 0) {
        if (n_in != 13 || in_sizes[0] != NTOK * DM || out_size != NTOK * DM || ws_size < WS_END) { fprintf(stderr, "kernel_launch: unexpected shapes (n_in %d, in0 %d, out %d, ws %zu)\n", n_in, n_in > 0 ? in_sizes[0] : -1, out_size, ws_size); grid = -1; return; }
        int dev = 0, cus = 0;
        if (hipGetDevice(&dev) != hipSuccess || hipDeviceGetAttribute(&cus, hipDeviceAttributeMultiprocessorCount, dev) != hipSuccess) { grid = -1; return; }
        if (hipFuncSetAttribute((const void*)fwd_mega, hipFuncAttributeMaxDynamicSharedMemorySize, LDS_BYTES) != hipSuccess) { fprintf(stderr, "kernel_launch: hipFuncSetAttribute failed\n"); grid = -1; return; }
        int per_cu = 0;
        if (hipOccupancyMaxActiveBlocksPerMultiprocessor(&per_cu, (const void*)fwd_mega, NWAVES * 64, LDS_BYTES) != hipSuccess || per_cu < 1) fprintf(stderr, "kernel_launch: occupancy query says %d\n", per_cu);
        (void)hipGetLastError();
        grid = cus;
    }
    if (grid < 0) return;
    (void)hipMemsetAsync((char*)d_ws + WS_CTL, 0, CTL_ZERO_BYTES, stream);
    Args a{};
    for (int i = 0; i < 13; ++i) a.in[i] = (const float*)d_in[i];
    a.out = (float*)d_out; a.ws = (unsigned char*)d_ws;
    if (MK_N_LAUNCHES == 1) { a.ph_lo = 0; a.ph_hi = N_PHASES; a.li = 0; hipLaunchKernelGGL(fwd_mega, dim3(grid), dim3(NWAVES * 64), LDS_BYTES, stream, a); }
    else for (int li = 0; li < N_PHASES; ++li) { a.ph_lo = li; a.ph_hi = li + 1; a.li = 0; hipLaunchKernelGGL(fwd_mega, dim3(grid), dim3(NWAVES * 64), LDS_BYTES, stream, a); }
}
```

```cpp
#include <hip/hip_runtime.h>
#include <hip/hip_bf16.h>
#include <cstdio>
#include <cstdint>
#include <cmath>

#ifndef MOE_B6
#define MOE_B6 1
#endif
#ifndef MOE_A3
#define MOE_A3 1
#endif
#ifndef AUX_P5
#define AUX_P5 0
#endif
#ifndef AUX_P6
#define AUX_P6 0
#endif
#ifndef WGM_DENSE
#define WGM_DENSE 8
#endif
#ifndef WGM_MOE
#define WGM_MOE 4
#endif
#ifndef FULL_LINE
#define FULL_LINE 1
#endif
#ifndef CONV_IN_P2
#define CONV_IN_P2 1
#endif
#ifndef MK_N_LAUNCHES
#define MK_N_LAUNCHES 1
#endif

#define LAS __attribute__((address_space(3)))
#define GAS __attribute__((address_space(1)))
typedef unsigned short bf16_t;
typedef short bf16x8 __attribute__((ext_vector_type(8)));
typedef short s16x4 __attribute__((ext_vector_type(4)));
typedef float f32x4 __attribute__((ext_vector_type(4)));
typedef float f32x2 __attribute__((ext_vector_type(2)));
typedef float f32x16 __attribute__((ext_vector_type(16)));
typedef unsigned u32x4 __attribute__((ext_vector_type(4)));
typedef unsigned u32x2 __attribute__((ext_vector_type(2)));
typedef GAS unsigned gu32;
typedef int v8i __attribute__((ext_vector_type(8)));
typedef int v6i __attribute__((ext_vector_type(6)));
typedef int v12i __attribute__((ext_vector_type(12)));
typedef _Float16 v32h __attribute__((ext_vector_type(32)));
typedef unsigned v6u __attribute__((ext_vector_type(6)));

constexpr int NB = 32, SEQ = 2048, DM = 1024, NTOK = NB * SEQ;
constexpr int DIN = 3072;
constexpr int NEXP = 32, TOPK = 4, NPAIR = NTOK * TOPK;
constexpr float RMS_EPS = 1e-5f, GN_EPS = 1e-6f;
constexpr float QC2 = 0.125f * 1.4426950408889634f;
constexpr int PC_RQ = 0, PC_RK = 256, PC_RV = 512, PC_RG = 1024, PC_MQ = 1536, PC_MK = 2048, PC_MV = 2560;

constexpr size_t MiB = 1u << 20;
constexpr size_t WS_CTL = 0, CTL_ZERO_BYTES = 256 * 1024;
constexpr size_t WS_ROPE = 1 * MiB;
constexpr size_t WS_KSUM = 2 * MiB;
constexpr size_t WS_RSTD = 3 * MiB;
constexpr size_t WS_WRF = 3 * MiB + 512 * 1024;
constexpr size_t WS_GATE = 4 * MiB;
constexpr size_t WS_SLOT = 5 * MiB;
constexpr size_t WS_WIN = 16 * MiB, WS_WOUT = 22 * MiB, WS_SGATE = 16 * MiB;
constexpr size_t WS_W2 = 24 * MiB, WS_W1 = 56 * MiB;
constexpr size_t WS_XN = 120 * MiB, WS_DELTA = 792 * MiB;
constexpr size_t WS_H2Q = 632 * MiB;
constexpr size_t WS_PROJ = 248 * MiB, WS_MIX = 632 * MiB;
constexpr size_t WS_ACT = 248 * MiB;
constexpr size_t WS_SRSTD = 696 * MiB;
constexpr size_t WS_Y4 = 504 * MiB;
constexpr size_t WS_RST = 760 * MiB;
constexpr size_t WS_END = 1016 * MiB;
constexpr int CW_TMO = 0, CW_CODE = 1, CW_BAR = 4096, CW_QUEUE = 45056, CW_RDONE = 47104, CW_GCNT = 40960;

constexpr int RING_BYTES = 147456;
constexpr int LDSCTL_OFF = RING_BYTES, MISC_OFF = LDSCTL_OFF + 320, LTAB_OFF = LDSCTL_OFF + 512;
constexpr int LDS_BYTES = 163840;
constexpr int NWAVES = 8;

#define RLX_AGENT __ATOMIC_RELAXED, __HIP_MEMORY_SCOPE_AGENT
#define LDS_WAIT() asm volatile("s_waitcnt lgkmcnt(0)" ::: "memory")
#define VM_WAIT() asm volatile("s_waitcnt vmcnt(0)" ::: "memory")
#define LDS_BARRIER() asm volatile("s_waitcnt lgkmcnt(0)\n\ts_barrier" ::: "memory")

__device__ __forceinline__ unsigned f2bf(float f) { unsigned u = __builtin_bit_cast(unsigned, f); return (u + 0x7fffu + ((u >> 16) & 1u)) >> 16; }
__device__ __forceinline__ unsigned pk2(float lo, float hi) { return f2bf(lo) | (f2bf(hi) << 16); }
__device__ __forceinline__ float bf2f(unsigned short b) { return __builtin_bit_cast(float, (unsigned)b << 16); }
__device__ __forceinline__ unsigned cvt_pk_bf16(float lo, float hi) { unsigned r; asm volatile("v_cvt_pk_bf16_f32 %0, %1, %2" : "=v"(r) : "v"(lo), "v"(hi)); return r; }
__device__ __forceinline__ u32x4 pack8(f32x4 a, f32x4 b) { u32x4 w; w.x = cvt_pk_bf16(a[0], a[1]); w.y = cvt_pk_bf16(a[2], a[3]); w.z = cvt_pk_bf16(b[0], b[1]); w.w = cvt_pk_bf16(b[2], b[3]); return w; }

__device__ __forceinline__ unsigned f2fp6(float x) {
    const float v = fminf(fabsf(x), 7.5f);
    const float sc = v < 2.f ? 8.f : (v < 4.f ? 4.f : 2.f), off = v < 2.f ? 0.f : (v < 4.f ? 2.f : 4.f), base = v < 2.f ? 0.f : (v < 4.f ? 16.f : 24.f);
    const unsigned c = (unsigned)(base + __builtin_rintf((v - off) * sc));
    return c | ((__builtin_bit_cast(unsigned, x) >> 26) & 32u);
}
__device__ __forceinline__ void pack8_fp6(f32x4 a, f32x4 b, unsigned& lo, unsigned& hi) {
    const unsigned c0 = f2fp6(a[0]), c1 = f2fp6(a[1]), c2 = f2fp6(a[2]), c3 = f2fp6(a[3]), c4 = f2fp6(b[0]), c5 = f2fp6(b[1]), c6 = f2fp6(b[2]), c7 = f2fp6(b[3]);
    lo = c0 | (c1 << 6) | (c2 << 12) | (c3 << 18) | (c4 << 24) | (c5 << 30); hi = (c5 >> 2) | (c6 << 4) | (c7 << 10);
}
__device__ __forceinline__ u32x2 pack8_fp8(f32x4 a, f32x4 b) { u32x2 w; int t = 0;
    t = __builtin_amdgcn_cvt_pk_fp8_f32(a[0], a[1], t, false); t = __builtin_amdgcn_cvt_pk_fp8_f32(a[2], a[3], t, true); w.x = (unsigned)t; t = 0;
    t = __builtin_amdgcn_cvt_pk_fp8_f32(b[0], b[1], t, false); t = __builtin_amdgcn_cvt_pk_fp8_f32(b[2], b[3], t, true); w.y = (unsigned)t; return w; }

namespace pg8 {
constexpr int BM = 256, BK = 64, HALF = 128, HTB = HALF * BK * 2, STAGE_BYTES = 8 * HTB, NXCD = 8, WGM = 4;
constexpr int KD = 1024;
__device__ __forceinline__ int lds_byte(int r, int c) { const int st = (r >> 4) * 2 + (c >> 5), rr = r & 15, cc = c & 31, ob = rr * 64 + cc * 2; return st * 1024 + (ob ^ (((ob >> 9) & 1) << 5)); }
__device__ __forceinline__ void stage_rc(int b, int& R, int& C) { const int st = b / 1024, sb = b % 1024, swz = sb ^ (((sb >> 9) & 1) << 5); R = (st >> 1) * 16 + swz / 64; C = (st & 1) * 32 + (swz % 64) / 2; }
template <bool F8_> __device__ __forceinline__ int fl_sw(int r) { return F8_ ? ((r >> 1) & 5) : ((r >> 1) & 7); }
template <bool F8_> __device__ __forceinline__ void fl_stage_rc(int b, int& R, int& C) { const int p = b >> 4; R = p >> 3; C = ((p & 7) ^ fl_sw<F8_>(R)) * 8; }
__device__ __forceinline__ int perm32(int rho) { const int n = rho >> 4, i = rho & 15; return 8 * (i >> 2) + 4 * n + (i & 3); }

struct Unit { int pm, pn, e, row0, nrows, arow; };

template <int WGM_> __device__ __forceinline__ bool tile_order(int i, int G, int c, int nM, int nN, int& pm, int& pn) { constexpr int WGM = WGM_;
    const int nwg = nM * nN; const long L = (long)i * G + c; if (L >= nwg) return false;
    int wgid = (int)L; { const int q = nwg / NXCD, r = nwg % NXCD, xcd = wgid % NXCD, off = wgid / NXCD; wgid = (xcd < r ? xcd * (q + 1) : r * (q + 1) + (xcd - r) * q) + off; }
    const int nig = WGM * nN, gid = wgid / nig, fm = gid * WGM, gsz = (nM - fm) < WGM ? (nM - fm) : WGM;
    pm = fm + ((wgid % nig) % gsz); pn = (wgid % nig) / gsz; return true;
}

template <class P, bool ALIGN_EPI>
__device__ __forceinline__ void gemm_phase(LAS unsigned char* lds, const P& S) {
    const int tid = threadIdx.x, wid = __builtin_amdgcn_readfirstlane(tid >> 6), lane = tid & 63, wr = wid >> 2, wc = wid & 3, fr = lane & 15, fq = lane >> 4;
    constexpr int KB = P::FP8 ? KD : KD * 2;
    constexpr int nt = KB / 128;
    constexpr bool SW8 = P::FP8 && !P::B6;
    unsigned voffB[2]; int RA[2], CA[2];
#pragma unroll
    for (int i = 0; i < 2; ++i) { int R, C; if constexpr (FULL_LINE) fl_stage_rc<SW8>(tid * 16 + i * 8192, R, C); else stage_rc(tid * 16 + i * 8192, R, C); const int Rb = P::PERM ? ((R & ~31) + perm32(R & 31)) : R;
        voffB[i] = (unsigned)(Rb * KB + C * 2); RA[i] = R; CA[i] = C; }
    const size_t kstep = 128;
    const size_t hstep = (size_t)HALF * KB;
    const unsigned ldsw = (unsigned)wid * 1024u;
    constexpr size_t kstepB = P::B6 ? 24576 : 128;
    const unsigned tid16 = (unsigned)tid * 16u; const int b6o = ((wc * 32 + fr) * 4 + fq), b6q = ((wc * 16 + fr) * 4 + fq);
    int aoffk[2], boffk[2];
    if constexpr (FULL_LINE) { const int sws = fl_sw<SW8>(fr);
#pragma unroll
        for (int k = 0; k < 2; ++k) { const int ch = SW8 ? (2 * fq + k) : (fq + 4 * k); aoffk[k] = (wr * 64 + fr) * 128 + ((ch ^ sws) << 4); boffk[k] = (wc * 32 + fr) * 128 + ((ch ^ sws) << 4); } }
    else { const int a0 = P::FP8 ? lds_byte(wr * 64 + fr, fq * 16) : lds_byte(wr * 64 + fr, fq * 8), b0 = P::FP8 ? lds_byte(wc * 32 + fr, fq * 16) : lds_byte(wc * 32 + fr, fq * 8);
        aoffk[0] = a0; boffk[0] = b0; aoffk[1] = a0 + (P::FP8 ? 16 : 1024); boffk[1] = b0 + (P::FP8 ? 16 : 1024); }
#define PG8_SA(b, h) (((b) * 2 + (h)) * HTB)
#define PG8_SB(b, h) ((4 + (b) * 2 + (h)) * HTB)
#define PG8_SB6(b) (P::A3 ? (98304 + (b) * 24576) : PG8_SB(b, 0))
#define PG8_STAGE(bufoff, gbase, voff) do { _Pragma("unroll") for (int _i = 0; _i < 2; ++_i) \
        __builtin_amdgcn_global_load_lds((const unsigned*)((const char*)(gbase) + (voff)[_i]), (LAS unsigned*)(lds + (bufoff) + ldsw + _i * 8192), 16, 0, 0); } while (0)
    const int scw_ = P::SCW, scx_ = P::SCX;
#define PG8_STAGEA(bufoff, gbase, voff) do { _Pragma("unroll") for (int _i = 0; _i < 2; ++_i) \
        __builtin_amdgcn_global_load_lds((const unsigned*)((const char*)(gbase) + (voff)[_i]), (LAS unsigned*)(lds + (bufoff) + ldsw + _i * 8192), 16, 0, P::A_AUX); } while (0)
#define PG8_STAGEB(b, gsrc) do { if constexpr (P::B6) { _Pragma("unroll") for (int _i = 0; _i < 3; ++_i) \
        __builtin_amdgcn_global_load_lds((const unsigned*)((const char*)(gsrc) + tid16 + _i * 8192), (LAS unsigned*)(lds + PG8_SB6(b) + ldsw + _i * 8192), 16, 0, 0); } \
        else { PG8_STAGE(PG8_SB(b, 0), gsrc, voffB); PG8_STAGE(PG8_SB(b, 1), (gsrc) + hstep, voffB); } } while (0)
#define PG8_LDB6(dst, b, h) do { const u32x4 p0_ = *(const LAS u32x4*)(lds + PG8_SB6(b) + (h) * 12288 + b6o * 16), p1_ = *(const LAS u32x4*)(lds + PG8_SB6(b) + (h) * 12288 + b6o * 16 + 1024), \
        q_ = *(const LAS u32x4*)(lds + PG8_SB6(b) + (h) * 12288 + 8192 + b6q * 16); \
        dst##c = (v12i){(int)p0_.x, (int)p0_.y, (int)p0_.z, (int)p0_.w, (int)q_.x, (int)q_.y, (int)q_.z, (int)q_.w, (int)p1_.x, (int)p1_.y, (int)p1_.z, (int)p1_.w}; } while (0)
#define PG8_B6SEL(x, n) ((n) == 0 ? __builtin_shufflevector(x, x, 0, 1, 2, 3, 4, 5) : __builtin_shufflevector(x, x, 6, 7, 8, 9, 10, 11))
#define PG8_STAGEA3(sb, h, gbase, voff) do { _Pragma("unroll") for (int _i = 0; _i < 2; ++_i) \
        __builtin_amdgcn_global_load_lds((const unsigned*)((const char*)(gbase) + (voff)[_i]), (LAS unsigned*)(lds + (sb) + (h) * 16384 + ldsw + _i * 8192), 16, 0, P::A_AUX); } while (0)
#define PG8_LDA3(dst, sb, h) do { const LAS unsigned char* la_ = lds + (sb) + (h) * 16384; _Pragma("unroll") for (int m = 0; m < 4; ++m) _Pragma("unroll") for (int k = 0; k < 2; ++k) dst[m][k] = *(const LAS bf16x8*)(la_ + aoffk[k] + m * 2048); } while (0)
#define PG8_LDA(dst, b, h) do { _Pragma("unroll") for (int m = 0; m < 4; ++m) _Pragma("unroll") for (int k = 0; k < 2; ++k) dst[m][k] = *(const LAS bf16x8*)(lds + PG8_SA(b, h) + aoffk[k] + m * 2048); } while (0)
#define PG8_LDB(dst, b, h) do { if constexpr (P::B6) PG8_LDB6(dst, b, h); else PG8_LDB8(dst, b, h); } while (0)
#define PG8_LDB8(dst, b, h) do { _Pragma("unroll") for (int n = 0; n < 2; ++n) _Pragma("unroll") for (int k = 0; k < 2; ++k) dst[n][k] = *(const LAS bf16x8*)(lds + PG8_SB(b, h) + boffk[k] + n * 2048); } while (0)
#define PG8_CAT(x) __builtin_bit_cast(v8i, __builtin_shufflevector(x[0], x[1], 0, 1, 2, 3, 4, 5, 6, 7, 8, 9, 10, 11, 12, 13, 14, 15))
#define PG8_MMA(ai, bj, At, Bt) do { __builtin_amdgcn_s_setprio(1); _Pragma("unroll") for (int m = 0; m < 4; ++m) _Pragma("unroll") for (int n = 0; n < 2; ++n) { \
        if constexpr (P::B6) asm volatile("s_nop 1\n\tv_mfma_scale_f32_16x16x128_f8f6f4 %0, %1, %2, %0, %3, %4 op_sel_hi:[0,0,0] cbsz:2" : "+v"(acc[ai][bj][m][n]) : "v"(PG8_B6SEL(Bt##c, n)), "v"(PG8_CAT(At[m])), "v"(scw_), "v"(scx_)); \
        else if constexpr (P::FP8) asm volatile("v_mfma_scale_f32_16x16x128_f8f6f4 %0, %1, %2, %0, %3, %4 op_sel_hi:[0,0,0]" : "+v"(acc[ai][bj][m][n]) : "v"(PG8_CAT(Bt[n])), "v"(PG8_CAT(At[m])), "v"(scw_), "v"(scx_)); \
        else { _Pragma("unroll") for (int k = 0; k < 2; ++k) acc[ai][bj][m][n] = __builtin_amdgcn_mfma_f32_16x16x32_bf16(Bt[n][k], At[m][k], acc[ai][bj][m][n], 0, 0, 0); } } \
        __builtin_amdgcn_s_setprio(0); } while (0)
#define PG8_WAIT_V(n) asm volatile("s_waitcnt vmcnt(" #n ")" ::: "memory")
#define PG8_WAIT_VL do { if constexpr (P::B6) PG8_WAIT_V(7); else PG8_WAIT_V(8); PG8_WAIT_L(0); } while (0)
#define PG8_WAIT_L(n) asm volatile("s_waitcnt lgkmcnt(" #n ")" ::: "memory")
#define PG8_BAR __builtin_amdgcn_s_barrier()
#define PG8_SCHED __builtin_amdgcn_sched_barrier(0)
    Unit cur, nxt; int ui = 0;
    if (!S.next(0, cur)) return;
    if constexpr (P::STAGGER > 0) {
        const unsigned long long t0 = __builtin_amdgcn_s_memrealtime(); const unsigned long long dl = (unsigned long long)(((unsigned)blockIdx.x >> 3) & 3u) * (unsigned long long)P::STAGGER;
        while (__builtin_amdgcn_s_memrealtime() - t0 < dl) __builtin_amdgcn_s_sleep(8);
    }
    f32x4 acc[2][2][4][2];
#pragma unroll
    for (int a = 0; a < 2; ++a)
#pragma unroll
        for (int b = 0; b < 2; ++b)
#pragma unroll
            for (int m = 0; m < 4; ++m)
#pragma unroll
                for (int n = 0; n < 2; ++n) acc[a][b][m][n] = (f32x4){0.f, 0.f, 0.f, 0.f};
    bf16x8 At[4][2], B0[2][2], B1[2][2]; v12i B0c, B1c;
    unsigned vC[2][2], vN[2][2];
    S.a_voff(cur, RA, CA, vC);
    const char* cA = S.a_ptr(cur); const char* cB = S.b_ptr(cur);
    int s0 = 0;
    if constexpr (P::A3) {
        PG8_STAGEB(0, cB); PG8_STAGEA3(0, 0, cA, vC[0]); PG8_STAGEA3(0, 1, cA, vC[1]);
        if (wr == 1) PG8_BAR;
        PG8_WAIT_V(2); PG8_BAR;
        PG8_STAGEB(1, cB + kstepB); PG8_STAGEA3(32768, 0, cA + kstep, vC[0]); PG8_STAGEA3(32768, 1, cA + kstep, vC[1]); PG8_STAGEA3(65536, 0, cA + 2 * kstep, vC[0]);
        PG8_WAIT_V(9);
        PG8_BAR;
    } else {
    PG8_STAGEB(0, cB); PG8_STAGEA(PG8_SA(0, 0), cA, vC[0]); PG8_STAGEA(PG8_SA(0, 1), cA, vC[1]);
    if (wr == 1) PG8_BAR;
    PG8_WAIT_V(2); PG8_BAR;
    PG8_STAGEB(1, cB + kstepB); PG8_STAGEA(PG8_SA(1, 0), cA + kstep, vC[0]);
    if constexpr (P::B6) PG8_WAIT_V(5); else PG8_WAIT_V(6);
    PG8_BAR;
    }
    for (;;) {
        const bool has_next = S.next(ui + 1, nxt);
        const char* nA = cA; const char* nB = cB;
#pragma unroll
        for (int h = 0; h < 2; ++h)
#pragma unroll
            for (int i = 0; i < 2; ++i) vN[h][i] = vC[h][i];
        if (has_next) { nA = S.a_ptr(nxt); nB = S.b_ptr(nxt); if constexpr (!P::SIDE) S.a_voff(nxt, RA, CA, vN); }
        if constexpr (P::SIDE) S.side_issue(cur, nxt, has_next, ui, wid, lane, lds);
        if constexpr (P::A3) {
            static_assert(P::KREP == 1 && nt >= 4, "A3");
            for (int tt_ = 0; tt_ < nt; tt_ += 2) { const int t = tt_;
                const bool last = (tt_ == nt - 2), pre = (tt_ >= nt - 4);
                if constexpr (P::SIDE) { if (tt_ == nt - 4 && has_next) S.a_voff_side(nxt, ui + 1, RA, CA, vN, lds); }
                const int s1 = s0 == 65536 ? 0 : s0 + 32768, s2 = s1 == 65536 ? 0 : s1 + 32768;
                const char* a2 = last ? nA : cA + (size_t)(t + 2) * kstep;
                const char* a3 = last ? nA + kstep : cA + (size_t)(t + 3) * kstep;
                const char* a4 = last ? nA + 2 * kstep : (pre ? nA : cA + (size_t)(t + 4) * kstep);
                const char* b2 = last ? nB : cB + (size_t)(t + 2) * kstepB; const char* b3 = b2 + kstepB;
                unsigned vL[2][2], vP[2];
#pragma unroll
                for (int i = 0; i < 2; ++i) { vL[0][i] = last ? vN[0][i] : vC[0][i]; vL[1][i] = last ? vN[1][i] : vC[1][i]; vP[i] = pre ? vN[0][i] : vC[0][i]; }
                PG8_LDB(B0, 0, 0); PG8_LDB(B1, 0, 1); PG8_SCHED; PG8_LDA3(At, s0, 0); PG8_STAGEA3(s2, 1, a2, vL[1]);
                PG8_WAIT_V(14); PG8_WAIT_L(0); PG8_BAR; PG8_MMA(0, 0, At, B0); PG8_MMA(0, 1, At, B1); PG8_BAR; PG8_SCHED;
                PG8_LDA3(At, s0, 1); PG8_STAGEB(0, b2); PG8_STAGEA3(s0, 0, a3, vL[0]);
                PG8_WAIT_V(9); PG8_WAIT_L(0); PG8_BAR; PG8_MMA(1, 0, At, B0); PG8_MMA(1, 1, At, B1); PG8_BAR; PG8_SCHED;
                PG8_LDB(B0, 1, 0); PG8_LDB(B1, 1, 1); PG8_SCHED; PG8_LDA3(At, s1, 0); PG8_STAGEA3(s0, 1, a3, vL[1]);
                PG8_WAIT_V(14); PG8_WAIT_L(0); PG8_BAR; PG8_MMA(0, 0, At, B0); PG8_MMA(0, 1, At, B1); PG8_BAR; PG8_SCHED;
                PG8_LDA3(At, s1, 1); PG8_STAGEB(1, b3); PG8_STAGEA3(s1, 0, a4, vP);
                PG8_WAIT_V(9); PG8_WAIT_L(0); PG8_BAR; PG8_MMA(1, 0, At, B0); PG8_MMA(1, 1, At, B1); PG8_BAR; PG8_SCHED;
                s0 = s2;
            }
        } else
        for (int tt_ = 0; tt_ < nt * P::KREP; tt_ += 2) { const int t = tt_ & (nt - 1);
            const bool last = (tt_ == nt * P::KREP - 2);
            const char* a1 = cA + (size_t)(t + 1) * kstep;
            const char* a2 = last ? nA : cA + (size_t)((t + 2) & (nt - 1)) * kstep; const char* b2 = last ? nB : cB + (size_t)((t + 2) & (nt - 1)) * kstepB;
            const char* a3 = a2 + kstep; const char* b3 = b2 + kstepB;
            if constexpr (P::SIDE) { if (last && has_next) S.a_voff_side(nxt, ui + 1, RA, CA, vN, lds); }
            unsigned vS[2][2];
#pragma unroll
            for (int h = 0; h < 2; ++h)
#pragma unroll
                for (int i = 0; i < 2; ++i) vS[h][i] = last ? vN[h][i] : vC[h][i];
            PG8_LDB(B0, 0, 0); PG8_LDB(B1, 0, 1); PG8_SCHED; PG8_LDA(At, 0, 0); PG8_STAGEA(PG8_SA(1, 1), a1, vC[1]);
            PG8_WAIT_VL; PG8_BAR; PG8_MMA(0, 0, At, B0); PG8_MMA(0, 1, At, B1); PG8_BAR; PG8_SCHED;
            PG8_LDA(At, 0, 1); PG8_STAGEB(0, b2); PG8_STAGEA(PG8_SA(0, 0), a2, vS[0]);
            PG8_WAIT_VL; PG8_BAR; PG8_MMA(1, 0, At, B0); PG8_MMA(1, 1, At, B1); PG8_BAR; PG8_SCHED;
            PG8_LDB(B0, 1, 0); PG8_LDB(B1, 1, 1); PG8_SCHED; PG8_LDA(At, 1, 0); PG8_STAGEA(PG8_SA(0, 1), a2, vS[1]);
            PG8_WAIT_VL; PG8_BAR; PG8_MMA(0, 0, At, B0); PG8_MMA(0, 1, At, B1); PG8_BAR; PG8_SCHED;
            PG8_LDA(At, 1, 1); PG8_STAGEB(1, b3); PG8_STAGEA(PG8_SA(1, 0), a3, vS[0]);
            PG8_WAIT_VL; PG8_BAR; PG8_MMA(1, 0, At, B0); PG8_MMA(1, 1, At, B1); PG8_BAR; PG8_SCHED;
        }
        if constexpr (ALIGN_EPI) { if (wr == 0) PG8_BAR; }
        if constexpr (P::FP8) asm volatile("s_nop 15\n\ts_nop 7" ::: "memory");
        if constexpr (P::KREP == 2) {
#pragma unroll
            for (int a = 0; a < 2; ++a)
#pragma unroll
                for (int b = 0; b < 2; ++b)
#pragma unroll
                    for (int m = 0; m < 4; ++m)
#pragma unroll
                        for (int n = 0; n < 2; ++n) acc[a][b][m][n] = acc[a][b][m][n] * 0.5f; }
        S.epi(acc, cur, ui, wr, wc, fr, fq, lds);
#ifdef PROBE_EPI2
        if constexpr (P::IDEM) { asm volatile("" ::: "memory"); S.epi(acc, cur, ui, wr, wc, fr, fq, lds); }
#endif
        if (!has_next) break;
#pragma unroll
        for (int a = 0; a < 2; ++a)
#pragma unroll
            for (int b = 0; b < 2; ++b)
#pragma unroll
                for (int m = 0; m < 4; ++m)
#pragma unroll
                    for (int n = 0; n < 2; ++n) acc[a][b][m][n] = (f32x4){0.f, 0.f, 0.f, 0.f};
        cur = nxt; cA = nA; cB = nB; ++ui;
#pragma unroll
        for (int h = 0; h < 2; ++h)
#pragma unroll
            for (int i = 0; i < 2; ++i) vC[h][i] = vN[h][i];
        if constexpr (ALIGN_EPI) { if (wr == 1) PG8_BAR; }
    }
    PG8_WAIT_V(0);
    if constexpr (!ALIGN_EPI) { if (wr == 0) PG8_BAR; }
    PG8_BAR;
#undef PG8_SA
#undef PG8_SB
#undef PG8_STAGE
#undef PG8_STAGEA
#undef PG8_STAGEA3
#undef PG8_LDA3
#undef PG8_SB6
#undef PG8_STAGEB
#undef PG8_LDB6
#undef PG8_B6SEL
#undef PG8_LDB8
#undef PG8_WAIT_VL
#undef PG8_LDA
#undef PG8_LDB
#undef PG8_MMA
#undef PG8_CAT
#undef PG8_WAIT_V
#undef PG8_WAIT_L
#undef PG8_BAR
#undef PG8_SCHED
}

struct DenseBase {
    const bf16_t* A; const bf16_t* Bt; int nM, nN, G, c;
    __device__ __forceinline__ bool next(int i, Unit& u) const { int pm, pn; if (!tile_order<WGM_DENSE>(i, G, c, nM, nN, pm, pn)) return false; u.pm = pm; u.pn = pn; u.e = 0; u.row0 = 0; u.nrows = 256; u.arow = pm * 256; return true; }
    __device__ __forceinline__ const char* a_ptr(const Unit& u) const { return (const char*)A + (size_t)u.pm * (size_t)(BM * KD * 2); }
    __device__ __forceinline__ const char* b_ptr(const Unit& u) const { return (const char*)Bt + (size_t)u.pn * (size_t)(BM * KD * 2); }
    __device__ __forceinline__ void a_voff(const Unit&, const int (&RA)[2], const int (&CA)[2], unsigned (&v)[2][2]) const {
#pragma unroll
        for (int h = 0; h < 2; ++h)
#pragma unroll
            for (int i = 0; i < 2; ++i) v[h][i] = (unsigned)((RA[i] + HALF * h) * KD + CA[i]) * 2u; }
};

struct ProbInProj : DenseBase {
    static constexpr bool PERM = true;
#ifdef PROBE_KX2_ProbInProj
    static constexpr int KREP = 2;
#else
    static constexpr int KREP = 1;
#endif
    static constexpr bool SIDE = false, IDEM = false, FP8 = false; static constexpr int SCW = 0, SCX = 0;
#ifndef STG_P1
#define STG_P1 0
#endif
    static constexpr int STAGGER = STG_P1, A_AUX = 0; static constexpr bool B6 = false, A3 = false;
    bf16_t* PROJ; const float* rc; const float* rs; const float* mc; const float* ms; float* ksum;
    __device__ __forceinline__ void epi(const f32x4 (&acc)[2][2][4][2], const Unit& u, int, int wr, int wc, int fr, int fq, LAS unsigned char*) const {
        const int pn = u.pn; const int rowt = u.pm * BM + wr * 64 + fr;
        if (pn <= 1) {
            const float sc = pn == 0 ? 1.f : 0.125f;
#pragma unroll
            for (int ai = 0; ai < 2; ++ai)
#pragma unroll
                for (int m = 0; m < 4; ++m) { const int row = rowt + ai * HALF + m * 16, s = row & (SEQ - 1);
                    const f32x4 c0 = *(const f32x4*)(rc + s * 32 + 8 * fq), c1 = *(const f32x4*)(rc + s * 32 + 8 * fq + 4);
                    const f32x4 s0 = *(const f32x4*)(rs + s * 32 + 8 * fq), s1 = *(const f32x4*)(rs + s * 32 + 8 * fq + 4);
                    const f32x4 a0 = acc[ai][0][m][0], a1 = acc[ai][0][m][1], b0 = acc[ai][1][m][0], b1 = acc[ai][1][m][1];
                    const f32x4 o10 = (a0 * c0 - b0 * s0) * sc, o11 = (a1 * c1 - b1 * s1) * sc, o20 = (a0 * s0 + b0 * c0) * sc, o21 = (a1 * s1 + b1 * c1) * sc;
                    bf16_t* dst = PROJ + (size_t)row * DIN + pn * 256 + 64 * wc + 8 * fq;
                    *(u32x4*)dst = pack8(o10, o11); *(u32x4*)(dst + 32) = pack8(o20, o21); asm volatile("" ::: "memory"); }
        } else if (pn >= 6 && pn <= 9) {
            const bool rot = ((wc & 1) == 0) && (fq < 2); const float sc = pn < 8 ? QC2 : 1.f; const bool isk = pn >= 8;
            f32x4 ks[2][2];
#pragma unroll
            for (int bj = 0; bj < 2; ++bj)
#pragma unroll
                for (int n = 0; n < 2; ++n) ks[bj][n] = (f32x4){0.f, 0.f, 0.f, 0.f};
#pragma unroll
            for (int ai = 0; ai < 2; ++ai)
#pragma unroll
                for (int m = 0; m < 4; ++m) { const int row = rowt + ai * HALF + m * 16, s = row & (SEQ - 1);
                    f32x4 c = *(const f32x4*)(mc + s * 8 + 4 * (fq & 1)), sn = *(const f32x4*)(ms + s * 8 + 4 * (fq & 1));
                    if (!rot) { c = (f32x4){1.f, 1.f, 1.f, 1.f}; sn = (f32x4){0.f, 0.f, 0.f, 0.f}; }
#pragma unroll
                    for (int bj = 0; bj < 2; ++bj) { const f32x4 v0 = acc[ai][bj][m][0], v1 = acc[ai][bj][m][1];
                        const f32x4 n0 = (v0 * c - v1 * sn) * sc, n1 = (v0 * sn + v1 * c) * sc;
                        if (isk) { ks[bj][0] += n0; ks[bj][1] += n1; asm volatile("" : "+v"(ks[bj][0]), "+v"(ks[bj][1])); }
                        *(u32x4*)(PROJ + (size_t)row * DIN + pn * 256 + bj * HALF + 32 * wc + 8 * fq) = pack8(n0, n1); }
                    asm volatile("" ::: "memory"); }
            if (isk) {
#pragma unroll
                for (int bj = 0; bj < 2; ++bj)
#pragma unroll
                    for (int n = 0; n < 2; ++n)
#pragma unroll
                        for (int e = 0; e < 4; ++e) { float v = ks[bj][n][e]; v += __shfl_xor(v, 1); v += __shfl_xor(v, 2); v += __shfl_xor(v, 4); v += __shfl_xor(v, 8); ks[bj][n][e] = v; }
                if (fr == 0) {
#pragma unroll
                    for (int bj = 0; bj < 2; ++bj)
#pragma unroll
                        for (int n = 0; n < 2; ++n) *(f32x4*)(ksum + ((size_t)u.pm * 2 + wr) * 512 + (pn - 8) * 256 + bj * HALF + 32 * wc + 8 * fq + 4 * n) = ks[bj][n]; }
            }
        } else {
#pragma unroll
            for (int ai = 0; ai < 2; ++ai)
#pragma unroll
                for (int m = 0; m < 4; ++m) { const int row = rowt + ai * HALF + m * 16;
#pragma unroll
                    for (int bj = 0; bj < 2; ++bj) *(u32x4*)(PROJ + (size_t)row * DIN + pn * 256 + bj * HALF + 32 * wc + 8 * fq) = pack8(acc[ai][bj][m][0], acc[ai][bj][m][1]); }
        }
    }
};

struct ProbOutProj : DenseBase {
    static constexpr bool PERM = true;
#ifdef PROBE_KX2_ProbOutProj
    static constexpr int KREP = 2;
#else
    static constexpr int KREP = 1;
#endif
    static constexpr bool SIDE = false, IDEM = false, FP8 = false; static constexpr int SCW = 0, SCX = 0, STAGGER = 0, A_AUX = 0; static constexpr bool B6 = false, A3 = false;
    bf16_t* D;
    __device__ __forceinline__ void epi(const f32x4 (&acc)[2][2][4][2], const Unit& u, int, int wr, int wc, int fr, int fq, LAS unsigned char*) const {
        const int row0 = u.pm * BM + wr * 64 + fr, col0 = u.pn * BM + wc * 32 + 8 * fq;
#pragma unroll
        for (int ai = 0; ai < 2; ++ai)
#pragma unroll
            for (int m = 0; m < 4; ++m) { bf16_t* p = D + (size_t)(row0 + ai * HALF + m * 16) * DM + col0;
#pragma unroll
                for (int bj = 0; bj < 2; ++bj) *(u32x4*)(p + bj * HALF) = pack8(acc[ai][bj][m][0], acc[ai][bj][m][1]); }
    }
};

struct MoeBase {
    int T, NP, G, c; int tp_lane, cp_lane;
    __device__ __forceinline__ void load_tables(const LAS int* tpre, const LAS int* cpre) { const int l = (int)(threadIdx.x & 63), i = l < 32 ? l : 32; tp_lane = tpre[i]; cp_lane = cpre[i]; }
    __device__ __forceinline__ bool next(int i, Unit& u) const {
        int pm, pn; if (!tile_order<WGM_MOE>(i, G, c, T, NP, pm, pn)) return false;
        const unsigned long long m = __ballot(tp_lane <= pm) & 0x1ffffffffull;
        int e = __builtin_popcountll(m) - 1; e = e > NEXP - 1 ? NEXP - 1 : e;
        const int t0 = __builtin_amdgcn_readlane(tp_lane, e), c0 = __builtin_amdgcn_readlane(cp_lane, e), c1 = __builtin_amdgcn_readlane(cp_lane, e + 1);
        u.pm = pm; u.pn = pn; u.e = e; u.row0 = (pm - t0) * 256; const int rem = (c1 - c0) - u.row0; u.nrows = rem < 256 ? rem : 256; u.arow = c0 + u.row0; return true;
    }
};
constexpr int SIDE_OFF = RING_BYTES + 1024, SIDE_PAR = 4096, SD_SLOT = 0, SD_ROW = 1024, SD_BIAS = 2048;
__device__ __forceinline__ void side_dma(const void* gsrc_lane, LAS unsigned char* dst_wave) { __builtin_amdgcn_global_load_lds((const unsigned*)gsrc_lane, (LAS unsigned*)dst_wave, 16, 0, 0); }
struct ProbMoe1 : MoeBase {
    static constexpr bool PERM = true, SIDE = true, IDEM = true, FP8 = true;
    static constexpr int SCW = 0x79797979, SCX = 0x7f7f7f7f;
#ifndef STG_P5
#define STG_P5 0
#endif
    static constexpr int STAGGER = STG_P5, A_AUX = AUX_P5; static constexpr bool B6 = (MOE_B6 != 0), A3 = B6 && (MOE_A3 != 0);
#ifdef PROBE_KX2_ProbMoe1
    static constexpr int KREP = 2;
#else
    static constexpr int KREP = 1;
#endif
    const unsigned char* H2; const unsigned char* W1T; const int* slot; const float* srstd; const float* b1; unsigned char* ACT;
    __device__ __forceinline__ const char* a_ptr(const Unit&) const { return (const char*)H2; }
    __device__ __forceinline__ const char* b_ptr(const Unit& u) const { return (const char*)W1T + ((size_t)u.e * 2048 + (size_t)u.pn * 256) * (size_t)(B6 ? 768 : KD); }
    __device__ __forceinline__ void a_voff(const Unit& u, const int (&RA)[2], const int (&CA)[2], unsigned (&v)[2][2]) const {
#pragma unroll
        for (int h = 0; h < 2; ++h)
#pragma unroll
            for (int i = 0; i < 2; ++i) { int r = RA[i] + HALF * h; r = r < u.nrows ? r : u.nrows - 1; const int pair = slot[(size_t)u.e * NTOK + u.row0 + r]; v[h][i] = (unsigned)(pair >> 2) * (unsigned)KD + (unsigned)CA[i] * 2u; } }
    __device__ __forceinline__ void a_voff_side(const Unit& u, int uin, const int (&RA)[2], const int (&CA)[2], unsigned (&v)[2][2], LAS unsigned char* lds) const {
        const LAS int* sb = (const LAS int*)(lds + SIDE_OFF + (uin & 1) * SIDE_PAR + SD_SLOT);
#pragma unroll
        for (int h = 0; h < 2; ++h)
#pragma unroll
            for (int i = 0; i < 2; ++i) { int r = RA[i] + HALF * h; r = r < u.nrows ? r : u.nrows - 1; const int pair = sb[r]; v[h][i] = (unsigned)(pair >> 2) * (unsigned)KD + (unsigned)CA[i] * 2u; } }
    __device__ __forceinline__ void side_issue(const Unit& cur, const Unit& nxt, bool has_next, int ui, int wid, int lane, LAS unsigned char* lds) const {
        if (wid == 0) { if (has_next) side_dma(slot + (size_t)nxt.e * NTOK + nxt.row0 + 4 * lane, lds + SIDE_OFF + ((ui + 1) & 1) * SIDE_PAR + SD_SLOT); }
        else if (wid == 1) side_dma(srstd + (size_t)cur.e * NTOK + cur.row0 + 4 * lane, lds + SIDE_OFF + (ui & 1) * SIDE_PAR + SD_ROW);
        else if (wid == 2) side_dma(b1 + (size_t)cur.e * 2048 + 128 * cur.pn + ((lane >> 5) * 1024) + 4 * (lane & 31), lds + SIDE_OFF + (ui & 1) * SIDE_PAR + SD_BIAS);
    }
    __device__ __forceinline__ void epi(const f32x4 (&acc)[2][2][4][2], const Unit& u, int ui, int wr, int wc, int fr, int fq, LAS unsigned char* lds) const {
        const LAS unsigned char* sd = lds + SIDE_OFF + (ui & 1) * SIDE_PAR;
        const int cc0 = 32 * wc + 8 * fq; const LAS float* bb = (const LAS float*)(sd + SD_BIAS) + cc0; const LAS float* rsb = (const LAS float*)(sd + SD_ROW);
        constexpr float CE = -1.702f * 1.4426950408889634f, K4 = 4.0f / CE;
        const f32x4 bg0 = *(const LAS f32x4*)bb * CE, bg1 = *(const LAS f32x4*)(bb + 4) * CE, bl0 = *(const LAS f32x4*)(bb + 128), bl1 = *(const LAS f32x4*)(bb + 132);
        const f32x4 tlo = (f32x4){7.f * CE, 7.f * CE, 7.f * CE, 7.f * CE}, one4 = (f32x4){1.f, 1.f, 1.f, 1.f}, k4 = (f32x4){K4, K4, K4, K4};
#pragma unroll
        for (int ai = 0; ai < 2; ++ai)
#pragma unroll
            for (int m = 0; m < 4; ++m) { const int r = ai * HALF + wr * 64 + m * 16 + fr; const bool valid = r < u.nrows;
                const float rs = rsb[r], rsc = rs * CE;
                f32x4 o[2];
#pragma unroll
                for (int n = 0; n < 2; ++n) { f32x4 t = __builtin_elementwise_max(acc[ai][0][m][n] * rsc + (n ? bg1 : bg0), tlo), l = acc[ai][1][m][n] * rs + (n ? bl1 : bl0), e, sg;
#pragma unroll
                    for (int q = 0; q < 4; ++q) { e[q] = __builtin_amdgcn_exp2f(t[q]); l[q] = __builtin_amdgcn_fmed3f(l[q], -7.f, 7.f); }
                    e = e + one4;
#pragma unroll
                    for (int q = 0; q < 4; ++q) sg[q] = __builtin_amdgcn_rcpf(e[q]);
                    o[n] = (t * sg) * (l * k4 + k4); }
                if (valid) *(u32x2*)(ACT + (size_t)(u.arow + r) * DM + 128 * u.pn + cc0) = pack8_fp8(o[0], o[1]); }
    }
};
struct ProbMoe2 : MoeBase {
    static constexpr bool PERM = true, SIDE = true, IDEM = true, FP8 = true;
    static constexpr int SCW = 0x79797979, SCX = 0x7d7d7d7d;
#ifndef STG_P6
#define STG_P6 0
#endif
    static constexpr int STAGGER = STG_P6, A_AUX = AUX_P6; static constexpr bool B6 = (MOE_B6 != 0), A3 = B6 && (MOE_A3 != 0);
#ifdef PROBE_KX2_ProbMoe2
    static constexpr int KREP = 2;
#else
    static constexpr int KREP = 1;
#endif
    const unsigned char* ACT; const unsigned char* W2T; const int* slot; const float* sgate; const float* b2; unsigned char* Y4;
    __device__ __forceinline__ const char* a_ptr(const Unit& u) const { return (const char*)ACT + (size_t)u.arow * (size_t)KD; }
    __device__ __forceinline__ const char* b_ptr(const Unit& u) const { return (const char*)W2T + ((size_t)u.e * 1024 + (size_t)u.pn * 256) * (size_t)(B6 ? 768 : KD); }
    __device__ __forceinline__ void a_voff(const Unit& u, const int (&RA)[2], const int (&CA)[2], unsigned (&v)[2][2]) const {
#pragma unroll
        for (int h = 0; h < 2; ++h)
#pragma unroll
            for (int i = 0; i < 2; ++i) { int r = RA[i] + HALF * h; r = r < u.nrows ? r : u.nrows - 1; v[h][i] = (unsigned)(r * KD + CA[i] * 2); } }
    __device__ __forceinline__ void a_voff_side(const Unit& u, int, const int (&RA)[2], const int (&CA)[2], unsigned (&v)[2][2], LAS unsigned char*) const { a_voff(u, RA, CA, v); }
    __device__ __forceinline__ void side_issue(const Unit& cur, const Unit&, bool, int ui, int wid, int lane, LAS unsigned char* lds) const {
        if (wid == 0) side_dma(slot + (size_t)cur.e * NTOK + cur.row0 + 4 * lane, lds + SIDE_OFF + (ui & 1) * SIDE_PAR + SD_SLOT);
        else if (wid == 1) side_dma(sgate + (size_t)cur.e * NTOK + cur.row0 + 4 * lane, lds + SIDE_OFF + (ui & 1) * SIDE_PAR + SD_ROW);
        else if (wid == 2) side_dma(b2 + (size_t)cur.e * 1024 + 256 * cur.pn + 4 * lane, lds + SIDE_OFF + (ui & 1) * SIDE_PAR + SD_BIAS);
    }
    __device__ __forceinline__ void epi(const f32x4 (&acc)[2][2][4][2], const Unit& u, int ui, int wr, int wc, int fr, int fq, LAS unsigned char* lds) const {
        const LAS unsigned char* sd = lds + SIDE_OFF + (ui & 1) * SIDE_PAR;
        const int cl0 = 32 * wc + 8 * fq, col0 = u.pn * BM + cl0; const LAS float* bb = (const LAS float*)(sd + SD_BIAS) + cl0;
        const LAS int* psb = (const LAS int*)(sd + SD_SLOT); const LAS float* gsb = (const LAS float*)(sd + SD_ROW);
        f32x4 bv[2][2];
#pragma unroll
        for (int bj = 0; bj < 2; ++bj)
#pragma unroll
            for (int n = 0; n < 2; ++n) bv[bj][n] = *(const LAS f32x4*)(bb + bj * HALF + 4 * n);
#pragma unroll
        for (int ai = 0; ai < 2; ++ai)
#pragma unroll
            for (int m = 0; m < 4; ++m) { const int r = ai * HALF + wr * 64 + m * 16 + fr; const bool valid = r < u.nrows;
                const int pair = psb[r]; const float gt = gsb[r] * 8.f;
                if (valid) { unsigned char* p = Y4 + (size_t)pair * DM + col0;
#pragma unroll
                    for (int bj = 0; bj < 2; ++bj) *(u32x2*)(p + bj * HALF) = pack8_fp8((acc[ai][bj][m][0] + bv[bj][0]) * gt, (acc[ai][bj][m][1] + bv[bj][1]) * gt); } }
    }
};
}

namespace moba {
using bf16 = __hip_bfloat16;
constexpr int D = 64, PP = DIN, OP = DM;
constexpr int NW = 8, QBLK = 32, QB = QBLK * NW, KVBLK = 64;
__device__ __forceinline__ int crow(int r, int hi) { return (r & 3) + 8 * (r >> 2) + 4 * hi; }
#define SBAR() __builtin_amdgcn_sched_barrier(0)
__device__ __forceinline__ void cmask(f32x16& p0, f32x16& p1, int jb, int qrel, int hi) {
  const float NEG = -INFINITY; int kb = 64 * jb + 4 * hi;
  #pragma unroll
  for (int r = 0; r < 16; ++r) { int kv = kb + (r & 3) + 8 * (r >> 2); if (kv > qrel) p0[r] = NEG; if (kv + 32 > qrel) p1[r] = NEG; }
}
constexpr int NSLOT = 3, SLOTB = 8192;
constexpr int LDS_K = 0, LDS_V = NSLOT * SLOTB, LDS_WS = 2 * NSLOT * SLOTB, LDS_OST = LDS_WS + NW * 64 * 4, LDS_BYTES_A = LDS_OST + NW * 4096;
__device__ __forceinline__ void glds16s(const void* sbase, unsigned voff, unsigned lds_dst) { unsigned keep;
  asm volatile("s_mov_b32 %0, m0\n\ts_mov_b32 m0, %3\n\ts_nop 4\n\tglobal_load_lds_dwordx4 %1, %2\n\ts_mov_b32 m0, %0" : "=&s"(keep) : "v"(voff), "s"(sbase), "s"(lds_dst) : "memory"); }
__device__ __forceinline__ float max3f(float a, float b, float c) { float r; asm("v_max3_f32 %0, %1, %2, %3" : "=v"(r) : "v"(a), "v"(b), "v"(c)); return r; }
__device__ __forceinline__ float max2f(float a, float b) { float r; asm("v_max_f32_e32 %0, %1, %2" : "=v"(r) : "v"(a), "v"(b)); return r; }
__device__ __forceinline__ float fadd_s(float a, float b) { float r; asm("v_add_f32_e32 %0, %1, %2" : "=v"(r) : "v"(a), "v"(b)); return r; }
__device__ __forceinline__ float fsub_s(float a, float b) { float r; asm("v_sub_f32_e32 %0, %1, %2" : "=v"(r) : "v"(a), "v"(b)); return r; }
typedef __bf16 bf16x2_t __attribute__((ext_vector_type(2)));
__device__ __forceinline__ unsigned cvtpk_s(float lo, float hi) { f32x2 v = {lo, hi}; bf16x2_t b = __builtin_convertvector(v, bf16x2_t); return __builtin_bit_cast(unsigned, b); }
#define WAIT_BAR(N) asm volatile("s_waitcnt vmcnt(" #N ") lgkmcnt(0)\n\ts_barrier" ::: "memory")
__device__ __forceinline__ void qkt(f32x16& p0, f32x16& p1, const char* Kslot, const bf16x8* qr, const f32x16& negm, int r32, int hi) {
  const char* kb = Kslot + hi * 1024 + r32 * 16;
  #pragma unroll
  for (int d0 = 0; d0 < 4; ++d0) {
    const bf16x8 b0 = *reinterpret_cast<const bf16x8*>(kb + d0 * 2048);
    const bf16x8 b1 = *reinterpret_cast<const bf16x8*>(kb + d0 * 2048 + 512);
    if (d0 == 0) { p0 = __builtin_amdgcn_mfma_f32_32x32x16_bf16(b0, qr[0], negm, 0, 0, 0); p1 = __builtin_amdgcn_mfma_f32_32x32x16_bf16(b1, qr[0], negm, 0, 0, 0); }
    else { p0 = __builtin_amdgcn_mfma_f32_32x32x16_bf16(b0, qr[d0], p0, 0, 0, 0); p1 = __builtin_amdgcn_mfma_f32_32x32x16_bf16(b1, qr[d0], p1, 0, 0, 0); } }
}
typedef LAS const char* lds_cptr;
typedef short v4i16_t __attribute__((ext_vector_type(4)));
__device__ __forceinline__ void kload8(bf16x8* kf, lds_cptr kp) {
  kf[0] = *(const LAS bf16x8*)(kp);        kf[1] = *(const LAS bf16x8*)(kp + 512);
  kf[2] = *(const LAS bf16x8*)(kp + 2048); kf[3] = *(const LAS bf16x8*)(kp + 2560);
  kf[4] = *(const LAS bf16x8*)(kp + 4096); kf[5] = *(const LAS bf16x8*)(kp + 4608);
  kf[6] = *(const LAS bf16x8*)(kp + 6144); kf[7] = *(const LAS bf16x8*)(kp + 6656);
}
__device__ __forceinline__ void kload2(bf16x8* kf, lds_cptr kp, int j) { kf[2 * j] = *(const LAS bf16x8*)(kp + j * 2048); kf[2 * j + 1] = *(const LAS bf16x8*)(kp + j * 2048 + 512); }
__device__ __forceinline__ s16x4 vtr(lds_cptr p) { return __builtin_bit_cast(s16x4, __builtin_amdgcn_ds_read_tr16_b64_v4i16((LAS v4i16_t*)p)); }
__device__ __forceinline__ float rowmax(const f32x16& p0, const f32x16& p1) {
  float a = max3f(p0[0], p0[1], p1[0]), b = max3f(p0[2], p0[3], p1[1]); a = max3f(a, p1[2], p1[3]);
  #pragma unroll
  for (int r = 4; r < 16; r += 4) { a = max3f(a, p0[r], p0[r + 1]); b = max3f(b, p0[r + 2], p0[r + 3]); a = max3f(a, p1[r], p1[r + 1]); b = max3f(b, p1[r + 2], p1[r + 3]); }
  const float m = max2f(a, b);
  auto rr = __builtin_amdgcn_permlane32_swap(__float_as_uint(m), __float_as_uint(m), false, false);
  return max2f(__uint_as_float(rr[0]), __uint_as_float(rr[1]));
}
__device__ __forceinline__ void pv(f32x16* o, int vb, bf16x8 pa0, bf16x8 pa1, bf16x8 pa2, bf16x8 pa3) {
  #pragma unroll
  for (int d0 = 0; d0 < 2; ++d0) { s16x4 lo[4], hi[4];
    #pragma unroll
    for (int ks = 0; ks < 4; ++ks) {
      asm volatile("ds_read_b64_tr_b16 %0,%1 offset:%c2" : "=&v"(lo[ks]) : "v"(vb), "i"(d0 * 4096 + ks * 1024) : "memory");
      asm volatile("ds_read_b64_tr_b16 %0,%1 offset:%c2" : "=&v"(hi[ks]) : "v"(vb), "i"(d0 * 4096 + ks * 1024 + 512) : "memory"); }
    asm volatile("s_waitcnt lgkmcnt(0)" ::: "memory"); SBAR();
    #define PK(k) (bf16x8){lo[k][0], lo[k][1], lo[k][2], lo[k][3], hi[k][0], hi[k][1], hi[k][2], hi[k][3]}
    o[d0] = __builtin_amdgcn_mfma_f32_32x32x16_bf16(pa0, PK(0), o[d0], 0, 0, 0);
    o[d0] = __builtin_amdgcn_mfma_f32_32x32x16_bf16(pa1, PK(1), o[d0], 0, 0, 0);
    o[d0] = __builtin_amdgcn_mfma_f32_32x32x16_bf16(pa2, PK(2), o[d0], 0, 0, 0);
    o[d0] = __builtin_amdgcn_mfma_f32_32x32x16_bf16(pa3, PK(3), o[d0], 0, 0, 0);
    #undef PK
  }
}

template <int THRL> __device__ __forceinline__ void moba_unit(int b, int h, int qb, const bf16* PROJ, const float* ksum, bf16* MIX, char* shm, volatile LAS unsigned* nidp, unsigned nid, volatile LAS unsigned* tsw = nullptr) {
#ifdef PROBE_TS
  const unsigned long long ts0_ = __builtin_amdgcn_s_memrealtime();
#endif
  int tid_ = threadIdx.x; asm volatile("" : "+v"(tid_));
  const int tid = tid_, lane = tid & 63, r32 = lane & 31, hi = lane >> 5; const int wid = __builtin_amdgcn_readfirstlane(tid >> 6);
  const long rowbase = (long)b * SEQ; const int q0 = qb * QB;
  const bf16* Qw = PROJ + (rowbase + q0 + wid * QBLK) * PP + PC_MQ + h * D;
  const bf16* Kh = PROJ + rowbase * PP + PC_MK + h * D, *Vh = PROJ + rowbase * PP + PC_MV + h * D;
  const unsigned lds0 = (unsigned)(uintptr_t)shm;
  float* wsf = (float*)(shm + LDS_WS) + wid * 64;
  const unsigned kvo = (unsigned)(lane * PP + wid * 8) * 2u;
  const unsigned vvo = (unsigned)((16 * (wid & 3) + (lane >> 2)) * PP + (wid >> 2) * 32 + (lane & 3) * 8) * 2u;
  const unsigned kdst = lds0 + LDS_K + wid * 1024, vdst = lds0 + LDS_V + wid * 1024;
  const int tb4 = 4 * qb, NT = tb4 + 4;
  #define TM(t) (((t) < 4) ? (tb4 + (t)) : ((t) - 4))
  const unsigned dump = lds0 + (unsigned)(RING_BYTES + 1024) + wid * 1024;
  #define DMA_K(t, slot) glds16s(Kh + (long)TM(t) * KVBLK * PP, kvo, (unsigned)__builtin_amdgcn_readfirstlane(((t) < NT) ? kdst + (slot) : dump))
  #define DMA_V(t, slot) glds16s(Vh + (long)TM(t) * KVBLK * PP, vvo, (unsigned)__builtin_amdgcn_readfirstlane(((t) < NT) ? vdst + (slot) : dump))
  const int vb0 = (int)(lds0 + LDS_V) + ((lane >> 4) & 1) * 32 + (lane & 3) * 8 + (4 * hi + ((lane & 15) >> 2)) * 64;
  const char* Kbase = shm + LDS_K; bf16x8 kf[8];
  const lds_cptr shm3 = (lds_cptr)shm; const lds_cptr kp0 = shm3 + LDS_K + hi * 1024 + r32 * 16; const lds_cptr vp0 = shm3 + LDS_V + ((lane >> 4) & 1) * 32 + (lane & 3) * 8 + (4 * hi + ((lane & 15) >> 2)) * 64;
  DMA_K(0, 0); DMA_V(0, 0); DMA_K(1, SLOTB);
  bf16x8 qr[4];
  #pragma unroll
  for (int d0 = 0; d0 < 4; ++d0) qr[d0] = *reinterpret_cast<const bf16x8*>(&Qw[(long)r32 * PP + d0 * 16 + hi * 8]);
  unsigned sel = (1u << qb) - 1u;
  if (qb > 3) {
    f32x16 gt = f32x16{};
    #pragma unroll
    for (int d0 = 0; d0 < 4; ++d0) {
      f32x4 a0 = (f32x4){0.f, 0.f, 0.f, 0.f}, a1 = a0;
      if (r32 < qb) { const float* k0 = ksum + ((size_t)(b * 8 + r32) * 2) * 512 + h * D + 16 * d0 + 8 * hi;
        a0 = *(const f32x4*)k0 + *(const f32x4*)(k0 + 512); a1 = *(const f32x4*)(k0 + 4) + *(const f32x4*)(k0 + 516); }
      u32x4 hw, lw;
      hw.x = pk2(a0.x, a0.y); hw.y = pk2(a0.z, a0.w); hw.z = pk2(a1.x, a1.y); hw.w = pk2(a1.z, a1.w);
      lw.x = pk2(a0.x - __builtin_bit_cast(float, hw.x << 16), a0.y - __builtin_bit_cast(float, hw.x & 0xffff0000u)); lw.y = pk2(a0.z - __builtin_bit_cast(float, hw.y << 16), a0.w - __builtin_bit_cast(float, hw.y & 0xffff0000u));
      lw.z = pk2(a1.x - __builtin_bit_cast(float, hw.z << 16), a1.y - __builtin_bit_cast(float, hw.z & 0xffff0000u)); lw.w = pk2(a1.z - __builtin_bit_cast(float, hw.w << 16), a1.w - __builtin_bit_cast(float, hw.w & 0xffff0000u));
      gt = __builtin_amdgcn_mfma_f32_32x32x16_bf16(__builtin_bit_cast(bf16x8, hw), qr[d0], gt, 0, 0, 0);
      gt = __builtin_amdgcn_mfma_f32_32x32x16_bf16(__builtin_bit_cast(bf16x8, lw), qr[d0], gt, 0, 0, 0);
    }
    float gl[4], gh[4];
    #pragma unroll
    for (int r = 0; r < 4; ++r) { const float mine = gt[r], oth = __shfl_xor(mine, 32); gl[r] = hi ? oth : mine; gh[r] = hi ? mine : oth; }
    float v1 = -INFINITY, v2 = -INFINITY, v3 = -INFINITY; int i1 = 0, i2 = 0, i3 = 0;
    #pragma unroll
    for (int j = 0; j < 8; ++j) { const float p = (j < 4) ? gl[j & 3] : gh[j & 3];
      if (j < qb) { if (p > v1) { v3 = v2; i3 = i2; v2 = v1; i2 = i1; v1 = p; i1 = j; } else if (p > v2) { v3 = v2; i3 = i2; v2 = p; i2 = j; } else if (p > v3) { v3 = p; i3 = j; } } }
    sel = (1u << i1) | (1u << i2) | (1u << i3);
  }
  float mhat = 0.f, l_reg = 0.f; f32x16 o[2]; o[0] = f32x16{}; o[1] = f32x16{}; const f32x16 zero16 = f32x16{};
  const int qrel = wid * QBLK + r32;
  #define CMASK(P0, P1, t) do { if ((t) < 4) cmask(P0, P1, (t), qrel, hi); } while (0)
  #define NVAL(t) (((t) >= 4 && !((sel >> (((t) - 4) >> 2)) & 1u)) ? -INFINITY : -mhat)
  bool resc = false;
  #define START(P0, P1) do { const float rm = rowmax(P0, P1); resc = false; \
    { const float dl = rm; mhat = fadd_s(mhat, dl); \
      _Pragma("unroll") for (int r = 0; r < 16; ++r) { P0[r] = fsub_s(P0[r], dl); P1[r] = fsub_s(P1[r], dl); } } \
    _Pragma("unroll") for (int r = 0; r < 16; ++r) P0[r] = __builtin_amdgcn_exp2f(P0[r]); } while (0)
  #define RESC() do { if (resc) { asm volatile("s_waitcnt lgkmcnt(0)" ::: "memory"); \
      _Pragma("unroll") for (int d_ = 0; d_ < 2; ++d_) _Pragma("unroll") for (int r = 0; r < 16; ++r) o[d_][r] *= wsf[crow(r, hi)]; } } while (0)
  f32x16 pA0, pA1, pB0, pB1;
  int sl_prev = 0, sl_cur = 0, sl_next = SLOTB;
  #define ROT() do { sl_prev = sl_cur; sl_cur = sl_next; sl_next = (sl_next == (NSLOT - 1) * SLOTB) ? 0 : sl_next + SLOTB; } while (0)
  DMA_K(2, 2 * SLOTB);
  WAIT_BAR(3);
  qkt(pA0, pA1, Kbase, qr, zero16, r32, hi); asm volatile("s_nop 15\n\ts_nop 7" : "+v"(pA0), "+v"(pA1)); CMASK(pA0, pA1, 0);
  START(pA0, pA1);
  _Pragma("unroll") for (int r = 0; r < 16; ++r) pA1[r] = __builtin_amdgcn_exp2f(pA1[r]);
  WAIT_BAR(0);
  DMA_K(3, 0); DMA_V(1, SLOTB);
  ROT();
  kload8(kf, kp0 + sl_cur);
  WAIT_BAR(2);
  s16x4 vlo[8], vhi[8]; u32x4 pw0, pw1, pw2, pw3;
  #define PKW(P, B) cvtpk_s(P[B], P[B + 1])
  #define PAF(k) __builtin_bit_cast(bf16x8, pw##k)
  #define VFR(i) (bf16x8){vlo[i][0], vlo[i][1], vlo[i][2], vlo[i][3], vhi[i][0], vhi[i][1], vhi[i][2], vhi[i][3]}
  #define PIN(x) asm volatile("" : "+v"(x))
  #define MX3(a, b, c) __builtin_fmaxf(__builtin_fmaxf((a), (b)), (c))
  #define GAPA(MF, A0, A1, A2, A3, W0, W1, PW) do { MF; sacc += A0; sacc += A1; sacc += A2; sacc += A3; PIN(sacc); W0; W1; PIN(PW); SBAR(); } while (0)
  #define EX(v) __builtin_amdgcn_exp2f(v)
  #define GAPB(MF, X, B) do { MF; X[B] = EX(X[B]); X[B + 1] = EX(X[B + 1]); X[B + 2] = EX(X[B + 2]); X[B + 3] = EX(X[B + 3]); PIN(X); SBAR(); } while (0)
  #define VRD(i) do { vlo[i] = vtr(vp_ + (((i) >> 2) * 4096 + ((i) & 3) * 1024)); vhi[i] = vtr(vp_ + (((i) >> 2) * 4096 + ((i) & 3) * 1024 + 512)); } while (0)
  #define KRD(G, j) do { if (G) { kload2(kf, kp0 + sl_next, j); SBAR(); } } while (0)
  #define STEP(C0, C1, P0, P1, t, GK, GV, GL) do { const float nv_ = NVAL(t); SBAR(); \
    const lds_cptr vp_ = vp0 + sl_prev; \
    VRD(0); SBAR(); float sacc = (P0[0] + P0[1]); \
    GAPA(C0 = __builtin_amdgcn_mfma_f32_32x32x16_bf16(kf[0], qr[0], zero16, 0, 0, 0), P0[2], P0[3], P0[4], P0[5],     pw0[0] = PKW(P0, 0), pw0[1] = PKW(P0, 2), pw0); \
    VRD(4); SBAR(); GAPA(C1 = __builtin_amdgcn_mfma_f32_32x32x16_bf16(kf[1], qr[0], zero16, 0, 0, 0), P0[6], P0[7], P0[8], P0[9],     pw0[2] = PKW(P0, 4), pw0[3] = PKW(P0, 6), pw0); \
    VRD(1); SBAR(); GAPA(C0 = __builtin_amdgcn_mfma_f32_32x32x16_bf16(kf[2], qr[1], C0, 0, 0, 0),   P0[10], P0[11], P0[12], P0[13], pw1[0] = PKW(P0, 8), pw1[1] = PKW(P0, 10), pw1); \
    VRD(5); SBAR(); GAPA(C1 = __builtin_amdgcn_mfma_f32_32x32x16_bf16(kf[3], qr[1], C1, 0, 0, 0),   P0[14], P0[15], P1[0], P1[1],   pw1[2] = PKW(P0, 12), pw1[3] = PKW(P0, 14), pw1); \
    VRD(2); SBAR(); GAPA(C0 = __builtin_amdgcn_mfma_f32_32x32x16_bf16(kf[4], qr[2], C0, 0, 0, 0),   P1[2], P1[3], P1[4], P1[5],     pw2[0] = PKW(P1, 0), pw2[1] = PKW(P1, 2), pw2); \
    VRD(6); SBAR(); GAPA(C1 = __builtin_amdgcn_mfma_f32_32x32x16_bf16(kf[5], qr[2], C1, 0, 0, 0),   P1[6], P1[7], P1[8], P1[9],     pw2[2] = PKW(P1, 4), pw2[3] = PKW(P1, 6), pw2); \
    VRD(3); SBAR(); GAPA(C0 = __builtin_amdgcn_mfma_f32_32x32x16_bf16(kf[6], qr[3], C0, 0, 0, 0),   P1[10], P1[11], P1[12], P1[13], pw3[0] = PKW(P1, 8), pw3[1] = PKW(P1, 10), pw3); \
    VRD(7); SBAR(); GAPA(C1 = __builtin_amdgcn_mfma_f32_32x32x16_bf16(kf[7], qr[3], C1, 0, 0, 0),   P1[14], P1[15], 0.f, 0.f,       pw3[2] = PKW(P1, 12), pw3[3] = PKW(P1, 14), pw3); \
    l_reg += sacc; \
    if (GK) { DMA_K((t) + 3, sl_cur); } if (GV) { DMA_V((t) + 1, sl_next); } \
    _Pragma("unroll") for (int r = 0; r < 16; ++r) { C0[r] += nv_; C1[r] += nv_; } \
    CMASK(C0, C1, t); \
    { float a = MX3(C0[0], C0[1], C1[0]), b = MX3(C0[2], C0[3], C1[1]); a = MX3(a, C1[2], C1[3]); \
      _Pragma("unroll") for (int r = 4; r < 16; r += 4) { a = MX3(a, C0[r], C0[r + 1]); b = MX3(b, C0[r + 2], C0[r + 3]); a = MX3(a, C1[r], C1[r + 1]); b = MX3(b, C1[r + 2], C1[r + 3]); } \
      float rm = __builtin_fmaxf(a, b); { auto rr = __builtin_amdgcn_permlane32_swap(__float_as_uint(rm), __float_as_uint(rm), false, false); rm = __builtin_fmaxf(__uint_as_float(rr[0]), __uint_as_float(rr[1])); } \
      resc = false; \
      if (__builtin_expect(__any(rm > (float)THRL), 0)) { const float dl = __builtin_fmaxf(rm, 0.f); mhat += dl; \
        _Pragma("unroll") for (int r = 0; r < 16; ++r) { C0[r] -= dl; C1[r] -= dl; } \
        const float f = __builtin_amdgcn_exp2f(-dl); l_reg *= f; if (hi == 0) wsf[r32] = f; resc = true; } } \
    SBAR(); \
    GAPB(o[0] = __builtin_amdgcn_mfma_f32_32x32x16_bf16(PAF(0), VFR(0), o[0], 0, 0, 0), C0, 0); \
    GAPB(o[1] = __builtin_amdgcn_mfma_f32_32x32x16_bf16(PAF(0), VFR(4), o[1], 0, 0, 0), C0, 4); \
    KRD(GL, 0); GAPB(o[0] = __builtin_amdgcn_mfma_f32_32x32x16_bf16(PAF(1), VFR(1), o[0], 0, 0, 0), C0, 8); \
    KRD(GL, 1); GAPB(o[1] = __builtin_amdgcn_mfma_f32_32x32x16_bf16(PAF(1), VFR(5), o[1], 0, 0, 0), C0, 12); \
    KRD(GL, 2); GAPB(o[0] = __builtin_amdgcn_mfma_f32_32x32x16_bf16(PAF(2), VFR(2), o[0], 0, 0, 0), C1, 0); \
    KRD(GL, 3); GAPB(o[1] = __builtin_amdgcn_mfma_f32_32x32x16_bf16(PAF(2), VFR(6), o[1], 0, 0, 0), C1, 4); \
    GAPB(o[0] = __builtin_amdgcn_mfma_f32_32x32x16_bf16(PAF(3), VFR(3), o[0], 0, 0, 0), C1, 8); \
    GAPB(o[1] = __builtin_amdgcn_mfma_f32_32x32x16_bf16(PAF(3), VFR(7), o[1], 0, 0, 0), C1, 12); \
    } while (0)
#ifdef PROBE_TS
  const unsigned long long ts1_ = __builtin_amdgcn_s_memrealtime();
#endif
  int t = 1;
  for (; t + 1 < NT; t += 2) {
    STEP(pB0, pB1, pA0, pA1, t, true, true, true);     WAIT_BAR(2); RESC(); ROT();
    STEP(pA0, pA1, pB0, pB1, t + 1, true, true, true); WAIT_BAR(2); RESC(); ROT();
  }
  STEP(pB0, pB1, pA0, pA1, NT - 1, true, true, true); WAIT_BAR(2); RESC();
  if (threadIdx.x == 0) *nidp = nid;
#ifdef PROBE_TS
  const unsigned long long ts2_ = __builtin_amdgcn_s_memrealtime();
#endif
  { float sacc = pB0[0] + pB0[1]; _Pragma("unroll") for (int r = 2; r < 16; ++r) sacc += pB0[r]; _Pragma("unroll") for (int r = 0; r < 16; ++r) sacc += pB1[r]; l_reg += sacc;
    pw0 = (u32x4){PKW(pB0, 0), PKW(pB0, 2), PKW(pB0, 4), PKW(pB0, 6)}; pw1 = (u32x4){PKW(pB0, 8), PKW(pB0, 10), PKW(pB0, 12), PKW(pB0, 14)}; pw2 = (u32x4){PKW(pB1, 0), PKW(pB1, 2), PKW(pB1, 4), PKW(pB1, 6)}; pw3 = (u32x4){PKW(pB1, 8), PKW(pB1, 10), PKW(pB1, 12), PKW(pB1, 14)};
    SBAR(); pv(o, vb0 + sl_cur, PAF(0), PAF(1), PAF(2), PAF(3)); }
  #undef PKW
  #undef PAF
  #undef VFR
  #undef PIN
  #undef MX3
  #undef GAPA
  #undef GAPB
  #undef EX
  #undef VRD
  #undef KRD
  #undef STEP
  { auto rr = __builtin_amdgcn_permlane32_swap(__float_as_uint(l_reg), __float_as_uint(l_reg), false, false); l_reg = __uint_as_float(rr[0]) + __uint_as_float(rr[1]); }
  if (hi == 0) wsf[32 + r32] = l_reg; asm volatile("s_waitcnt lgkmcnt(0)" ::: "memory");
  float rli[16];
  #pragma unroll
  for (int r = 0; r < 16; ++r) rli[r] = __builtin_amdgcn_rcpf(wsf[32 + crow(r, hi)]);
  bf16* Ow = MIX + (rowbase + q0 + wid * QBLK) * OP + 512 + h * D;
  { bf16* stg = (bf16*)(shm + LDS_OST) + wid * 2048;
    #pragma unroll
    for (int r = 0; r < 16; ++r) { const int orow = crow(r, hi);
      #pragma unroll
      for (int d0 = 0; d0 < 2; ++d0) stg[orow * 64 + d0 * 32 + r32] = __float2bfloat16(o[d0][r] * rli[r]); }
    asm volatile("s_waitcnt lgkmcnt(0)" ::: "memory");
    #pragma unroll
    for (int i = 0; i < 4; ++i) { const int row = i * 8 + (lane >> 3), ch = lane & 7; const u32x4 v = *(const u32x4*)(stg + row * 64 + ch * 8); *(u32x4*)(Ow + (long)row * OP + ch * 8) = v; } }
  asm volatile("s_waitcnt lgkmcnt(0)\n\ts_barrier" ::: "memory");
#ifdef PROBE_TS
  if (tsw && threadIdx.x == 0) { const unsigned long long ts3_ = __builtin_amdgcn_s_memrealtime(); tsw[0] += (unsigned)(ts1_ - ts0_); tsw[1] += (unsigned)(ts2_ - ts1_); tsw[2] += (unsigned)(ts3_ - ts2_); tsw[3] += (unsigned)(NT - 1); tsw[4] += 1u; }
#endif
  #undef DMA_K
  #undef DMA_V
  #undef TM
  #undef CMASK
  #undef NVAL
  #undef START
  #undef RESC
  #undef ROT
}
#undef WAIT_BAR
}

namespace ret {
constexpr int KS_STR = 144, V_STR = 272;
constexpr int L_KS = 0, L_KH = 18432, L_VS = 36864, L_RT = 71680, L_GS = 90112, L_END = 122880;
typedef short v4i16_t __attribute__((ext_vector_type(4)));
__device__ __forceinline__ s16x4 vtr(LAS const char* p) { return __builtin_bit_cast(s16x4, __builtin_amdgcn_ds_read_tr16_b64_v4i16((LAS v4i16_t*)p)); }
__device__ __forceinline__ bf16x8 cat8(s16x4 a, s16x4 b) { return (bf16x8){a[0], a[1], a[2], a[3], b[0], b[1], b[2], b[3]}; }
__device__ __forceinline__ float red16(float v) {
    v += __builtin_bit_cast(float, __builtin_amdgcn_update_dpp(0, __builtin_bit_cast(int, v), 0xB1, 0xF, 0xF, true));
    v += __builtin_bit_cast(float, __builtin_amdgcn_update_dpp(0, __builtin_bit_cast(int, v), 0x4E, 0xF, 0xF, true));
    v += __builtin_bit_cast(float, __builtin_amdgcn_update_dpp(0, __builtin_bit_cast(int, v), 0x141, 0xF, 0xF, true));
    v += __builtin_bit_cast(float, __builtin_amdgcn_update_dpp(0, __builtin_bit_cast(int, v), 0x140, 0xF, 0xF, true));
    return v;
}

__device__ __forceinline__ void ret_state_unit(int b, int h, const bf16_t* PROJ, bf16_t* RST, LAS unsigned char* lds) {
    int tid_ = threadIdx.x; asm volatile("" : "+v"(tid_));
    const int tid = tid_, lane = tid & 63, c16 = lane & 15, g = lane >> 4; const int w = __builtin_amdgcn_readfirstlane(tid >> 6);
    const float log2g = log2f(1.0f - exp2f(-5.0f - (float)h));
    const float gC = exp2f(log2g * 128.0f);
    LAS unsigned char* Kh = lds + L_KH; LAS unsigned char* Vs = lds + L_VS;
    f32x4 Racc[4];
#pragma unroll
    for (int dt = 0; dt < 4; ++dt) Racc[dt] = (f32x4){0.f, 0.f, 0.f, 0.f};
    const size_t tokb = (size_t)b * SEQ;
    u32x4 kreg[2], vreg[4];
    const int krow0 = tid >> 3, kcc = tid & 7, vrow0 = tid >> 4, vcc = tid & 15;
#define RS_LOAD(c) do { const bf16_t* base = PROJ + (tokb + (size_t)(c) * 128) * DIN; \
        _Pragma("unroll") for (int i = 0; i < 2; ++i) kreg[i] = *(const u32x4*)(base + (size_t)(krow0 + 64 * i) * DIN + PC_RK + 64 * h + 8 * kcc); \
        _Pragma("unroll") for (int i = 0; i < 4; ++i) vreg[i] = *(const u32x4*)(base + (size_t)(vrow0 + 32 * i) * DIN + PC_RV + 128 * h + 8 * vcc); } while (0)
    RS_LOAD(0);
    const int trq = c16 >> 2, trp = c16 & 3;
    LAS const char* vtb = (LAS const char*)Vs + (4 * g + trq) * V_STR + trp * 8;
    LAS const char* khb = (LAS const char*)Kh + (4 * g + trq) * KS_STR + trp * 8;
    bf16_t* rst = RST + ((size_t)(b * 4 + h) * 16) * (128 * 64) + (size_t)(16 * w + c16) * 64 + 4 * g;
    for (int c = 0; c < 16; ++c) {
#pragma unroll
        for (int i = 0; i < 2; ++i) { const int row = krow0 + 64 * i; const float z = __builtin_amdgcn_exp2f(log2g * (float)(127 - row)); u32x4 sc;
#pragma unroll
            for (int j = 0; j < 4; ++j) { const unsigned u = kreg[i][j]; sc[j] = pk2(bf2f((unsigned short)(u & 0xffffu)) * z, bf2f((unsigned short)(u >> 16)) * z); }
            *(LAS u32x4*)(Kh + row * KS_STR + kcc * 16) = sc; }
#pragma unroll
        for (int i = 0; i < 4; ++i) { const int row = vrow0 + 32 * i; *(LAS u32x4*)(Vs + row * V_STR + vcc * 16) = vreg[i]; }
        LDS_BARRIER();
        if (c + 1 < 16) RS_LOAD(c + 1);
#pragma unroll
        for (int dt = 0; dt < 4; ++dt) { u32x2 o2; o2.x = pk2(Racc[dt][0], Racc[dt][1]); o2.y = pk2(Racc[dt][2], Racc[dt][3]);
            *(u32x2*)(rst + (size_t)c * (128 * 64) + 16 * dt) = o2; }
#pragma unroll
        for (int dt = 0; dt < 4; ++dt) Racc[dt] = Racc[dt] * gC;
#pragma unroll 1
        for (int ks = 0; ks < 4; ++ks) { LAS const char* vp = vtb + ks * (32 * V_STR) + w * 32;
            const bf16x8 vf = cat8(vtr(vp), vtr(vp + 16 * V_STR));
            LAS const char* kp = khb + ks * (32 * KS_STR);
#pragma unroll
            for (int dt = 0; dt < 4; ++dt) { const bf16x8 kfm = cat8(vtr(kp + dt * 32), vtr(kp + dt * 32 + 16 * KS_STR));
                Racc[dt] = __builtin_amdgcn_mfma_f32_16x16x32_bf16(kfm, vf, Racc[dt], 0, 0, 0); } }
        LDS_BARRIER();
    }
#undef RS_LOAD
}

__device__ __forceinline__ void ret_out_unit(int b, int h, int c, const bf16_t* PROJ, const bf16_t* RST, const float* rnw, bf16_t* MIX, LAS unsigned char* lds, volatile LAS unsigned* nidp, unsigned nid) {
    int tid_ = threadIdx.x; asm volatile("" : "+v"(tid_));
    const int tid = tid_, lane = tid & 63, c16 = lane & 15, g = lane >> 4; const int w = __builtin_amdgcn_readfirstlane(tid >> 6);
    const float log2g = log2f(1.0f - exp2f(-5.0f - (float)h));
    LAS unsigned char* Ks = lds + L_KS; LAS unsigned char* Vs = lds + L_VS; LAS unsigned char* Rt = lds + L_RT; LAS unsigned char* Gs = lds + L_GS;
    LAS float* Wn = (LAS float*)(lds + L_END);
    const size_t tok0c = (size_t)b * SEQ + (size_t)c * 128;
    const bf16_t* base = PROJ + tok0c * DIN;
    { const bf16_t* gb = base + PC_RG + 128 * h;
#pragma unroll
        for (int i = 0; i < 4; ++i) { const int q = tid + 512 * i;
            __builtin_amdgcn_global_load_lds((const unsigned*)(gb + (size_t)(q >> 4) * DIN + 8 * (q & 15)), (LAS unsigned*)(Gs + (size_t)(w * 64 + 512 * i) * 16), 16, 0, 0); } }
    u32x4 kreg[2], vreg[4], rreg[2]; bf16x8 qf[2];
    const int krow0 = tid >> 3, kcc = tid & 7, vrow0 = tid >> 4, vcc = tid & 15;
    const bf16_t* rsrc = RST + ((size_t)(b * 4 + h) * 16 + c) * (128 * 64);
#pragma unroll
    for (int i = 0; i < 2; ++i) kreg[i] = *(const u32x4*)(base + (size_t)(krow0 + 64 * i) * DIN + PC_RK + 64 * h + 8 * kcc);
#pragma unroll
    for (int i = 0; i < 4; ++i) vreg[i] = *(const u32x4*)(base + (size_t)(vrow0 + 32 * i) * DIN + PC_RV + 128 * h + 8 * vcc);
#pragma unroll
    for (int i = 0; i < 2; ++i) rreg[i] = *(const u32x4*)(rsrc + (size_t)(krow0 + 64 * i) * 64 + 8 * kcc);
#pragma unroll
    for (int k2 = 0; k2 < 2; ++k2) qf[k2] = *(const bf16x8*)(base + (size_t)(16 * w + c16) * DIN + PC_RQ + 64 * h + 32 * k2 + 8 * g);
    if (tid < 128) Wn[tid] = rnw[128 * h + tid];
#pragma unroll
    for (int i = 0; i < 2; ++i) { const int row = krow0 + 64 * i; *(LAS u32x4*)(Ks + row * KS_STR + kcc * 16) = kreg[i]; *(LAS u32x4*)(Rt + row * KS_STR + kcc * 16) = rreg[i]; }
#pragma unroll
    for (int i = 0; i < 4; ++i) { const int row = vrow0 + 32 * i; *(LAS u32x4*)(Vs + row * V_STR + vcc * 16) = vreg[i]; }
    __syncthreads();
    if (tid == 0) *nidp = nid;
    f32x4 oi[8], oc[8];
#pragma unroll
    for (int et = 0; et < 8; ++et) { oi[et] = (f32x4){0.f, 0.f, 0.f, 0.f}; oc[et] = (f32x4){0.f, 0.f, 0.f, 0.f}; }
    const int trq = c16 >> 2, trp = c16 & 3;
    const int nks = (w >> 1) + 1;
    LAS const char* ksb = (LAS const char*)Ks + c16 * KS_STR + g * 16;
    LAS const char* vtb = (LAS const char*)Vs + (4 * g + trq) * V_STR + trp * 8;
    LAS const char* rtb = (LAS const char*)Rt + c16 * KS_STR + g * 16;
#pragma unroll 1
    for (int ks = 0; ks < nks; ++ks) {
        u32x4 pw;
#pragma unroll
        for (int half = 0; half < 2; ++half) { const int mt = 2 * ks + half; f32x4 st = (f32x4){0.f, 0.f, 0.f, 0.f};
            if (mt <= w) {
#pragma unroll
                for (int k2 = 0; k2 < 2; ++k2) { const bf16x8 ka = *(const LAS bf16x8*)(ksb + mt * (16 * KS_STR) + k2 * 64);
                    st = __builtin_amdgcn_mfma_f32_16x16x32_bf16(ka, qf[k2], st, 0, 0, 0); } }
            float pv_[4];
#pragma unroll
            for (int r = 0; r < 4; ++r) { const int diff = (16 * w + c16) - (16 * mt + 4 * g + r); pv_[r] = diff >= 0 ? st[r] * __builtin_amdgcn_exp2f(log2g * (float)diff) : 0.f; }
            pw[2 * half] = pk2(pv_[0], pv_[1]); pw[2 * half + 1] = pk2(pv_[2], pv_[3]); }
        const bf16x8 pf = __builtin_bit_cast(bf16x8, pw);
        LAS const char* vp = vtb + ks * (32 * V_STR);
#pragma unroll
        for (int et = 0; et < 8; ++et) { const bf16x8 vf = cat8(vtr(vp + et * 32), vtr(vp + et * 32 + 16 * V_STR));
            oi[et] = __builtin_amdgcn_mfma_f32_16x16x32_bf16(pf, vf, oi[et], 0, 0, 0); }
    }
#pragma unroll
    for (int k2 = 0; k2 < 2; ++k2)
#pragma unroll
        for (int et = 0; et < 8; ++et) { const bf16x8 rf = *(const LAS bf16x8*)(rtb + et * (16 * KS_STR) + k2 * 64);
            oc[et] = __builtin_amdgcn_mfma_f32_16x16x32_bf16(qf[k2], rf, oc[et], 0, 0, 0); }
    {
        float s1[4], s2[4], xi[4];
#pragma unroll
        for (int r = 0; r < 4; ++r) { xi[r] = __builtin_amdgcn_exp2f(log2g * (float)(16 * w + 4 * g + r + 1)); s1[r] = 0.f; s2[r] = 0.f; }
#pragma unroll
        for (int et = 0; et < 8; ++et)
#pragma unroll
            for (int r = 0; r < 4; ++r) { const float x = oi[et][r] + xi[r] * oc[et][r]; oi[et][r] = x; s1[r] += x; s2[r] += x * x; }
#pragma unroll
        for (int r = 0; r < 4; ++r) { s1[r] = red16(s1[r]); s2[r] = red16(s2[r]);
            const float mu = s1[r] * (1.f / 128.f); const float var = fmaxf(s2[r] * (1.f / 128.f) - mu * mu, 0.f); s1[r] = mu; s2[r] = 1.0f / sqrtf(var + GN_EPS); }
        LAS unsigned short* gl = (LAS unsigned short*)Gs + (16 * w + 4 * g) * 128 + c16;
        unsigned short gq[8][4];
#pragma unroll
        for (int et = 0; et < 8; ++et)
#pragma unroll
            for (int r = 0; r < 4; ++r) gq[et][r] = gl[r * 128 + 16 * et];
        LDS_WAIT(); asm volatile("" ::: "memory");
#pragma unroll
        for (int et = 0; et < 8; ++et) { const float wgt = Wn[16 * et + c16];
#pragma unroll
            for (int r = 0; r < 4; ++r) { const float gv = bf2f(gq[et][r]);
                const float sg = gv * __builtin_amdgcn_rcpf(1.f + __builtin_amdgcn_exp2f(-gv * 1.4426950408889634f));
                oi[et][r] = (oi[et][r] - s1[r]) * s2[r] * wgt * sg; } }
#pragma unroll
        for (int et = 0; et < 8; ++et)
#pragma unroll
            for (int r = 0; r < 4; ++r) gl[r * 128 + 16 * et] = (unsigned short)f2bf(oi[et][r]);
    }
    LDS_BARRIER();
    { bf16_t* ob = MIX + tok0c * DM + 128 * h;
#pragma unroll
        for (int i = 0; i < 4; ++i) { const int q = tid + 512 * i; *(u32x4*)(ob + (size_t)(q >> 4) * DM + 8 * (q & 15)) = *(const LAS u32x4*)(Gs + q * 16); } }
    LDS_BARRIER();
}
}

#define XB_TMO      128
#define XB_XCNT(j)  (256  + 64 * (j))
#define XB_XSUB(j)  (1280 + 64 * (j))
#define XB_XGEN(j)  (2304 + 64 * (j))
#define XB_TOP      3328
#define XB_TOPGEN   3392
#define XCD_BAR_WORDS 3456
#define XB_SPIN_CAP (1u << 18)
__device__ __forceinline__ unsigned xb_ld(unsigned* p)              { return __hip_atomic_load(p, __ATOMIC_RELAXED, __HIP_MEMORY_SCOPE_AGENT); }
__device__ __forceinline__ unsigned xb_add(unsigned* p, unsigned v) { return __hip_atomic_fetch_add(p, v, __ATOMIC_RELAXED, __HIP_MEMORY_SCOPE_AGENT); }
__device__ __forceinline__ unsigned xb_xcc_id() { return (unsigned)__builtin_amdgcn_s_getreg((3 << 11) | 20) & 0xFu; }
#define XB_SPIN(cond, bar) do { unsigned _sp = 0; while (cond) { __builtin_amdgcn_s_sleep(1); \
    if ((++_sp & 255u) == 0u) { if (xb_ld(&(bar)[XB_TMO])) break; if (_sp > XB_SPIN_CAP) { atomicAdd(&(bar)[XB_TMO], 1u); break; } } } } while (0)
struct XcdBarrier { unsigned* bar; unsigned x; volatile LAS unsigned* st; };
__device__ __forceinline__ XcdBarrier xcd_barrier_post(unsigned* bar, volatile LAS unsigned* st) {
    XcdBarrier b; b.bar = bar; b.x = xb_xcc_id(); b.st = st;
    if (threadIdx.x == 0) (void)xb_add(&bar[XB_XCNT(b.x)], 1u);
    return b;
}
__device__ __forceinline__ void xcd_barrier_complete(unsigned* bar, unsigned x, unsigned& nloc, unsigned& nx) {
    const unsigned G = gridDim.x * gridDim.y * gridDim.z;
    unsigned sum, cnt, mine, sp = 0u;
    for (;;) {
        sum = 0u; cnt = 0u; mine = 0u;
#pragma unroll
        for (unsigned j = 0; j < 16; ++j) { const unsigned c = xb_ld(&bar[XB_XCNT(j)]); sum += c; cnt += (c > 0u) ? 1u : 0u; mine = (j == x) ? c : mine; }
        if (sum == G) break;
        __builtin_amdgcn_s_sleep(1);
        if ((++sp & 255u) == 0u) { if (xb_ld(&bar[XB_TMO])) break; if (sp > XB_SPIN_CAP) { atomicAdd(&bar[XB_TMO], 1u); break; } }
    }
    nloc = mine > 0u ? mine : 1u; nx = cnt > 0u ? cnt : 1u;
}
__device__ __forceinline__ void xcd_barrier(const XcdBarrier& b) {
    asm volatile("s_waitcnt vmcnt(0)" ::: "memory");
    __syncthreads();
    if (threadIdx.x == 0) {
        unsigned* bar = b.bar;
        __builtin_amdgcn_s_waitcnt(0);
        unsigned nloc = b.st[0], nx = b.st[1];
        if (nloc == 0u) { xcd_barrier_complete(bar, b.x, nloc, nx); b.st[0] = nloc; b.st[1] = nx; }
        const unsigned old = xb_add(&bar[XB_XSUB(b.x)], 1u);
        const unsigned gen = old / nloc;
        if (old + 1u == (gen + 1u) * nloc) {
            __builtin_amdgcn_fence(__ATOMIC_RELEASE, "agent");
            asm volatile("s_waitcnt vmcnt(0)" ::: "memory");
            const unsigned og = xb_add(&bar[XB_TOP], 1u);
            const unsigned tg = og / nx;
            if (og + 1u == (tg + 1u) * nx) xb_add(&bar[XB_TOPGEN], 1u);
            else XB_SPIN(xb_ld(&bar[XB_TOPGEN]) == tg, bar);
            __builtin_amdgcn_fence(__ATOMIC_ACQUIRE, "agent");
            xb_add(&bar[XB_XGEN(b.x)], 1u);
            asm volatile("s_waitcnt vmcnt(0)" ::: "memory");
        } else {
            XB_SPIN(xb_ld(&bar[XB_XGEN(b.x)]) == gen, bar);
            __builtin_amdgcn_fence(__ATOMIC_ACQUIRE, "agent");
            asm volatile("s_waitcnt vmcnt(0)" ::: "memory");
        }
    }
    __syncthreads();
}

__device__ __forceinline__ float wave_sum(float v) {
#pragma unroll
    for (int o = 1; o < 64; o <<= 1) v += __shfl_xor(v, o);
    return v;
}
__device__ __forceinline__ int dst_row(int mode, int n) {
    if (mode == 1) {
        if (n < 512) { const int base = n & ~255, j = n & 255, hh = j >> 6, d = j & 63; return base + ((d < 32) ? (32 * hh + d) : (128 + 32 * hh + (d - 32))); }
        if (n >= PC_MQ && n < PC_MV) { const int d = n & 63; if (d < 16) { const int nn = d >> 3, fq = (d >> 2) & 1, e = d & 3; return (n & ~63) + 8 * fq + 4 * nn + e; } }
        return n;
    }
    if (mode == 2) { return (n < 1024) ? (256 * (n >> 7) + (n & 127)) : (256 * ((n - 1024) >> 7) + 128 + ((n - 1024) & 127)); }
    return n;
}
__device__ __forceinline__ void p0_load(f32x4 (&v)[8], const float* W, int N, int item, int lane) {
    const int nblk = N / 32, kb = item / nblk, nb = item % nblk, k0 = 64 * kb, n0 = 32 * nb;
#pragma unroll
    for (int j = 0; j < 8; ++j) v[j] = __builtin_nontemporal_load((const f32x4*)(W + (size_t)(k0 + 8 * j + (lane >> 3)) * N + n0 + 4 * (lane & 7)));
}
template <bool FP8_>
__device__ __forceinline__ void p0_finish(const f32x4 (&v)[8], int K, int N, void* WTv, int mode, float scale, LAS float* scr, int item, int lane) {
    const int nblk = N / 32, kb = item / nblk, nb = item % nblk, k0 = 64 * kb, n0 = 32 * nb;
#pragma unroll
    for (int j = 0; j < 8; ++j) { LAS float* d = scr + (8 * j + (lane >> 3)) * 33 + 4 * (lane & 7); d[0] = v[j].x * scale; d[1] = v[j].y * scale; d[2] = v[j].z * scale; d[3] = v[j].w * scale; }
    LDS_WAIT(); asm volatile("" ::: "memory");
    const int c = lane & 7;
#pragma unroll
    for (int j = 0; j < 4; ++j) { const int n = (lane >> 3) + 8 * j; const LAS float* s = scr + (8 * c) * 33 + n;
        const f32x4 a = (f32x4){s[0 * 33], s[1 * 33], s[2 * 33], s[3 * 33]}, b = (f32x4){s[4 * 33], s[5 * 33], s[6 * 33], s[7 * 33]};
        if constexpr (FP8_) *(GAS u32x2*)((unsigned char*)WTv + (size_t)dst_row(mode, n0 + n) * K + k0 + 8 * c) = pack8_fp8(a, b);
        else { u32x4 o; o.x = pk2(a[0], a[1]); o.y = pk2(a[2], a[3]); o.z = pk2(b[0], b[1]); o.w = pk2(b[2], b[3]); *(GAS u32x4*)((bf16_t*)WTv + (size_t)dst_row(mode, n0 + n) * K + k0 + 8 * c) = o; } }
    LDS_WAIT(); asm volatile("" ::: "memory");
}
__device__ __forceinline__ void p0_finish6(const f32x4 (&v)[8], int N, unsigned char* W6, int mode, float scale, LAS float* scr, int item, int lane) {
    const int nblk = N / 32, kb = item / nblk, nb = item % nblk, k0 = 64 * kb, n0 = 32 * nb;
#pragma unroll
    for (int j = 0; j < 8; ++j) { LAS float* d = scr + (8 * j + (lane >> 3)) * 33 + 4 * (lane & 7); d[0] = v[j].x * scale; d[1] = v[j].y * scale; d[2] = v[j].z * scale; d[3] = v[j].w * scale; }
    LDS_WAIT(); asm volatile("" ::: "memory");
    const int nl = lane & 31, blk = lane >> 5; const LAS float* s = scr + (32 * blk) * 33 + nl;
    v32h hv;
#pragma unroll
    for (int i = 0; i < 32; ++i) hv[i] = (_Float16)s[i * 33];
    const v6u dd = __builtin_amdgcn_cvt_scalef32_pk32_fp6_f16(hv, 1.0f);
    const int row = dst_row(mode, n0 + nl), pn = row >> 8, h = (row >> 7) & 1, s128 = row & 127, sg_ = s128 & 31, rr = (s128 & ~31) + 16 * ((sg_ >> 2) & 1) + 4 * (sg_ >> 3) + (sg_ & 3);
    const int kt = k0 >> 7, fq = ((k0 >> 6) & 1) * 2 + blk;
    unsigned char* img = W6 + (size_t)(pn * 8 + kt) * 24576 + h * 12288;
    const unsigned d0 = dd[0], d1 = dd[1], d2 = dd[2], d3 = dd[3], d4 = dd[4], d5 = dd[5];
    const bool n1 = (rr >> 4) & 1;
    u32x4 o16; o16.x = n1 ? d2 : d0; o16.y = n1 ? d3 : d1; o16.z = n1 ? d4 : d2; o16.w = n1 ? d5 : d3;
    u32x2 o8; o8.x = n1 ? d0 : d4; o8.y = n1 ? d1 : d5;
    *(GAS u32x4*)(img + (rr * 4 + fq) * 16) = o16; *(GAS u32x2*)(img + 8192 + ((((rr >> 5) * 16 + (rr & 15)) * 4 + fq) * 16) + (n1 ? 8 : 0)) = o8;
    LDS_WAIT(); asm volatile("" ::: "memory");
}
template <bool FP8_>
__device__ __forceinline__ void p0_item(const float* W, int K, int N, void* WTv, int mode, float scale, LAS float* scr, int item, int lane) {
    f32x4 v[8]; p0_load(v, W, N, item, lane); p0_finish<FP8_>(v, K, N, WTv, mode, scale, scr, item, lane);
}
__device__ __forceinline__ void sincos_acc(float af, float& sn, float& cs) {
    const double a = (double)af; const double k = rint(a * 0.15915494309189535); double r = a - k * 6.283185307179586;
    double sgn = 1.0; if (r > 1.5707963267948966) { r = 3.141592653589793 - r; sgn = -1.0; } else if (r < -1.5707963267948966) { r = -3.141592653589793 - r; sgn = -1.0; }
    const double r2 = r * r;
    double s = -1.0 / 355687428096000.0; s = s * r2 + 1.0 / 1307674368000.0; s = s * r2 - 1.0 / 6227020800.0; s = s * r2 + 1.0 / 39916800.0; s = s * r2 - 1.0 / 362880.0; s = s * r2 + 1.0 / 5040.0; s = s * r2 - 1.0 / 120.0; s = s * r2 + 1.0 / 6.0; s = r - r * r2 * s;
    double c = 1.0 / 20922789888000.0; c = c * r2 - 1.0 / 87178291200.0; c = c * r2 + 1.0 / 479001600.0; c = c * r2 - 1.0 / 3628800.0; c = c * r2 + 1.0 / 40320.0; c = c * r2 - 1.0 / 720.0; c = c * r2 + 1.0 / 24.0; c = c * r2 - 0.5; c = 1.0 + c * r2;
    sn = (float)s; cs = (float)(sgn * c);
}


#ifdef PROBE_CHECK
__device__ __forceinline__ void probe_check(int c, const float* x, const float* nw1, const float* w_in, const float* rnw, const bf16_t* MIX, float* SC, gu32* res, LAS unsigned char* lds) {
    const int tid = threadIdx.x;
    const int tt[8] = {2047, 1300, 777, 300, 1999, 1024, 255, 1535};
    const int b = (5 * c + 3) & 31, t = tt[c & 7], hr = c & 3, hm = (3 * c + 1) & 7, blk = t >> 8;
    LAS float* L = (LAS float*)lds;
    const size_t tok0 = (size_t)b * SEQ;
    for (int s_ = tid; s_ <= t; s_ += 512) {
        const float* xr = x + (tok0 + s_) * DM; float ss = 0.f;
        for (int k = 0; k < DM; ++k) ss += xr[k] * xr[k];
        const float rstd = 1.0f / sqrtf(ss * (1.f / DM) + RMS_EPS);
        for (int cc = 0; cc < 20; ++cc) {
            const int cb = cc < 4 ? 256 + 64 * hr + 16 * cc : cc < 12 ? 512 + 128 * hr + 16 * (cc - 4) : cc < 16 ? 2048 + 64 * hm + 16 * (cc - 12) : 2560 + 64 * hm + 16 * (cc - 16);
            float acc[16];
#pragma unroll
            for (int j = 0; j < 16; ++j) acc[j] = 0.f;
            for (int k = 0; k < DM; ++k) { const float hv = xr[k] * rstd * nw1[k]; const float* wr_ = w_in + (size_t)k * DIN + cb;
#pragma unroll
                for (int j = 0; j < 16; ++j) acc[j] += hv * wr_[j]; }
#pragma unroll
            for (int j = 0; j < 16; ++j) SC[(size_t)s_ * 320 + 16 * cc + j] = acc[j];
        }
        float* kr = SC + (size_t)s_ * 320;
        for (int i = 0; i < 32; ++i) { const float inv = (float)exp2(-(double)i / 32.0 * 13.287712379549449); float sn, cs; sincos_acc((float)s_ * inv, sn, cs);
            const float a = kr[i], bb = kr[32 + i]; kr[i] = (a * cs - bb * sn) * 0.125f; kr[32 + i] = (a * sn + bb * cs) * 0.125f; }
        float* km = SC + (size_t)s_ * 320 + 192;
        for (int i = 0; i < 8; ++i) { const float inv = (float)exp2(-(double)i / 8.0 * 18.931568569324174); float sn, cs; sincos_acc((float)s_ * inv, sn, cs);
            const float a = km[i], bb = km[8 + i]; km[i] = a * cs - bb * sn; km[8 + i] = a * sn + bb * cs; }
    }
    { const float* xr = x + (tok0 + t) * DM; float ss = 0.f; for (int k = 0; k < DM; ++k) ss += xr[k] * xr[k]; const float rstd = 1.0f / sqrtf(ss * (1.f / DM) + RMS_EPS);
      for (int k = tid; k < DM; k += 512) L[k] = xr[k] * rstd * nw1[k]; }
    __threadfence(); __syncthreads();
    if (tid < 256) { const int col = tid < 64 ? 64 * hr + tid : tid < 128 ? 1536 + 64 * hm + (tid - 64) : 1024 + 128 * hr + (tid - 128); float a = 0.f;
        for (int k = 0; k < DM; ++k) a += L[k] * w_in[(size_t)k * DIN + col];
        L[1024 + tid] = a; }
    __syncthreads();
    if (tid < 32) { const float inv = (float)exp2(-(double)tid / 32.0 * 13.287712379549449); float sn, cs; sincos_acc((float)t * inv, sn, cs);
        const float a = L[1024 + tid], bb = L[1024 + 32 + tid]; L[1024 + tid] = a * cs - bb * sn; L[1024 + 32 + tid] = a * sn + bb * cs; }
    if (tid >= 64 && tid < 72) { const int i = tid - 64; const float inv = (float)exp2(-(double)i / 8.0 * 18.931568569324174); float sn, cs; sincos_acc((float)t * inv, sn, cs);
        const float a = L[1024 + 64 + i], bb = L[1024 + 64 + 8 + i]; L[1024 + 64 + i] = a * cs - bb * sn; L[1024 + 64 + 8 + i] = a * sn + bb * cs; }
    __syncthreads();
    const float lg2 = log2f(1.0f - exp2f(-5.0f - (float)hr));
    for (int s_ = tid; s_ < SEQ; s_ += 512) { float w_ = 0.f; if (s_ <= t) { const float* kr = SC + (size_t)s_ * 320; float d = 0.f; for (int i = 0; i < 64; ++i) d += L[1024 + i] * kr[i]; w_ = d * exp2f(lg2 * (float)(t - s_)); } L[2048 + s_] = w_; }
    __syncthreads();
    if (tid < 128) { float a = 0.f; for (int s_ = 0; s_ <= t; ++s_) a += L[2048 + s_] * SC[(size_t)s_ * 320 + 64 + tid]; L[4096 + tid] = a; }
    __syncthreads();
    if (tid == 0) { float mu = 0.f; for (int e = 0; e < 128; ++e) mu += L[4096 + e]; mu *= (1.f / 128.f); float var = 0.f; for (int e = 0; e < 128; ++e) { const float d = L[4096 + e] - mu; var += d * d; } var *= (1.f / 128.f); L[4300] = mu; L[4301] = 1.0f / sqrtf(var + GN_EPS); }
    __syncthreads();
    if (tid < 128) { const float gv = L[1024 + 128 + tid]; const float ref = (L[4096 + tid] - L[4300]) * L[4301] * rnw[128 * hr + tid] * (gv / (1.f + expf(-gv)));
        const float got = bf2f(MIX[(tok0 + t) * DM + 128 * hr + tid]); L[4400 + tid] = fabsf(ref - got); L[4600 + tid] = fabsf(ref); }
    __syncthreads();
    if (tid == 0) { float me = 0.f, mr = 1e-20f; for (int e = 0; e < 128; ++e) { me = fmaxf(me, L[4400 + e]); mr = fmaxf(mr, L[4600 + e]); } atomicMax((unsigned*)res, __float_as_uint(me / mr)); }
    __syncthreads();
    for (int i = tid; i < blk * 64; i += 512) { const int j = i >> 6, d = i & 63; float a = 0.f; for (int s_ = 256 * j; s_ < 256 * j + 256; ++s_) a += SC[(size_t)s_ * 320 + 192 + d]; L[4800 + i] = a * (1.f / 256.f); }
    __syncthreads();
    if (tid < 8) { float gsum = -INFINITY; if (tid < blk) { gsum = 0.f; for (int d = 0; d < 64; ++d) gsum += L[1024 + 64 + d] * L[4800 + tid * 64 + d]; } L[5400 + tid] = gsum; }
    __syncthreads();
    if (tid == 0) { unsigned sel = 0u; const int ns = blk < 3 ? blk : 3; float g8[8]; for (int j = 0; j < 8; ++j) g8[j] = L[5400 + j];
        for (int r = 0; r < ns; ++r) { int bi = -1; float bv = -INFINITY; for (int j = 0; j < blk; ++j) if (!((sel >> j) & 1u) && g8[j] > bv) { bv = g8[j]; bi = j; } if (bi >= 0) sel |= 1u << bi; }
        L[5420] = __uint_as_float(sel); }
    __syncthreads();
    const unsigned selm = __float_as_uint(L[5420]);
    for (int s_ = tid; s_ < SEQ; s_ += 512) { float lgt = -INFINITY; const int sb = s_ >> 8;
        if (s_ <= t && (sb == blk || ((selm >> sb) & 1u))) { const float* km = SC + (size_t)s_ * 320 + 192; float d = 0.f; for (int i = 0; i < 64; ++i) d += L[1024 + 64 + i] * km[i]; lgt = d * 0.125f; }
        L[2048 + s_] = lgt; }
    __syncthreads();
    if (tid == 0) { float mx = -INFINITY; for (int s_ = 0; s_ <= t; ++s_) mx = fmaxf(mx, L[2048 + s_]); L[5430] = mx; }
    __syncthreads();
    for (int s_ = tid; s_ < SEQ; s_ += 512) L[2048 + s_] = (s_ <= t) ? expf(L[2048 + s_] - L[5430]) : 0.f;
    __syncthreads();
    if (tid == 0) { float sm = 0.f; for (int s_ = 0; s_ <= t; ++s_) sm += L[2048 + s_]; L[5431] = sm; }
    __syncthreads();
    if (tid < 64) { float a = 0.f; for (int s_ = 0; s_ <= t; ++s_) a += L[2048 + s_] * SC[(size_t)s_ * 320 + 256 + tid]; const float ref = a / L[5431];
        const float got = bf2f(MIX[(tok0 + t) * DM + 512 + 64 * hm + tid]); L[4400 + tid] = fabsf(ref - got); L[4600 + tid] = fabsf(ref); }
    __syncthreads();
    if (tid == 0) { float me = 0.f, mr = 1e-20f; for (int e = 0; e < 64; ++e) { me = fmaxf(me, L[4400 + e]); mr = fmaxf(mr, L[4600 + e]); } atomicMax((unsigned*)res + 64, __float_as_uint(me / mr)); }
    __syncthreads();
}
#endif

struct Args { const float* in[13]; float* out; unsigned char* ws; int ph_lo, ph_hi, li, pad; };
constexpr int N_PHASES = 8;

__global__ void __launch_bounds__(NWAVES * 64, 2) fwd_mega(Args args) {
    extern __shared__ __attribute__((aligned(16))) unsigned char lds_raw[];
    LAS unsigned char* lds = (LAS unsigned char*)lds_raw;
    volatile LAS unsigned* MISC = (volatile LAS unsigned*)(lds + MISC_OFF);
    LAS int* LTAB = (LAS int*)(lds + LTAB_OFF);
#define PHASE_IDS() int tid_o_ = threadIdx.x; asm volatile("" : "+v"(tid_o_)); const int tid = tid_o_, lane = tid & 63, wave = __builtin_amdgcn_readfirstlane(tid >> 6); (void)lane; (void)wave
    const int G = gridDim.x, bx = blockIdx.x; const int vcu = (G % 8 == 0) ? (bx % 8) * (G / 8) + bx / 8 : bx;
    unsigned char* ws = args.ws;
    gu32* ctl = (gu32*)(ws + WS_CTL);
    const float* x = args.in[0]; const float* norm1_w = args.in[1]; const float* w_in = args.in[2]; const float* ret_norm_w = args.in[3]; const float* w_out = args.in[4];
    const float* norm2_w = args.in[5]; const float* w_router = args.in[6]; const float* b_router = args.in[7]; const float* w1 = args.in[8]; const float* b1 = args.in[9];
    const float* w2 = args.in[10]; const float* b2 = args.in[11]; const float* final_w = args.in[12];
    float* out = args.out;
    float* rope = (float*)(ws + WS_ROPE); float* rc = rope; float* rs = rope + SEQ * 32; float* mc = rope + 2 * SEQ * 32; float* ms = mc + SEQ * 8;
    float* ksum = (float*)(ws + WS_KSUM); float* rstd1 = (float*)(ws + WS_RSTD); float* inw1 = (float*)(ws + WS_RSTD + 262144);
    bf16_t* wrf = (bf16_t*)(ws + WS_WRF); float* srstd = (float*)(ws + WS_SRSTD); float* sgate = (float*)(ws + WS_SGATE); int* slot = (int*)(ws + WS_SLOT);
    bf16_t* WinT = (bf16_t*)(ws + WS_WIN); bf16_t* WoutT = (bf16_t*)(ws + WS_WOUT); unsigned char* W2T = ws + WS_W2; unsigned char* W1T = ws + WS_W1;
    bf16_t* PROJ = (bf16_t*)(ws + WS_PROJ); bf16_t* MIX = (bf16_t*)(ws + WS_MIX); unsigned char* ACT = ws + WS_ACT; bf16_t* XN = (bf16_t*)(ws + WS_XN); unsigned char* H2q = ws + WS_H2Q; bf16_t* DELTA = (bf16_t*)(ws + WS_DELTA); unsigned char* Y4 = ws + WS_Y4; bf16_t* RST = (bf16_t*)(ws + WS_RST);

    { PHASE_IDS(); for (int u = tid; u < (LDS_BYTES - LDSCTL_OFF) / 4; u += NWAVES * 64) ((LAS unsigned*)(lds + LDSCTL_OFF))[u] = 0u; }
    __syncthreads();
    const bool use_bar = (MK_N_LAUNCHES != N_PHASES);
    XcdBarrier bar; bar.bar = (unsigned*)(ctl + CW_BAR) + args.li * XCD_BAR_WORDS; bar.x = 0; bar.st = nullptr;
    if (use_bar) bar = xcd_barrier_post((unsigned*)(ctl + CW_BAR) + args.li * XCD_BAR_WORDS, MISC + 8);
    const int lo = args.ph_lo, hi = args.ph_hi;
#ifndef PHASE_MASK
#define PHASE_MASK 0xff
#endif
#ifndef PROBE_DUP
#define PROBE_DUP -1
#endif
#define NREP(k) ((PROBE_DUP) == (k) ? 2 : 1)
#define IN(k) ((((PHASE_MASK) >> (k)) & 1) && lo <= (k) && (k) < hi)
#define SEAM(k) do { if (IN(k) && IN((k) + 1)) xcd_barrier(bar); } while (0)

    if (IN(0)) for (int rep_ = 0; rep_ < NREP(0); ++rep_) { PHASE_IDS();
        LAS float* scr = (LAS float*)(lds + wave * 16384);
        const int gw = vcu * NWAVES + wave, NGW = G * NWAVES;
        constexpr int I_IN = (DM / 64) * (DIN / 32), I_OUT = (DM / 64) * (DM / 32), I_1E = (DM / 64) * (2048 / 32), I_2E = (DM / 64) * (DM / 32);
        constexpr int I_1 = NEXP * I_1E, I_2 = NEXP * I_2E, NITEMS = I_IN + I_OUT + I_1 + I_2;
        {
            auto src_of = [&](int r, const float*& W, int& N, int& loc) { if (r < I_1) { const int e = r / I_1E; W = w1 + (size_t)e * DM * 2048; N = 2048; loc = r % I_1E; } else { r -= I_1; const int e = r / I_2E; W = w2 + (size_t)e * DM * DM; N = DM; loc = r % I_2E; } };
            f32x4 vc[8], vn[8]; int it = gw + (CONV_IN_P2 ? (I_1 + I_2) : 0);
            if (it < I_1 + I_2) { const float* W; int N, loc; src_of(it, W, N, loc); p0_load(vc, W, N, loc, lane); }
            for (; it < I_1 + I_2; it += NGW) {
                const int nx = it + NGW;
                if (nx < I_1 + I_2) { const float* W; int N, loc; src_of(nx, W, N, loc); p0_load(vn, W, N, loc, lane); }
                if (it < I_1) { const int e = it / I_1E; if constexpr (MOE_B6) p0_finish6(vc, 2048, W1T + (size_t)e * 2048 * 768, 2, 64.f, scr, it % I_1E, lane); else p0_finish<true>(vc, DM, 2048, W1T + (size_t)e * 2048 * DM, 2, 64.f, scr, it % I_1E, lane); }
                else { const int r = it - I_1, e = r / I_2E; if constexpr (MOE_B6) p0_finish6(vc, DM, W2T + (size_t)e * DM * 768, 0, 64.f, scr, r % I_2E, lane); else p0_finish<true>(vc, DM, DM, W2T + (size_t)e * DM * DM, 0, 64.f, scr, r % I_2E, lane); }
#pragma unroll
                for (int j = 0; j < 8; ++j) vc[j] = vn[j];
            }
        }
        for (int it = gw; it < I_IN + I_OUT; it += NGW) {
            if (it < I_IN) p0_item<false>(w_in, DM, DIN, WinT, 1, 1.f, scr, it, lane);
            else p0_item<false>(w_out, DM, DM, WoutT, 0, 1.f, scr, it - I_IN, lane);
        }
        {
            f32x4 wv[4];
#pragma unroll
            for (int j = 0; j < 4; ++j) wv[j] = *((const f32x4*)norm1_w + lane + 64 * j);
            for (int m = gw; m < NTOK; m += 2 * NGW) {
                const int m1 = (m + NGW < NTOK) ? m + NGW : m;
                const f32x4* xr0 = (const f32x4*)(x + (size_t)m * DM) + lane; const f32x4* xr1 = (const f32x4*)(x + (size_t)m1 * DM) + lane; f32x4 v0[4], v1[4]; float s0 = 0.f, s1 = 0.f;
#pragma unroll
                for (int j = 0; j < 4; ++j) { v0[j] = __builtin_nontemporal_load(xr0 + 64 * j); v1[j] = __builtin_nontemporal_load(xr1 + 64 * j); }
#pragma unroll
                for (int j = 0; j < 4; ++j) { s0 += (v0[j].x * v0[j].x + v0[j].y * v0[j].y) + (v0[j].z * v0[j].z + v0[j].w * v0[j].w); s1 += (v1[j].x * v1[j].x + v1[j].y * v1[j].y) + (v1[j].z * v1[j].z + v1[j].w * v1[j].w); }
                const float r0 = 1.0f / sqrtf(wave_sum(s0) * (1.f / DM) + RMS_EPS), r1 = 1.0f / sqrtf(wave_sum(s1) * (1.f / DM) + RMS_EPS);
                if (lane == 0) { rstd1[m] = r0; rstd1[m1] = r1; }
                unsigned long long* o0 = (unsigned long long*)(XN + (size_t)m * DM) + lane; unsigned long long* o1 = (unsigned long long*)(XN + (size_t)m1 * DM) + lane;
#pragma unroll
                for (int j = 0; j < 4; ++j) { const f32x4 y = v0[j] * r0 * wv[j]; o0[64 * j] = (unsigned long long)pk2(y.x, y.y) | ((unsigned long long)pk2(y.z, y.w) << 32); }
                if (m1 != m) {
#pragma unroll
                    for (int j = 0; j < 4; ++j) { const f32x4 y = v1[j] * r1 * wv[j]; o1[64 * j] = (unsigned long long)pk2(y.x, y.y) | ((unsigned long long)pk2(y.z, y.w) << 32); } }
            }
        }
        {
            const int gt = vcu * (NWAVES * 64) + tid, NGT = G * NWAVES * 64;
            for (int idx = gt; idx < SEQ * 32 + SEQ * 8; idx += NGT) {
                if (idx < SEQ * 32) { const int s = idx >> 5, i = idx & 31; const float inv = (float)exp2(-(double)i / 32.0 * 13.287712379549449);
                    float sn, cs; sincos_acc((float)s * inv, sn, cs); rc[idx] = cs; rs[idx] = sn; }
                else { const int j = idx - SEQ * 32, s = j >> 3, i = j & 7; const float inv = (float)exp2(-(double)i / 8.0 * 18.931568569324174);
                    float sn, cs; sincos_acc((float)s * inv, sn, cs); mc[j] = cs; ms[j] = sn; }
            }
            for (int idx = gt; idx < DM; idx += NGT) inw1[idx] = 1.0f / norm1_w[idx];
            for (int idx = gt; idx < 32 * 2 * 64 * 8; idx += NGT) {
                const int j = idx & 7, ln = (idx >> 3) & 63, eh = (idx >> 9) & 1, ks = idx >> 10;
                const int k = 32 * ks + 8 * (ln >> 4) + j, e = 16 * eh + (ln & 15);
                const float wv = w_router[(size_t)k * NEXP + e]; const unsigned hb = f2bf(wv); const float lof = wv - bf2f((unsigned short)hb);
                wrf[(((size_t)(ks * 2 + eh) * 2 + 0) * 64 + ln) * 8 + j] = (bf16_t)hb;
                wrf[(((size_t)(ks * 2 + eh) * 2 + 1) * 64 + ln) * 8 + j] = (bf16_t)f2bf(lof);
            }
        }
    }
    SEAM(0);

    if (IN(1)) for (int rep_ = 0; rep_ < NREP(1); ++rep_) {
        pg8::ProbInProj P; P.A = XN; P.Bt = WinT; P.nM = NTOK / 256; P.nN = DIN / 256; P.G = G; P.c = bx;
        P.PROJ = PROJ; P.rc = rc; P.rs = rs; P.mc = mc; P.ms = ms; P.ksum = ksum;
        pg8::gemm_phase<pg8::ProbInProj, true>(lds, P);
    }
    SEAM(1);

    if (IN(2)) for (int rep_ = 0; rep_ < NREP(2); ++rep_) { PHASE_IDS();
        constexpr int QLEN = 528 + (CONV_IN_P2 ? 128 : 0);
#ifdef PROBE_TS
        const unsigned long long tp0_ = __builtin_amdgcn_s_memrealtime();
#endif
        int q = (int)(xb_xcc_id() & 7u), tried = 0; unsigned ready_mask = 0u, steal = 0u;
        if (tid == 0) MISC[16] = __hip_atomic_fetch_add(ctl + CW_QUEUE + 64 * (8 * rep_ + q), 1u, RLX_AGENT);
        __syncthreads();
        int id = __builtin_amdgcn_readfirstlane((int)MISC[16]);
        for (;;) {
            if (id >= QLEN) {
                if (tried == 0) { __syncthreads();
                    if (tid == 0) { unsigned cnt[8]; unsigned m = 0u;
#pragma unroll
                        for (int k = 0; k < 8; ++k) cnt[k] = __hip_atomic_load(ctl + CW_QUEUE + 64 * (8 * rep_ + k), RLX_AGENT);
#pragma unroll
                        for (int k = 0; k < 8; ++k) m |= (cnt[k] < (unsigned)QLEN ? 1u : 0u) << k;
                        MISC[18] = m; }
                    __syncthreads(); steal = MISC[18]; }
                ++tried; int nq = -1;
                for (int k = 1; k < 8; ++k) { const int qq = (q + k) & 7; if ((steal >> qq) & 1u) { nq = qq; break; } }
                if (nq < 0) break;
                steal &= ~(1u << nq); q = nq;
                __syncthreads();
                if (tid == 0) MISC[16] = __hip_atomic_fetch_add(ctl + CW_QUEUE + 64 * (8 * rep_ + q), 1u, RLX_AGENT);
                __syncthreads();
                id = __builtin_amdgcn_readfirstlane((int)MISC[16]);
                continue;
            }
            unsigned nid = 0u; if (tid == 0) nid = __hip_atomic_fetch_add(ctl + CW_QUEUE + 64 * (8 * rep_ + q), 1u, RLX_AGENT);
#ifdef PROBE_KIND
            if (rep_ == 1 && !((PROBE_KIND == 1 && id < 16) || (PROBE_KIND == 2 && id >= 16 && id < 272) || (PROBE_KIND == 3 && id >= 272))) { if (tid == 0) MISC[16] = nid; __syncthreads(); id = __builtin_amdgcn_readfirstlane((int)MISC[16]); __syncthreads(); continue; }
#endif
#ifdef PROBE_TS
            const unsigned long long tu0_ = __builtin_amdgcn_s_memrealtime();
#endif
            if (id < 16) {
                const int bh = 16 * q + id;
                ret::ret_state_unit(bh >> 2, bh & 3, PROJ, RST, lds);
                asm volatile("s_waitcnt vmcnt(0)" ::: "memory");
                __syncthreads();
                if (tid == 0) { __builtin_amdgcn_fence(__ATOMIC_RELEASE, "agent"); asm volatile("s_waitcnt vmcnt(0)" ::: "memory");
                    __hip_atomic_fetch_add(ctl + CW_RDONE + 64 * (8 * rep_ + q), 1u, RLX_AGENT); }
            } else if (id >= QLEN - 256) {
                if (!((ready_mask >> q) & 1u)) {
                    if (tid == 0) { unsigned sp = 0;
                        while (__hip_atomic_load(ctl + CW_RDONE + 64 * (8 * rep_ + q), RLX_AGENT) < 16u) { __builtin_amdgcn_s_sleep(8);
                            if (++sp > (1u << 20)) { __hip_atomic_store(ctl + CW_TMO, 1u, RLX_AGENT); break; } }
                        __builtin_amdgcn_fence(__ATOMIC_ACQUIRE, "agent"); asm volatile("s_waitcnt vmcnt(0)" ::: "memory"); }
                    __syncthreads();
                    ready_mask |= 1u << q;
                }
                const int u = id - (QLEN - 256), bh = 16 * q + (u >> 4); ret::ret_out_unit(bh >> 2, bh & 3, u & 15, PROJ, RST, ret_norm_w, MIX, lds, MISC + 16, nid);
            } else if (CONV_IN_P2 && (id - 16) % 3 == 2) {
                int t2_ = threadIdx.x; asm volatile("" : "+v"(t2_)); const int lane2 = t2_ & 63, wave2 = __builtin_amdgcn_readfirstlane(t2_ >> 6);
                constexpr int I_1E = (DM / 64) * (2048 / 32), I_2E = (DM / 64) * (DM / 32), I_1 = NEXP * I_1E;
                LAS float* scr = (LAS float*)(lds + wave2 * 16384);
                const int cu = 128 * q + (id - 16) / 3, it0 = cu * 48 + wave2 * 6;
                auto src_of = [&](int r, const float*& W, int& N, int& loc) { if (r < I_1) { const int e = r / I_1E; W = w1 + (size_t)e * DM * 2048; N = 2048; loc = r % I_1E; } else { r -= I_1; const int e = r / I_2E; W = w2 + (size_t)e * DM * DM; N = DM; loc = r % I_2E; } };
                auto ld = [&](f32x4 (&v)[8], int it) { const float* W; int N, loc; src_of(it, W, N, loc); p0_load(v, W, N, loc, lane2); };
                auto fin = [&](const f32x4 (&v)[8], int it) {
                    if (it < I_1) { const int e = it / I_1E; if constexpr (MOE_B6) p0_finish6(v, 2048, W1T + (size_t)e * 2048 * 768, 2, 64.f, scr, it % I_1E, lane2); else p0_finish<true>(v, DM, 2048, W1T + (size_t)e * 2048 * DM, 2, 64.f, scr, it % I_1E, lane2); }
                    else { const int r = it - I_1, e = r / I_2E; if constexpr (MOE_B6) p0_finish6(v, DM, W2T + (size_t)e * DM * 768, 0, 64.f, scr, r % I_2E, lane2); else p0_finish<true>(v, DM, DM, W2T + (size_t)e * DM * DM, 0, 64.f, scr, r % I_2E, lane2); } };
                f32x4 v0[8], v1[8], v2[8]; ld(v0, it0); ld(v1, it0 + 1);
#pragma unroll 1
                for (int k = 0; k < 6; k += 3) { const int it = it0 + k;
                    ld(v2, it + 2); fin(v0, it);
                    if (k == 0) ld(v0, it + 3);
                    fin(v1, it + 1);
                    if (k == 0) ld(v1, it + 4);
                    fin(v2, it + 2); }
                if (tid == 0) MISC[16] = nid;
                LDS_BARRIER();
            } else { const int jm = id - 16, j = CONV_IN_P2 ? (jm / 3) * 2 + (jm % 3) : jm, bh = 32 * q + (j >> 3), qb = 7 - (j & 7);
                moba::moba_unit<8>(bh >> 3, bh & 7, qb, (const moba::bf16*)PROJ, ksum, (moba::bf16*)MIX, (char*)lds_raw, MISC + 16, nid, MISC + 20); }
#ifdef PROBE_TS
            if (tid == 0) { const unsigned dt_ = (unsigned)(__builtin_amdgcn_s_memrealtime() - tu0_); if (id < 16) MISC[25] += dt_; else if (id >= 272) MISC[26] += dt_; else MISC[28] += dt_; }
#endif
            if (id < 16 && tid == 0) MISC[16] = nid;
            LDS_BARRIER();
            id = __builtin_amdgcn_readfirstlane((int)MISC[16]);
        }
#ifdef PROBE_TS
        if (tid == 0) { const unsigned lt_ = (unsigned)(__builtin_amdgcn_s_memrealtime() - tp0_); MISC[27] = lt_; atomicMax((unsigned*)(ctl + 49152 + 128), lt_); atomicMin((unsigned*)(ctl + 49152 + 192), lt_ ^ 0x7fffffffu ? lt_ : lt_); atomicAdd((unsigned*)(ctl + 49152 + 256), lt_ >> 8); }
#endif
    }
    SEAM(2);
#ifdef PROBE_CHECK
    if (IN(2) && bx < 8) probe_check(bx, x, norm1_w, w_in, ret_norm_w, MIX, (float*)(ws + 920 * MiB) + (size_t)bx * (1u << 20), ctl + 49152, lds);
    if (IN(2)) xcd_barrier(bar);
#endif

    if (IN(3)) for (int rep_ = 0; rep_ < NREP(3); ++rep_) {
        pg8::ProbOutProj P; P.A = MIX; P.Bt = WoutT; P.nM = NTOK / 256; P.nN = DM / 256; P.G = G; P.c = bx; P.D = DELTA;
        pg8::gemm_phase<pg8::ProbOutProj, true>(lds, P);
    }
    SEAM(3);

    if (IN(4)) { PHASE_IDS();
        LAS float* lg = (LAS float*)(lds) + wave * (32 * 33);
        LAS unsigned* pinfo = (LAS unsigned*)(lds + 40960);
        LAS float* pgate = (LAS float*)(lds + 40960 + 4096);
        LAS unsigned* lcnt = (LAS unsigned*)(lds + 40960 + 8192);
        LAS unsigned* lbase = lcnt + 32;
        LAS float* prstd = (LAS float*)(lds + 40960 + 8192 + 256);
        const int c16 = lane & 15, g = lane >> 4;
        constexpr int WRF_L = 0, NW_L = 131072, IW_L = 131072 + 4096;
        for (int blk = bx; blk < NTOK / 256; blk += G) {
            {
#pragma unroll
                for (int i = 0; i < 16; ++i) __builtin_amdgcn_global_load_lds((const unsigned*)((const char*)wrf + (size_t)i * 8192 + tid * 16), (LAS unsigned*)(lds + WRF_L + i * 8192 + wave * 1024), 16, 0, 0);
                if (wave < 4) __builtin_amdgcn_global_load_lds((const unsigned*)((const char*)norm2_w + tid * 16), (LAS unsigned*)(lds + NW_L + wave * 1024), 16, 0, 0);
                else __builtin_amdgcn_global_load_lds((const unsigned*)((const char*)inw1 + (tid - 256) * 16), (LAS unsigned*)(lds + IW_L + (wave - 4) * 1024), 16, 0, 0);
            }
            const int R0 = blk * 256 + wave * 32;
            f32x4 acc[2][2]; float ssq[2] = {0.f, 0.f}; float irs[2];
#pragma unroll
            for (int tt = 0; tt < 2; ++tt) irs[tt] = 1.0f / rstd1[R0 + 16 * tt + c16];
#pragma unroll
            for (int tt = 0; tt < 2; ++tt)
#pragma unroll
                for (int eh = 0; eh < 2; ++eh) acc[tt][eh] = (f32x4){0.f, 0.f, 0.f, 0.f};
            constexpr int TK = 2;
            u32x4 xq[TK][2], dq[TK][2];
            auto ldtrip = [&](u32x4 (&xa)[TK][2], u32x4 (&da)[TK][2], int ks0) {
#pragma unroll
                for (int k = 0; k < TK; ++k)
#pragma unroll
                    for (int tt = 0; tt < 2; ++tt) { const size_t ro = (size_t)(R0 + 16 * tt + c16) * DM + 32 * (ks0 + k) + 8 * g; xa[k][tt] = *(const u32x4*)(XN + ro); da[k][tt] = *(const u32x4*)(DELTA + ro); } };
            ldtrip(xq, dq, 0);
            asm volatile("s_waitcnt vmcnt(8)" ::: "memory");
            __syncthreads();
#pragma unroll 1
            for (int ks0 = 0; ks0 < 32; ks0 += TK) {
                u32x4 xn[TK][2], dn[TK][2];
                if (ks0 + TK < 32) ldtrip(xn, dn, ks0 + TK);
#pragma unroll
                for (int k = 0; k < TK; ++k) { const int ks = ks0 + k;
                    const f32x4 w0 = *(const LAS f32x4*)(lds + NW_L + (32 * ks + 8 * g) * 4), w1v = *(const LAS f32x4*)(lds + NW_L + (32 * ks + 8 * g + 4) * 4);
                    const f32x4 iw0 = *(const LAS f32x4*)(lds + IW_L + (32 * ks + 8 * g) * 4), iw1 = *(const LAS f32x4*)(lds + IW_L + (32 * ks + 8 * g + 4) * 4);
                    bf16x8 bh[2], bl[2];
#pragma unroll
                    for (int eh = 0; eh < 2; ++eh) { bh[eh] = *(const LAS bf16x8*)(lds + WRF_L + ((size_t)((ks * 2 + eh) * 2 + 0) * 64 + lane) * 16); bl[eh] = *(const LAS bf16x8*)(lds + WRF_L + ((size_t)((ks * 2 + eh) * 2 + 1) * 64 + lane) * 16); }
#pragma unroll
                    for (int tt = 0; tt < 2; ++tt) { const size_t ro = (size_t)(R0 + 16 * tt + c16) * DM + 32 * ks + 8 * g;
                        f32x4 a0, a1; { const u32x4 xx = xq[k][tt]; const f32x4 i0 = iw0 * irs[tt], i1 = iw1 * irs[tt];
                            a0.x = __builtin_bit_cast(float, xx.x << 16) * i0.x; a0.y = __builtin_bit_cast(float, xx.x & 0xffff0000u) * i0.y; a0.z = __builtin_bit_cast(float, xx.y << 16) * i0.z; a0.w = __builtin_bit_cast(float, xx.y & 0xffff0000u) * i0.w;
                            a1.x = __builtin_bit_cast(float, xx.z << 16) * i1.x; a1.y = __builtin_bit_cast(float, xx.z & 0xffff0000u) * i1.y; a1.z = __builtin_bit_cast(float, xx.w << 16) * i1.z; a1.w = __builtin_bit_cast(float, xx.w & 0xffff0000u) * i1.w; }
                        { const u32x4 dd = dq[k][tt];
                            a0.x += __builtin_bit_cast(float, dd.x << 16); a0.y += __builtin_bit_cast(float, dd.x & 0xffff0000u); a0.z += __builtin_bit_cast(float, dd.y << 16); a0.w += __builtin_bit_cast(float, dd.y & 0xffff0000u);
                            a1.x += __builtin_bit_cast(float, dd.z << 16); a1.y += __builtin_bit_cast(float, dd.z & 0xffff0000u); a1.z += __builtin_bit_cast(float, dd.w << 16); a1.w += __builtin_bit_cast(float, dd.w & 0xffff0000u); }
                        ssq[tt] += (a0.x * a0.x + a0.y * a0.y) + (a0.z * a0.z + a0.w * a0.w) + (a1.x * a1.x + a1.y * a1.y) + (a1.z * a1.z + a1.w * a1.w);
                        const f32x4 v0 = a0 * w0, v1 = a1 * w1v; u32x4 hw, lw;
                        hw.x = pk2(v0.x, v0.y); hw.y = pk2(v0.z, v0.w); hw.z = pk2(v1.x, v1.y); hw.w = pk2(v1.z, v1.w);
                        lw.x = pk2(v0.x - __builtin_bit_cast(float, hw.x << 16), v0.y - __builtin_bit_cast(float, hw.x & 0xffff0000u)); lw.y = pk2(v0.z - __builtin_bit_cast(float, hw.y << 16), v0.w - __builtin_bit_cast(float, hw.y & 0xffff0000u));
                        lw.z = pk2(v1.x - __builtin_bit_cast(float, hw.z << 16), v1.y - __builtin_bit_cast(float, hw.z & 0xffff0000u)); lw.w = pk2(v1.z - __builtin_bit_cast(float, hw.w << 16), v1.w - __builtin_bit_cast(float, hw.w & 0xffff0000u));
                        *(u32x2*)(H2q + ro) = pack8_fp8(v0, v1);
                        const bf16x8 ah = __builtin_bit_cast(bf16x8, hw), al = __builtin_bit_cast(bf16x8, lw);
#pragma unroll
                        for (int eh = 0; eh < 2; ++eh) { acc[tt][eh] = __builtin_amdgcn_mfma_f32_16x16x32_bf16(ah, bh[eh], acc[tt][eh], 0, 0, 0);
                            acc[tt][eh] = __builtin_amdgcn_mfma_f32_16x16x32_bf16(al, bh[eh], acc[tt][eh], 0, 0, 0); acc[tt][eh] = __builtin_amdgcn_mfma_f32_16x16x32_bf16(ah, bl[eh], acc[tt][eh], 0, 0, 0); } }
                }
                if (ks0 + TK < 32) {
#pragma unroll
                    for (int k = 0; k < TK; ++k)
#pragma unroll
                        for (int tt = 0; tt < 2; ++tt) { xq[k][tt] = xn[k][tt]; dq[k][tt] = dn[k][tt]; } }
            }
            __syncthreads();
            if (tid < 32) lcnt[tid] = 0u;
#pragma unroll
            for (int tt = 0; tt < 2; ++tt) { float s = ssq[tt]; s += __shfl_xor(s, 16); s += __shfl_xor(s, 32); const float rstd = 1.0f / sqrtf(s * (1.f / DM) + RMS_EPS);
                if (g == 0) prstd[wave * 32 + 16 * tt + c16] = rstd;
#pragma unroll
                for (int r = 0; r < 4; ++r) { const float rr = __shfl(rstd, 4 * g + r);
#pragma unroll
                    for (int eh = 0; eh < 2; ++eh) lg[(16 * tt + 4 * g + r) * 33 + 16 * eh + c16] = acc[tt][eh][r] * rr + b_router[16 * eh + c16]; } }
            LDS_BARRIER();
            if (lane < 32) {
                float v[32];
#pragma unroll
                for (int e = 0; e < 32; ++e) v[e] = lg[lane * 33 + e];
                float tv[4]; int te[4];
#pragma unroll
                for (int k = 0; k < 4; ++k) { float best = v[0]; int bi = 0;
#pragma unroll
                    for (int e = 1; e < 32; ++e) if (v[e] > best) { best = v[e]; bi = e; }
                    tv[k] = best; te[k] = bi;
#pragma unroll
                    for (int e = 0; e < 32; ++e) v[e] = (e == bi) ? -INFINITY : v[e]; }
                float ex[4], sum = 0.f;
#pragma unroll
                for (int k = 0; k < 4; ++k) { ex[k] = __expf(tv[k] - tv[0]); sum += ex[k]; }
                const float inv = 1.0f / sum;
#pragma unroll
                for (int k = 0; k < 4; ++k) { const unsigned lr = __hip_atomic_fetch_add(lcnt + te[k], 1u, __ATOMIC_RELAXED, __HIP_MEMORY_SCOPE_WORKGROUP);
                    const int p = (wave * 32 + lane) * 4 + k; pinfo[p] = (unsigned)te[k] | (lr << 8); pgate[p] = ex[k] * inv; }
            }
            LDS_BARRIER();
            if (tid < 32) lbase[tid] = __hip_atomic_fetch_add(ctl + CW_GCNT + 64 * tid, lcnt[tid], RLX_AGENT);
            LDS_BARRIER();
            for (int p = tid; p < 1024; p += NWAVES * 64) { const unsigned pi = pinfo[p]; const int e = pi & 255u; const unsigned pos = lbase[e] + (pi >> 8);
                const int pair = (blk * 256) * 4 + p; const size_t si = (size_t)e * NTOK + pos; slot[si] = pair; sgate[si] = pgate[p]; srstd[si] = prstd[p >> 2]; }
            LDS_BARRIER();
        }
    }
    SEAM(4);

    if (IN(5) || IN(6)) { PHASE_IDS();
        if (tid == 0) { int tp = 0, cp = 0;
            for (int e = 0; e < NEXP; ++e) { const int c = (int)__hip_atomic_load(ctl + CW_GCNT + 64 * e, RLX_AGENT); LTAB[e] = tp; LTAB[33 + e] = cp; tp += (c + 255) >> 8; cp += c; }
            LTAB[32] = tp; LTAB[33 + 32] = cp; }
        __syncthreads();
    }
    if (IN(5)) for (int rep_ = 0; rep_ < NREP(5); ++rep_) {
        pg8::ProbMoe1 P; P.T = LTAB[32]; P.NP = 8; P.G = G; P.c = bx; P.load_tables(LTAB, LTAB + 33);
        P.H2 = H2q; P.W1T = W1T; P.slot = slot; P.srstd = srstd; P.b1 = b1; P.ACT = ACT;
        pg8::gemm_phase<pg8::ProbMoe1, true>(lds, P);
    }
    SEAM(5);
    if (IN(6)) for (int rep_ = 0; rep_ < NREP(6); ++rep_) {
        pg8::ProbMoe2 P; P.T = LTAB[32]; P.NP = 4; P.G = G; P.c = bx; P.load_tables(LTAB, LTAB + 33);
        P.ACT = ACT; P.W2T = W2T; P.slot = slot; P.sgate = sgate; P.b2 = b2; P.Y4 = Y4;
        pg8::gemm_phase<pg8::ProbMoe2, true>(lds, P);
    }
    SEAM(6);

    if (IN(7)) for (int rep_ = 0; rep_ < NREP(7); ++rep_) { PHASE_IDS();
        const int gw = vcu * NWAVES + wave, NGW = G * NWAVES;
        unsigned bad = __hip_atomic_load(ctl + CW_TMO, RLX_AGENT);
        for (int li = 0; li < (MK_N_LAUNCHES == N_PHASES ? 0 : MK_N_LAUNCHES); ++li) bad |= __hip_atomic_load(ctl + CW_BAR + li * XCD_BAR_WORDS + XB_TMO, RLX_AGENT);
        f32x4 wv[4];
#pragma unroll
        for (int j = 0; j < 4; ++j) wv[j] = *((const f32x4*)final_w + lane + 64 * j);
        f32x4 iw[4];
#pragma unroll
        for (int j = 0; j < 4; ++j) iw[j] = *((const f32x4*)inw1 + lane + 64 * j);
        for (int mm = gw; mm < NTOK; mm += 2 * NGW) {
            f32x4 v[2][4]; u32x2 xq[2][4], dd[2][4]; unsigned yy[2][4][4]; int mr[2]; float irs[2]; mr[0] = mm; mr[1] = (mm + NGW < NTOK) ? mm + NGW : mm;
#pragma unroll
            for (int r = 0; r < 2; ++r) { const u32x2* xi = (const u32x2*)(XN + (size_t)mr[r] * DM) + lane; irs[r] = rstd1[mr[r]]; const unsigned* y0 = (const unsigned*)(Y4 + (size_t)mr[r] * 4 * DM) + lane; const u32x2* dl = (const u32x2*)(DELTA + (size_t)mr[r] * DM) + lane;
#pragma unroll
                for (int j = 0; j < 4; ++j) { xq[r][j] = __builtin_nontemporal_load(xi + 64 * j); dd[r][j] = __builtin_nontemporal_load(dl + 64 * j);
#pragma unroll
                    for (int k = 0; k < 4; ++k) yy[r][j][k] = __builtin_nontemporal_load(y0 + k * (DM / 4) + 64 * j); } }
#pragma unroll
            for (int r = 0; r < 2; ++r) { float s = 0.f; const float ir = 1.0f / irs[r];
#pragma unroll
                for (int j = 0; j < 4; ++j) { f32x4 a; { const u32x2 q = xq[r][j]; a.x = __builtin_bit_cast(float, q.x << 16); a.y = __builtin_bit_cast(float, q.x & 0xffff0000u); a.z = __builtin_bit_cast(float, q.y << 16); a.w = __builtin_bit_cast(float, q.y & 0xffff0000u); a = a * iw[j] * ir; }
                    { const u32x2 q = dd[r][j];
                        a.x += __builtin_bit_cast(float, q.x << 16); a.y += __builtin_bit_cast(float, q.x & 0xffff0000u); a.z += __builtin_bit_cast(float, q.y << 16); a.w += __builtin_bit_cast(float, q.y & 0xffff0000u); }
                    f32x4 ys = (f32x4){0.f, 0.f, 0.f, 0.f};
#pragma unroll
                    for (int k = 0; k < 4; ++k) { const f32x2 lo = __builtin_amdgcn_cvt_pk_f32_fp8((int)yy[r][j][k], false), hi = __builtin_amdgcn_cvt_pk_f32_fp8((int)yy[r][j][k], true);
                        ys.x += lo.x; ys.y += lo.y; ys.z += hi.x; ys.w += hi.y; }
                    a = a + ys * (1.f / 8.f);
                    v[r][j] = a; s += (a.x * a.x + a.y * a.y) + (a.z * a.z + a.w * a.w); }
                const float rstd = 1.0f / sqrtf(wave_sum(s) * (1.f / DM) + RMS_EPS);
                if (r == 0 || mr[1] != mr[0]) { f32x4* xr = (f32x4*)(out + (size_t)mr[r] * DM) + lane;
#pragma unroll
                    for (int j = 0; j < 4; ++j) { f32x4 y = v[r][j] * rstd * wv[j]; if (bad) { const float q = __builtin_nanf(""); y = (f32x4){q, q, q, q}; } xr[64 * j] = y; } }
            }
        }
    }
#ifdef PROBE_F6MAP
    __syncthreads();
    if (bx == 0 && threadIdx.x < 64) {
        const int l = (int)threadIdx.x, fr = l & 15, fq = l >> 4;
        const int pa[16] = {0, 0, 0, 0, 0, 0, 0, 1, 1, 2, 2, 3, 3, 3, 1, 2}, pb[16] = {0, 1, 4, 15, 16, 17, 31, 0, 16, 0, 16, 0, 16, 31, 5, 21};
        int a_ = 0, b_ = 0;
#pragma unroll
        for (int r = 0; r < 16; ++r) if (fr == r) { a_ = pa[r]; b_ = pb[r]; }
        v8i A8;
#pragma unroll
        for (int w = 0; w < 8; ++w) A8[w] = (fq == a_ && (b_ >> 2) == w) ? (0x38 << (8 * (b_ & 3))) : 0;
        unsigned long long lo64 = 0, mid64 = 0, hi64 = 0;
        const bool on = (fr < 8) && (fq == (fr & 3));
#pragma unroll
        for (int i = 0; i < 32; ++i) { const unsigned long long c = on ? (unsigned long long)((fr < 4) ? i : ((i + 1) & 31)) : 0ull; const int bit = 6 * i;
            if (bit < 64) { lo64 |= c << bit; if (bit > 58) mid64 |= c >> (64 - bit); }
            else if (bit < 128) { mid64 |= c << (bit - 64); if (bit > 122) hi64 |= c >> (128 - bit); }
            else hi64 |= c << (bit - 128); }
        v6i B6v = (v6i){(int)(unsigned)lo64, (int)(unsigned)(lo64 >> 32), (int)(unsigned)mid64, (int)(unsigned)(mid64 >> 32), (int)(unsigned)hi64, (int)(unsigned)(hi64 >> 32)};
        f32x4 d = (f32x4){0.f, 0.f, 0.f, 0.f}; const int one_ = 0x7f7f7f7f;
        asm volatile("s_nop 7\n\tv_mfma_scale_f32_16x16x128_f8f6f4 %0, %1, %2, %0, %3, %3 op_sel_hi:[0,0,0] cbsz:2\n\ts_nop 15\n\ts_nop 7" : "+v"(d) : "v"(B6v), "v"(A8), "v"(one_));
        LAS float* Dm = (LAS float*)lds;
#pragma unroll
        for (int r = 0; r < 4; ++r) Dm[(4 * fq + r) * 16 + fr] = d[r];
        asm volatile("s_waitcnt lgkmcnt(0)" ::: "memory");
        if (l < 16) { int found = -1, cnt = 0;
            for (int j = 0; j < 8; ++j) { const float v = Dm[j * 16 + l]; if (v != 0.f) { const float av = fabsf(v); const int code = av < 2.f ? (int)(av * 8.f + 0.5f) : (av < 4.f ? 16 + (int)((av - 2.f) * 4.f + 0.5f) : 24 + (int)((av - 4.f) * 2.f + 0.5f));
                    const int ip = (j < 4) ? code : ((code - 1) & 31); const int idx = 32 * (j & 3) + ip; if (found < 0 || found == idx) found = idx; else found = 255; ++cnt; } }
            if (found < 0) found = 254;
            ((LAS int*)lds)[512 + l] = found; }
        asm volatile("s_waitcnt lgkmcnt(0)" ::: "memory");
        if (l == 0) { const LAS int* R = (const LAS int*)lds + 512; bool h1 = true, h2 = true, h3 = true;
            for (int r = 0; r < 16; ++r) { const int a = pa[r], b = pb[r], idx = R[r]; const int fqp = idx >> 5, ip = idx & 31;
                if (idx != 32 * a + b) h1 = false;
                const int k8 = b < 16 ? 16 * a + b : 64 + 16 * a + (b - 16); if (idx != k8) h2 = false;
                const int k6 = ip < 16 ? 16 * fqp + ip : 64 + 16 * fqp + (ip - 16); if (idx > 127 || k6 != 32 * a + b) h3 = false; }
            const int hyp = h1 ? 1 : (h2 ? 2 : (h3 ? 3 : 0));
            const int sel = (PROBE_F6MAP) - 1;
            const unsigned long long ticks = sel < 0 ? (unsigned long long)(hyp + 1) * 30000ull : (unsigned long long)(R[sel] + 1) * 10000ull;
            const unsigned long long t0 = __builtin_amdgcn_s_memrealtime(); while (__builtin_amdgcn_s_memrealtime() - t0 < ticks) __builtin_amdgcn_s_sleep(8); }
    }
#endif
#ifdef PROBE_CHECK
    if (bx == 0 && threadIdx.x == 0) { const float rel = __uint_as_float(__hip_atomic_load(ctl + 49152 + 64 * ((PROBE_CHECK) - 1), RLX_AGENT)); unsigned long long ticks = (unsigned long long)(fminf(rel, 1.f) * 2.0e7f);
        const unsigned long long t0 = __builtin_amdgcn_s_memrealtime(); while (__builtin_amdgcn_s_memrealtime() - t0 < ticks) __builtin_amdgcn_s_sleep(8); }
#endif
#ifdef PROBE_TS
    if (bx == 0 && threadIdx.x == 0) { const unsigned val = (PROBE_TS) == 9 ? __hip_atomic_load(ctl + 49152 + 128, RLX_AGENT) : (PROBE_TS) == 10 ? __hip_atomic_load(ctl + 49152 + 256, RLX_AGENT) : MISC[20 + ((PROBE_TS) & 15)]; const unsigned long long t0 = __builtin_amdgcn_s_memrealtime(); while (__builtin_amdgcn_s_memrealtime() - t0 < (unsigned long long)val * 2ull) __builtin_amdgcn_s_sleep(8); }
#endif
#undef IN
#undef SEAM
}

extern "C" void kernel_launch(void* const* d_in, const int* in_sizes, int n_in, void* d_out, int out_size, void* d_ws, size_t ws_size, hipStream_t stream) {
    static int grid = 0;
    if (grid == 0) {
        if (n_in != 13 || in_sizes[0] != NTOK * DM || out_size != NTOK * DM || ws_size < WS_END) { fprintf(stderr, "kernel_launch: unexpected shapes (n_in %d, in0 %d, out %d, ws %zu)\n", n_in, n_in > 0 ? in_sizes[0] : -1, out_size, ws_size); grid = -1; return; }
        int dev = 0, cus = 0;
        if (hipGetDevice(&dev) != hipSuccess || hipDeviceGetAttribute(&cus, hipDeviceAttributeMultiprocessorCount, dev) != hipSuccess) { grid = -1; return; }
        if (hipFuncSetAttribute((const void*)fwd_mega, hipFuncAttributeMaxDynamicSharedMemorySize, LDS_BYTES) != hipSuccess) { fprintf(stderr, "kernel_launch: hipFuncSetAttribute failed\n"); grid = -1; return; }
        int per_cu = 0;
        if (hipOccupancyMaxActiveBlocksPerMultiprocessor(&per_cu, (const void*)fwd_mega, NWAVES * 64, LDS_BYTES) != hipSuccess || per_cu < 1) fprintf(stderr, "kernel_launch: occupancy query says %d\n", per_cu);
        (void)hipGetLastError();
        grid = cus;
    }
    if (grid < 0) return;
    (void)hipMemsetAsync((char*)d_ws + WS_CTL, 0, CTL_ZERO_BYTES, stream);
    Args a{};
    for (int i = 0; i < 13; ++i) a.in[i] = (const float*)d_in[i];
    a.out = (float*)d_out; a.ws = (unsigned char*)d_ws;
    if (MK_N_LAUNCHES == 1) { a.ph_lo = 0; a.ph_hi = N_PHASES; a.li = 0; hipLaunchKernelGGL(fwd_mega, dim3(grid), dim3(NWAVES * 64), LDS_BYTES, stream, a); }
    else for (int li = 0; li < N_PHASES; ++li) { a.ph_lo = li; a.ph_hi = li + 1; a.li = 0; hipLaunchKernelGGL(fwd_mega, dim3(grid), dim3(NWAVES * 64), LDS_BYTES, stream, a); }
}
```
